# Optimizing an MI355X kernel written in HIP

```python
import math
import jax, jax.numpy as jnp
from jax import lax
import numpy as np

D_MODEL = 4096
BATCH = 4
SEQ = 4096
DEPTH = 1
DEC_BATCH = 4
DEC_SEQ = 2048
PAST_LEN = 128

PLE_DIM = 256
HEAD_DIM = 128
N_Q_HEADS = D_MODEL // 256
N_KV_HEADS = N_Q_HEADS // 4
Q_PER_KV = N_Q_HEADS // N_KV_HEADS
ATTN_WIDTH = N_Q_HEADS * HEAD_DIM
KV_WIDTH = N_KV_HEADS * HEAD_DIM
WINDOW = 128
BLOCK = 128
N_BUCKETS = 32
MAX_DISTANCE = 128
HYENA_WIDTH = D_MODEL // 2
FILTER_BANDS = 16
FILTER_EMB = 2 * FILTER_BANDS + 1
FILTER_HIDDEN = 64
SHORT_CONV = 3
D_FF = 11008
EPS = 1e-6
NEG_INF = -1e30
Q_END = ATTN_WIDTH
K_END = Q_END + KV_WIDTH
V_END = K_END + KV_WIDTH
HY_END = V_END + 3 * HYENA_WIDTH
IN_COLS = HY_END + 2 * D_MODEL

kernel_name = 'hybrid_swa_hyena_encoder'


def rmsnorm(x, g):
    x32 = x.astype(jnp.float32)
    y = x32 * lax.rsqrt(jnp.mean(x32 * x32, axis=-1, keepdims=True) + EPS)
    return (y * g.astype(jnp.float32)).astype(x.dtype)


def dwconv3(x, w, b):
    xp = jnp.pad(x, ((0, 0), (1, 1), (0, 0)))
    return xp[:, :-2] * w[0] + xp[:, 1:-1] * w[1] + xp[:, 2:] * w[2] + b


def t5_bucket(rel):
    half = N_BUCKETS // 2
    max_exact = half // 2
    ret = jnp.where(rel > 0, half, 0)
    n = jnp.abs(rel)
    nf = jnp.maximum(n, 1).astype(jnp.float32)
    large = max_exact + (jnp.log(nf / max_exact) / math.log(MAX_DISTANCE / max_exact) * (half - max_exact)).astype(jnp.int32)
    large = jnp.minimum(large, half - 1)
    return ret + jnp.where(n < max_exact, n, large)


def windowed_gqa(q, k, v, rel_bias, sink):
    B, L = q.shape[:2]
    nb = L // BLOCK
    qb = q.reshape(B, nb, BLOCK, N_KV_HEADS, Q_PER_KV, HEAD_DIM)

    def band(t):
        tp = jnp.pad(t, ((0, 0), (BLOCK, BLOCK), (0, 0), (0, 0))).reshape(B, nb + 2, BLOCK, N_KV_HEADS, HEAD_DIM)
        return jnp.concatenate([tp[:, :-2], tp[:, 1:-1], tp[:, 2:]], axis=2)

    kb, vb = band(k), band(v)
    s = jnp.einsum('bnqkgd,bnskd->bnkgqs', qb, kb, preferred_element_type=jnp.float32) * (HEAD_DIM ** -0.5)
    qi = jnp.arange(BLOCK)[:, None]
    sj = jnp.arange(3 * BLOCK)[None, :]
    rel = sj - BLOCK - qi
    bias = jnp.transpose(rel_bias[t5_bucket(rel)], (2, 0, 1)).astype(jnp.float32)
    bias = bias.reshape(N_KV_HEADS, Q_PER_KV, BLOCK, 3 * BLOCK)
    kpos = jnp.arange(nb)[:, None] * BLOCK - BLOCK + jnp.arange(3 * BLOCK)[None, :]
    valid = (jnp.abs(rel) <= WINDOW)[None] & ((kpos >= 0) & (kpos < L))[:, None, :]
    s = jnp.where(valid[None, :, None, None], s + bias, NEG_INF)
    sink_l = sink.astype(jnp.float32).reshape(N_KV_HEADS, Q_PER_KV)[:, :, None, None]
    m = jnp.maximum(jnp.max(s, axis=-1, keepdims=True), sink_l)
    pr = jnp.exp(s - m)
    denom = jnp.sum(pr, axis=-1, keepdims=True) + jnp.exp(sink_l - m)
    o = jnp.einsum('bnkgqs,bnskd->bnqkgd', (pr / denom).astype(v.dtype), vb)
    return o.reshape(B, L, ATTN_WIDTH)


def hyena_filters(L, w1, b1, f1, w2, b2, f2, w3, decay):
    f32 = jnp.float32
    pos = jnp.arange(L, dtype=f32)
    t = pos / (L - 1)
    bands = jnp.linspace(1e-4, FILTER_BANDS - 1, FILTER_BANDS, dtype=f32)
    ang = (2.0 * math.pi / L) * pos[:, None] * bands[None, :]
    z = jnp.concatenate([t[:, None], jnp.cos(ang), -jnp.sin(ang)], axis=-1)
    h = jnp.sin(f1.astype(f32) * (z @ w1.astype(f32) + b1.astype(f32)))
    h = jnp.sin(f2.astype(f32) * (h @ w2.astype(f32) + b2.astype(f32)))
    h = (h @ w3.astype(f32)).reshape(L, 2, HYENA_WIDTH)
    return h * jnp.exp(-t[:, None, None] * decay.astype(f32)[None])


def bidir_long_conv(u, h_fwd, h_bwd):
    L, C = h_fwd.shape
    k = jnp.concatenate([h_fwd, jnp.zeros((1, C), jnp.float32), h_bwd[:0:-1]], axis=0)
    kf = jnp.fft.rfft(k, axis=0)
    uf = jnp.fft.rfft(u.astype(jnp.float32), n=2 * L, axis=1)
    return jnp.fft.irfft(uf * kf[None], n=2 * L, axis=1)[:, :L]


def encoder_layer(x, p, rel_bias, g_mix, w_in, attn_sink, hy_short_w, hy_short_b,
                  hy_filt_w1, hy_filt_b1, hy_filt_f1, hy_filt_w2, hy_filt_b2, hy_filt_f2,
                  hy_filt_w3, hy_decay, hy_skip, w_attn_o, w_hyena_o, w_out,
                  g_ffn, w_up, ffn_conv_w, ffn_conv_b, w_down, g_ple, w_ple_gate, w_ple):
    B, L, _ = x.shape
    h = rmsnorm(x, g_mix)
    z = h @ w_in
    q, k, v, hy, gate_logits = jnp.split(z, [Q_END, K_END, V_END, HY_END], axis=-1)
    attn = windowed_gqa(q.reshape(B, L, N_Q_HEADS, HEAD_DIM),
                        k.reshape(B, L, N_KV_HEADS, HEAD_DIM),
                        v.reshape(B, L, N_KV_HEADS, HEAD_DIM), rel_bias, attn_sink)
    hy = dwconv3(hy, hy_short_w, hy_short_b)
    hv, hx1, hx0 = jnp.split(hy, 3, axis=-1)
    filt = hyena_filters(L, hy_filt_w1, hy_filt_b1, hy_filt_f1, hy_filt_w2, hy_filt_b2,
                         hy_filt_f2, hy_filt_w3, hy_decay)
    u = hv * hx1
    hy_out = (bidir_long_conv(u, filt[:, 0], filt[:, 1])
              + u.astype(jnp.float32) * hy_skip.astype(jnp.float32)).astype(x.dtype) * hx0
    gates = jax.nn.sigmoid(gate_logits)
    g_attn, g_hy = jnp.split(gates, 2, axis=-1)
    mixed = (g_attn * (attn @ w_attn_o) + g_hy * (hy_out @ w_hyena_o)) @ w_out
    x = x + mixed
    h = rmsnorm(x, g_ffn)
    gu, val = jnp.split(h @ w_up, 2, axis=-1)
    gu = dwconv3(gu, ffn_conv_w, ffn_conv_b)
    x = x + (jax.nn.gelu(gu, approximate=False) * val) @ w_down
    h = rmsnorm(x, g_ple)
    x = x + jax.nn.sigmoid(h @ w_ple_gate) * (p @ w_ple)
    return x


def trunk(x, p, rel_bias, layer_weights, g_final):
    for l in range(DEPTH):
        x = encoder_layer(x, p[l], rel_bias, *[w[l] for w in layer_weights])
    return rmsnorm(x, g_final)


def setup_inputs(seed: int = 0) -> dict:
    key = jax.random.key(seed)
    ks = jax.random.split(key, 32)
    f32 = jnp.float32

    def nrm(k, shape, scale):
        return jax.random.normal(k, shape, f32) * scale

    def gain(k, shape):
        return 1.0 + 0.02 * jax.random.normal(k, shape, f32)

    return {
        'x_prompt': nrm(ks[0], (BATCH, SEQ, D_MODEL), 1.0),
        'x_sample': nrm(ks[1], (DEC_BATCH, DEC_SEQ, D_MODEL), 1.0),
        'p_prompt': nrm(ks[2], (DEPTH, BATCH, SEQ, PLE_DIM), 1.0),
        'p_sample': nrm(ks[3], (DEPTH, DEC_BATCH, DEC_SEQ, PLE_DIM), 1.0),
        'rel_bias': nrm(ks[4], (N_BUCKETS, N_Q_HEADS), 0.5),
        'g_mix': gain(ks[5], (DEPTH, D_MODEL)),
        'w_in': nrm(ks[6], (DEPTH, D_MODEL, IN_COLS), D_MODEL ** -0.5),
        'attn_sink': nrm(ks[7], (DEPTH, N_Q_HEADS), 0.5),
        'hy_short_w': nrm(ks[8], (DEPTH, SHORT_CONV, 3 * HYENA_WIDTH), SHORT_CONV ** -0.5),
        'hy_short_b': nrm(ks[9], (DEPTH, 3 * HYENA_WIDTH), 0.02),
        'hy_filt_w1': nrm(ks[10], (DEPTH, FILTER_EMB, FILTER_HIDDEN), FILTER_EMB ** -0.5),
        'hy_filt_b1': nrm(ks[11], (DEPTH, FILTER_HIDDEN), 0.02),
        'hy_filt_f1': gain(ks[12], (DEPTH, FILTER_HIDDEN)),
        'hy_filt_w2': nrm(ks[13], (DEPTH, FILTER_HIDDEN, FILTER_HIDDEN), FILTER_HIDDEN ** -0.5),
        'hy_filt_b2': nrm(ks[14], (DEPTH, FILTER_HIDDEN), 0.02),
        'hy_filt_f2': gain(ks[15], (DEPTH, FILTER_HIDDEN)),
        'hy_filt_w3': nrm(ks[16], (DEPTH, FILTER_HIDDEN, 2 * HYENA_WIDTH), 0.03 * FILTER_HIDDEN ** -0.5),
        'hy_decay': jax.random.uniform(ks[17], (DEPTH, 2, HYENA_WIDTH), f32, 3.0, 15.0),
        'hy_skip': nrm(ks[18], (DEPTH, HYENA_WIDTH), 0.5),
        'w_attn_o': nrm(ks[19], (DEPTH, ATTN_WIDTH, D_MODEL), ATTN_WIDTH ** -0.5),
        'w_hyena_o': nrm(ks[20], (DEPTH, HYENA_WIDTH, D_MODEL), HYENA_WIDTH ** -0.5),
        'w_out': nrm(ks[21], (DEPTH, D_MODEL, D_MODEL), D_MODEL ** -0.5),
        'g_ffn': gain(ks[22], (DEPTH, D_MODEL)),
        'w_up': nrm(ks[23], (DEPTH, D_MODEL, 2 * D_FF), D_MODEL ** -0.5),
        'ffn_conv_w': nrm(ks[24], (DEPTH, SHORT_CONV, D_FF), SHORT_CONV ** -0.5),
        'ffn_conv_b': nrm(ks[25], (DEPTH, D_FF), 0.02),
        'w_down': nrm(ks[26], (DEPTH, D_FF, D_MODEL), D_FF ** -0.5),
        'g_ple': gain(ks[27], (DEPTH, D_MODEL)),
        'w_ple_gate': nrm(ks[28], (DEPTH, D_MODEL, D_MODEL), D_MODEL ** -0.5),
        'w_ple': nrm(ks[29], (DEPTH, PLE_DIM, D_MODEL), PLE_DIM ** -0.5),
        'g_final': gain(ks[30], (D_MODEL,)),
    }


def reference(x_prompt, x_sample, p_prompt, p_sample, rel_bias, g_mix, w_in, attn_sink,
              hy_short_w, hy_short_b, hy_filt_w1, hy_filt_b1, hy_filt_f1, hy_filt_w2,
              hy_filt_b2, hy_filt_f2, hy_filt_w3, hy_decay, hy_skip, w_attn_o, w_hyena_o,
              w_out, g_ffn, w_up, ffn_conv_w, ffn_conv_b, w_down, g_ple, w_ple_gate, w_ple,
              g_final):
    layer_weights = (g_mix, w_in, attn_sink, hy_short_w, hy_short_b, hy_filt_w1, hy_filt_b1,
                     hy_filt_f1, hy_filt_w2, hy_filt_b2, hy_filt_f2, hy_filt_w3, hy_decay,
                     hy_skip, w_attn_o, w_hyena_o, w_out, g_ffn, w_up, ffn_conv_w, ffn_conv_b,
                     w_down, g_ple, w_ple_gate, w_ple)
    y_prompt = trunk(x_prompt, p_prompt, rel_bias, layer_weights, g_final)
    y_sample = trunk(x_sample, p_sample, rel_bias, layer_weights, g_final)
    return (y_prompt, y_sample)
```

```cpp
#include <hip/hip_runtime.h>
#include <cstdio>
#include <cstdint>
namespace pg8 {
#define PG8_LAS __attribute__((address_space(3)))
typedef unsigned short bf16_t;
typedef short bf16x8 __attribute__((ext_vector_type(8)));
typedef float f32x4 __attribute__((ext_vector_type(4)));
typedef unsigned u32x4 __attribute__((ext_vector_type(4)));
constexpr int BM = 256, BK = 64, HALF = 128, HTB = HALF * BK * 2  , STAGE_BYTES = 8 * HTB, NXCD = 8, WGM = 8;

__host__ __device__ __forceinline__ int lds_byte(int r, int c) { const int st = (r >> 4) * 2 + (c >> 5), rr = r & 15, cc = c & 31, ob = rr * 64 + cc * 2; return st * 1024 + (ob ^ (((ob >> 9) & 1) << 5)); }
__host__ __device__ __forceinline__ void stage_rc(int b, int& R, int& C) { const int st = b / 1024, sb = b % 1024, swz = sb ^ (((sb >> 9) & 1) << 5); R = (st >> 1) * 16 + swz / 64; C = (st & 1) * 32 + (swz % 64) / 2; }
__host__ __device__ __forceinline__ int perm32(int rho) { const int n = rho >> 4, i = rho & 15; return 8 * (i >> 2) + 4 * n + (i & 3); }

struct Unit { int pm, pn; };
struct Gemm { const bf16_t* A; const bf16_t* Bt; int M, N, K; };

struct StaticOrder {
    int nM, nN, nwg, G, c;
    __host__ __device__ void init(int M, int N, int G_, int c_) { nM = M / BM; nN = N / BM; nwg = nM * nN; G = G_; c = c_; }
    __host__ __device__ bool next(int i, Unit& u) const {
        const long L = (long)i * G + c; if (L >= nwg) return false;
        int wgid = (int)L; { const int q = nwg / NXCD, r = nwg % NXCD, xcd = wgid % NXCD, off = wgid / NXCD; wgid = (xcd < r ? xcd * (q + 1) : r * (q + 1) + (xcd - r) * q) + off; }
        const int nig = WGM * nN, gid = wgid / nig, fm = gid * WGM, gsz = (nM - fm) < WGM ? (nM - fm) : WGM;
        u.pm = fm + ((wgid % nig) % gsz); u.pn = (wgid % nig) / gsz; return true;
    }
    __device__ __forceinline__ void a_ready(const Unit&) const {}
    __device__ __forceinline__ void done(const Unit&) const {}
};
__device__ __forceinline__ unsigned cvt_pk_bf16(float lo, float hi) { unsigned r; asm volatile("v_cvt_pk_bf16_f32 %0, %1, %2" : "=v"(r) : "v"(lo), "v"(hi)); return r; }
typedef float f32x2 __attribute__((ext_vector_type(2)));
__device__ __forceinline__ f32x2 gelu_pk(f32x2 v) {
    const f32x2 av = __builtin_elementwise_abs(v), d = av * 0.2316418882f + 1.0f;
    f32x2 t; t.x = __builtin_amdgcn_rcpf(d.x); t.y = __builtin_amdgcn_rcpf(d.y);
    f32x2 q = t * 0.5307027145f + (-0.7265760135f); q = q * t + 0.7107068705f; q = q * t + (-0.142248368f); q = q * t + 0.127414796f; q = q * t;
    const f32x2 s = (v * v) * (-0.72134752044f);
    f32x2 e; e.x = __builtin_amdgcn_exp2f(s.x); e.y = __builtin_amdgcn_exp2f(s.y);
    const f32x2 m = v * (q * e), r = v - m;
    f32x2 o; o.x = v.x < 0.f ? m.x : r.x; o.y = v.y < 0.f ? m.y : r.y; return o;
}
typedef unsigned u32x2 __attribute__((ext_vector_type(2)));
__device__ __forceinline__ unsigned pk2f(float lo, float hi) { typedef float f2_ __attribute__((ext_vector_type(2))); typedef __bf16 b2_ __attribute__((ext_vector_type(2))); return __builtin_bit_cast(unsigned, __builtin_convertvector((f2_){lo, hi}, b2_)); }
__device__ __forceinline__ float bflo(unsigned u) { return __uint_as_float(u << 16); }
__device__ __forceinline__ float bfhi(unsigned u) { return __uint_as_float(u & 0xffff0000u); }
__device__ __forceinline__ float sigm(float x) { return __builtin_amdgcn_rcpf(1.0f + __builtin_amdgcn_exp2f(-1.44269504089f * x)); }
__device__ __forceinline__ u32x4 pack8(const f32x4 v0, const f32x4 v1) { u32x4 w; w.x = pk2f(v0[0], v0[1]); w.y = pk2f(v0[2], v0[3]); w.z = pk2f(v1[0], v1[1]); w.w = pk2f(v1[2], v1[3]); return w; }

struct EpiIn {
    static constexpr bool PERM = true, AFTER_DRAIN = false;
    bf16_t *QKV, *HY, *GT;
    __device__ __forceinline__ void operator()(const f32x4 (&acc)[2][2][4][2], const Unit& u, int wr, int wc, int fr, int fq) const {
        const int row0 = u.pm * BM + wr * 64 + fr; bf16_t* base; int ldc, colt; float sc = 1.f; bool sg = false;
        if (u.pn < 12) { base = QKV; ldc = 3072; colt = u.pn * 256; if (u.pn < 8) sc = 0.08838834764831845f; }
        else if (u.pn < 36) { base = HY; ldc = 6144; colt = (u.pn - 12) * 256; }
        else { base = GT; ldc = 8192; colt = (u.pn - 36) * 256; sg = true; }
        const int col0 = colt + wc * 32 + 8 * fq;
#pragma unroll
        for (int ai = 0; ai < 2; ++ai)
#pragma unroll
            for (int m = 0; m < 4; ++m) { bf16_t* rowp = base + (size_t)(row0 + ai * HALF + m * 16) * ldc + col0;
#pragma unroll
                for (int bj = 0; bj < 2; ++bj) { f32x4 v0 = acc[ai][bj][m][0], v1 = acc[ai][bj][m][1];
                    if (sg) {
#pragma unroll
                        for (int j = 0; j < 4; ++j) { v0[j] = sigm(v0[j]); v1[j] = sigm(v1[j]); } }
                    else { v0 = v0 * sc; v1 = v1 * sc; }
                    *(u32x4*)(rowp + bj * HALF) = pack8(v0, v1); } }
    }
};
struct EpiStore {
    static constexpr bool PERM = true, AFTER_DRAIN = false;
    bf16_t* O; int ldc;
    __device__ __forceinline__ void operator()(const f32x4 (&acc)[2][2][4][2], const Unit& u, int wr, int wc, int fr, int fq) const {
        const int row0 = u.pm * BM + wr * 64 + fr, col0 = u.pn * BM + wc * 32 + 8 * fq;
#pragma unroll
        for (int ai = 0; ai < 2; ++ai)
#pragma unroll
            for (int m = 0; m < 4; ++m) { bf16_t* rowp = O + (size_t)(row0 + ai * HALF + m * 16) * ldc + col0;
#pragma unroll
                for (int bj = 0; bj < 2; ++bj) *(u32x4*)(rowp + bj * HALF) = pack8(acc[ai][bj][m][0], acc[ai][bj][m][1]); }
    }
};
template <int MODE> struct EpiGate {
    static constexpr bool PERM = true, AFTER_DRAIN = false;
    const bf16_t* GT; bf16_t* TM;
    __device__ __forceinline__ void operator()(const f32x4 (&acc)[2][2][4][2], const Unit& u, int wr, int wc, int fr, int fq) const {
        const int row0 = u.pm * BM + wr * 64 + fr, col0 = u.pn * BM + wc * 32 + 8 * fq;
#pragma unroll
        for (int ai = 0; ai < 2; ++ai)
#pragma unroll
            for (int m = 0; m < 4; ++m) { const size_t r = (size_t)(row0 + ai * HALF + m * 16); const bf16_t* gp = GT + r * 8192 + MODE * 4096 + col0; bf16_t* tp = TM + r * 4096 + col0;
#pragma unroll
                for (int bj = 0; bj < 2; ++bj) { const u32x4 g = *(const u32x4*)(gp + bj * HALF); f32x4 v0 = acc[ai][bj][m][0], v1 = acc[ai][bj][m][1];
                    v0[0] *= bflo(g.x); v0[1] *= bfhi(g.x); v0[2] *= bflo(g.y); v0[3] *= bfhi(g.y); v1[0] *= bflo(g.z); v1[1] *= bfhi(g.z); v1[2] *= bflo(g.w); v1[3] *= bfhi(g.w);
                    if (MODE == 1) { const u32x4 t = *(const u32x4*)(tp + bj * HALF);
                        v0[0] += bflo(t.x); v0[1] += bfhi(t.x); v0[2] += bflo(t.y); v0[3] += bfhi(t.y); v1[0] += bflo(t.z); v1[1] += bfhi(t.z); v1[2] += bflo(t.w); v1[3] += bfhi(t.w); }
                    *(u32x4*)(tp + bj * HALF) = pack8(v0, v1); } }
    }
};
struct EpiRes {
    static constexpr bool PERM = false, AFTER_DRAIN = false;
    const float* b0; const float* b1; int split; float* out;
    __device__ __forceinline__ void operator()(const f32x4 (&acc)[2][2][4][2], const Unit& u, int wr, int wc, int fr, int fq) const {
        const int row0 = u.pm * BM + wr * 64 + fr, col0 = u.pn * BM + wc * 32 + 4 * fq;
#pragma unroll
        for (int ai = 0; ai < 2; ++ai)
#pragma unroll
            for (int m = 0; m < 4; ++m) { const int r = row0 + ai * HALF + m * 16;
                const float* bp = (r < split ? b0 + (size_t)r * 4096 : b1 + (size_t)(r - split) * 4096) + col0; float* op = out + (size_t)r * 4096 + col0;
#pragma unroll
                for (int bj = 0; bj < 2; ++bj)
#pragma unroll
                    for (int n = 0; n < 2; ++n) *(f32x4*)(op + bj * HALF + n * 16) = *(const f32x4*)(bp + bj * HALF + n * 16) + acc[ai][bj][m][n];
                if (m & 1) asm volatile("" ::: "memory"); }
    }
};
struct EpiGlu {
    static constexpr bool PERM = true, AFTER_DRAIN = false;
    const bf16_t* GU; bf16_t* ACT; const float* cw; const float* cb; int L;
    __device__ __forceinline__ void operator()(const f32x4 (&acc)[2][2][4][2], const Unit& u, int wr, int wc, int fr, int fq) const {
        const int row0 = u.pm * BM + wr * 64 + fr;
#pragma unroll
        for (int bj = 0; bj < 2; ++bj) {
            const int c0 = u.pn * BM + bj * HALF + wc * 32 + 8 * fq;
            f32x4 w0[2], w1[2], w2[2], bb[2];
#pragma unroll
            for (int n = 0; n < 2; ++n) { w0[n] = *(const f32x4*)(cw + c0 + 4 * n); w1[n] = *(const f32x4*)(cw + 11008 + c0 + 4 * n); w2[n] = *(const f32x4*)(cw + 22016 + c0 + 4 * n); bb[n] = *(const f32x4*)(cb + c0 + 4 * n); }
#pragma unroll
            for (int ai = 0; ai < 2; ++ai)
#pragma unroll
                for (int m = 0; m < 4; ++m) { const int r = row0 + ai * HALF + m * 16, t = r & (L - 1);
                    const bf16_t* gp = GU + (size_t)r * 11008 + c0;
                    const u32x4 z4 = {0u, 0u, 0u, 0u};
                    const u32x4 gc = *(const u32x4*)gp, gm = t > 0 ? *(const u32x4*)(gp - 11008) : z4, gn = t < L - 1 ? *(const u32x4*)(gp + 11008) : z4;
                    f32x4 xm[2], xc[2], xn[2];
                    xm[0] = (f32x4){bflo(gm.x), bfhi(gm.x), bflo(gm.y), bfhi(gm.y)}; xm[1] = (f32x4){bflo(gm.z), bfhi(gm.z), bflo(gm.w), bfhi(gm.w)};
                    xc[0] = (f32x4){bflo(gc.x), bfhi(gc.x), bflo(gc.y), bfhi(gc.y)}; xc[1] = (f32x4){bflo(gc.z), bfhi(gc.z), bflo(gc.w), bfhi(gc.w)};
                    xn[0] = (f32x4){bflo(gn.x), bfhi(gn.x), bflo(gn.y), bfhi(gn.y)}; xn[1] = (f32x4){bflo(gn.z), bfhi(gn.z), bflo(gn.w), bfhi(gn.w)};
                    f32x4 o[2];
#pragma unroll
                    for (int n = 0; n < 2; ++n) { const f32x4 pre = w0[n] * xm[n] + w1[n] * xc[n] + w2[n] * xn[n] + bb[n];
                        const f32x2 ga = gelu_pk((f32x2){pre[0], pre[1]}), gb = gelu_pk((f32x2){pre[2], pre[3]});
                        o[n] = (f32x4){ga.x, ga.y, gb.x, gb.y} * acc[ai][bj][m][n]; }
                    *(u32x4*)(ACT + (size_t)r * 11008 + c0) = pack8(o[0], o[1]); }
        }
    }
};
struct EpiPP {
    static constexpr bool PERM = false, AFTER_DRAIN = false;
    bf16_t* PP;
    __device__ __forceinline__ void operator()(const f32x4 (&acc)[2][2][4][2], const Unit& u, int wr, int wc, int fr, int fq) const {
        const int row0 = u.pm * BM + wr * 64 + fr, col0 = u.pn * BM + wc * 32 + 4 * fq;
#pragma unroll
        for (int ai = 0; ai < 2; ++ai)
#pragma unroll
            for (int m = 0; m < 4; ++m) { bf16_t* pp = PP + (size_t)(row0 + ai * HALF + m * 16) * 4096 + col0;
#pragma unroll
                for (int bj = 0; bj < 2; ++bj)
#pragma unroll
                    for (int n = 0; n < 2; ++n) { const f32x4 v = acc[ai][bj][m][n]; u32x2 w; w.x = pk2f(v[0], v[1]); w.y = pk2f(v[2], v[3]); *(u32x2*)(pp + bj * HALF + n * 16) = w; } }
    }
};
struct EpiPle {
    static constexpr bool PERM = false, AFTER_DRAIN = false;
    const bf16_t* PP; float* out;
    __device__ __forceinline__ void operator()(const f32x4 (&acc)[2][2][4][2], const Unit& u, int wr, int wc, int fr, int fq) const {
        const int row0 = u.pm * BM + wr * 64 + fr, col0 = u.pn * BM + wc * 32 + 4 * fq;
#pragma unroll
        for (int ai = 0; ai < 2; ++ai)
#pragma unroll
            for (int m = 0; m < 4; ++m) { const size_t ro = (size_t)(row0 + ai * HALF + m * 16) * 4096 + col0;
#pragma unroll
                for (int bj = 0; bj < 2; ++bj)
#pragma unroll
                    for (int n = 0; n < 2; ++n) { const f32x4 v = acc[ai][bj][m][n]; const u32x2 p = *(const u32x2*)(PP + ro + bj * HALF + n * 16); float* op = out + ro + bj * HALF + n * 16;
                        f32x4 x = *(const f32x4*)op; x[0] += sigm(v[0]) * bflo(p.x); x[1] += sigm(v[1]) * bfhi(p.x); x[2] += sigm(v[2]) * bflo(p.y); x[3] += sigm(v[3]) * bfhi(p.y); *(f32x4*)op = x; }
                asm volatile("" ::: "memory"); }
    }
};
template <class Epi, class Sched, bool ALIGN_EPI = false, bool SP2 = false>
__device__ __forceinline__ void gemm_phase(PG8_LAS unsigned char* lds, const Gemm g, const Sched& S, const Epi& E, int tid_in) {
    int tid_ = tid_in; asm volatile("" : "+v"(tid_));
    const int tid = tid_, wid = __builtin_amdgcn_readfirstlane(tid >> 6), lane = tid & 63, wr = wid >> 2, wc = wid & 3, fr = lane & 15, fq = lane >> 4;
    const int K = g.K, nt = K / BK;
    unsigned voffA[2], voffB[2];
#pragma unroll
    for (int i = 0; i < 2; ++i) { int R, C; stage_rc(tid * 16 + i * 8192, R, C); const int Rb = Epi::PERM ? ((R & ~31) + perm32(R & 31)) : R;
        voffA[i] = (unsigned)(R * K + C) * 2u; voffB[i] = (unsigned)(Rb * K + C) * 2u; }
    const size_t kstep = (size_t)(BK * 2);
    const size_t hstep = (size_t)HALF * K * 2;
    const size_t tstep = 2 * hstep;
    const unsigned ldsw = (unsigned)wid * 1024u;
    const int aoff = lds_byte(wr * 64 + fr, fq * 8), boff = lds_byte(wc * 32 + fr, fq * 8);
#define PG8_SA(b, h) (((b) * 2 + (h)) * HTB)
#define PG8_SB(b, h) ((4 + (b) * 2 + (h)) * HTB)
#define PG8_STAGE(bufoff, gbase, voff) do { _Pragma("unroll") for (int _i = 0; _i < 2; ++_i) \
        __builtin_amdgcn_global_load_lds((const unsigned*)((const char*)(gbase) + (voff)[_i]), (PG8_LAS unsigned*)(lds + (bufoff) + ldsw + _i * 8192), 16, 0, 0); } while (0)
#define PG8_LDA(dst, b, h) do { _Pragma("unroll") for (int m = 0; m < 4; ++m) _Pragma("unroll") for (int k = 0; k < 2; ++k) dst[m][k] = *(const PG8_LAS bf16x8*)(lds + PG8_SA(b, h) + aoff + m * 2048 + k * 1024); } while (0)
#define PG8_LDB(dst, b, h) do { _Pragma("unroll") for (int n = 0; n < 2; ++n) _Pragma("unroll") for (int k = 0; k < 2; ++k) dst[n][k] = *(const PG8_LAS bf16x8*)(lds + PG8_SB(b, h) + boff + n * 2048 + k * 1024); } while (0)
#define PG8_MMA(ai, bj, At, Bt) do { __builtin_amdgcn_s_setprio(1); _Pragma("unroll") for (int m = 0; m < 4; ++m) _Pragma("unroll") for (int n = 0; n < 2; ++n) _Pragma("unroll") for (int k = 0; k < 2; ++k) \
        acc[ai][bj][m][n] = __builtin_amdgcn_mfma_f32_16x16x32_bf16(Bt[n][k], At[m][k], acc[ai][bj][m][n], 0, 0, 0); __builtin_amdgcn_s_setprio(0); } while (0)
#define PG8_WAIT_V(n) asm volatile("s_waitcnt vmcnt(" #n ")" ::: "memory")
#define PG8_WAIT_L(n) asm volatile("s_waitcnt lgkmcnt(" #n ")" ::: "memory")
#define PG8_BAR __builtin_amdgcn_s_barrier()
#define PG8_SCHED __builtin_amdgcn_sched_barrier(0)
    Unit cur, nxt; int ui = 0;
    if (!S.next(0, cur)) return;
    f32x4 acc[2][2][4][2];
#pragma unroll
    for (int a = 0; a < 2; ++a)
#pragma unroll
        for (int b = 0; b < 2; ++b)
#pragma unroll
            for (int m = 0; m < 4; ++m)
#pragma unroll
                for (int n = 0; n < 2; ++n) acc[a][b][m][n] = (f32x4){0.f, 0.f, 0.f, 0.f};
    bf16x8 At[4][2], B0[2][2], B1[2][2];
    const char* cA = (const char*)g.A + (size_t)cur.pm * tstep; const char* cB = (const char*)g.Bt + (size_t)cur.pn * tstep;
    S.a_ready(cur);
    if constexpr (SP2) {
        PG8_STAGE(PG8_SB(0, 0), cB, voffB); PG8_STAGE(PG8_SB(0, 1), cB + hstep, voffB); PG8_STAGE(PG8_SA(0, 0), cA, voffA); PG8_STAGE(PG8_SA(0, 1), cA + hstep, voffA);
        if (wr == 1) PG8_BAR;
        PG8_WAIT_V(2); PG8_BAR;
        PG8_STAGE(PG8_SB(1, 0), cB + kstep, voffB); PG8_STAGE(PG8_SA(1, 0), cA + kstep, voffA); PG8_STAGE(PG8_SB(1, 1), cB + hstep + kstep, voffB);
        PG8_WAIT_V(6); PG8_BAR;
    } else {
        PG8_STAGE(PG8_SB(0, 0), cB, voffB); PG8_STAGE(PG8_SA(0, 0), cA, voffA); PG8_STAGE(PG8_SB(0, 1), cB + hstep, voffB); PG8_STAGE(PG8_SA(0, 1), cA + hstep, voffA);
        if (wr == 1) PG8_BAR;
        PG8_WAIT_V(4); PG8_BAR;
        PG8_STAGE(PG8_SB(1, 0), cB + kstep, voffB); PG8_STAGE(PG8_SA(1, 0), cA + kstep, voffA); PG8_STAGE(PG8_SB(1, 1), cB + hstep + kstep, voffB);
        PG8_WAIT_V(6); PG8_BAR;
    }
    for (;;) {
        const bool has_next = S.next(ui + 1, nxt);
        const char* nA = has_next ? (const char*)g.A + (size_t)nxt.pm * tstep : cA; const char* nB = has_next ? (const char*)g.Bt + (size_t)nxt.pn * tstep : cB;
        for (int t = 0; t < nt; t += 2) {
            const bool last = (t == nt - 2);
            const char* a1 = cA + (size_t)(t + 1) * kstep;
            const char* a2 = last ? nA : cA + (size_t)(t + 2) * kstep; const char* b2 = last ? nB : cB + (size_t)(t + 2) * kstep;
            const char* a3 = a2 + kstep; const char* b3 = b2 + kstep;
            if (last && has_next) S.a_ready(nxt);
            if constexpr (SP2) {
            PG8_LDB(B0, 0, 0); PG8_LDB(B1, 0, 1); PG8_SCHED; PG8_LDA(At, 0, 0); PG8_STAGE(PG8_SA(1, 1), a1 + hstep, voffA);
            PG8_WAIT_V(8); PG8_WAIT_L(0); PG8_BAR; PG8_MMA(0, 0, At, B0); PG8_MMA(0, 1, At, B1); PG8_BAR; PG8_SCHED;
            PG8_LDA(At, 0, 1); PG8_STAGE(PG8_SB(0, 0), b2, voffB); PG8_STAGE(PG8_SB(0, 1), b2 + hstep, voffB); PG8_STAGE(PG8_SA(0, 0), a2, voffA);
            PG8_WAIT_V(8); PG8_WAIT_L(0); PG8_BAR; PG8_MMA(1, 0, At, B0); PG8_MMA(1, 1, At, B1); PG8_BAR; PG8_SCHED;
            PG8_LDB(B0, 1, 0); PG8_LDB(B1, 1, 1); PG8_SCHED; PG8_LDA(At, 1, 0); PG8_STAGE(PG8_SA(0, 1), a2 + hstep, voffA);
            PG8_WAIT_V(8); PG8_WAIT_L(0); PG8_BAR; PG8_MMA(0, 0, At, B0); PG8_MMA(0, 1, At, B1); PG8_BAR; PG8_SCHED;
            PG8_LDA(At, 1, 1); PG8_STAGE(PG8_SB(1, 0), b3, voffB); PG8_STAGE(PG8_SB(1, 1), b3 + hstep, voffB); PG8_STAGE(PG8_SA(1, 0), a3, voffA);
            PG8_WAIT_V(8); PG8_WAIT_L(0); PG8_BAR; PG8_MMA(1, 0, At, B0); PG8_MMA(1, 1, At, B1); PG8_BAR; PG8_SCHED;
            } else {
            PG8_LDB(B0, 0, 0); PG8_SCHED; PG8_LDA(At, 0, 0); PG8_STAGE(PG8_SA(1, 1), a1 + hstep, voffA);
            PG8_WAIT_L(8); PG8_BAR; PG8_WAIT_L(0); PG8_MMA(0, 0, At, B0); PG8_BAR; PG8_SCHED;
            PG8_LDB(B1, 0, 1); PG8_STAGE(PG8_SB(0, 0), b2, voffB);
            PG8_BAR; PG8_WAIT_L(0); PG8_MMA(0, 1, At, B1); PG8_BAR;
            PG8_LDA(At, 0, 1); PG8_STAGE(PG8_SA(0, 0), a2, voffA);
            PG8_BAR; PG8_WAIT_L(0); PG8_MMA(1, 0, At, B0); PG8_BAR; PG8_SCHED;
            PG8_STAGE(PG8_SB(0, 1), b2 + hstep, voffB);
            PG8_WAIT_V(6); PG8_BAR; PG8_MMA(1, 1, At, B1); PG8_BAR;
            PG8_LDB(B0, 1, 0); PG8_SCHED; PG8_LDA(At, 1, 0); PG8_STAGE(PG8_SA(0, 1), a2 + hstep, voffA);
            PG8_WAIT_L(8); PG8_BAR; PG8_WAIT_L(0); PG8_MMA(0, 0, At, B0); PG8_BAR; PG8_SCHED;
            PG8_LDB(B1, 1, 1); PG8_STAGE(PG8_SB(1, 0), b3, voffB);
            PG8_BAR; PG8_WAIT_L(0); PG8_MMA(0, 1, At, B1); PG8_BAR;
            PG8_LDA(At, 1, 1); PG8_STAGE(PG8_SA(1, 0), a3, voffA);
            PG8_BAR; PG8_WAIT_L(0); PG8_MMA(1, 0, At, B0); PG8_BAR; PG8_SCHED;
            PG8_STAGE(PG8_SB(1, 1), b3 + hstep, voffB);
            PG8_WAIT_V(6); PG8_BAR; PG8_MMA(1, 1, At, B1); PG8_BAR;
            }
        }
        if constexpr (ALIGN_EPI) { if (wr == 0) PG8_BAR; }
        if constexpr (!Epi::AFTER_DRAIN) { E(acc, cur, wr, wc, fr, fq); S.done(cur); }
        if (!has_next) break;
#pragma unroll
        for (int a = 0; a < 2; ++a)
#pragma unroll
            for (int b = 0; b < 2; ++b)
#pragma unroll
                for (int m = 0; m < 4; ++m)
#pragma unroll
                    for (int n = 0; n < 2; ++n) acc[a][b][m][n] = (f32x4){0.f, 0.f, 0.f, 0.f};
        cur = nxt; cA = nA; cB = nB; ++ui;
        if constexpr (ALIGN_EPI) { if (wr == 1) PG8_BAR; }
    }
    PG8_WAIT_V(0);
    if constexpr (!ALIGN_EPI) { if (wr == 0) PG8_BAR; }
    PG8_BAR;
    if constexpr (Epi::AFTER_DRAIN) { E.fused(acc, cur, wr, wc, fr, fq, lds, wid, lane); S.done(cur); }
#undef PG8_SA
#undef PG8_SB
#undef PG8_STAGE
#undef PG8_LDA
#undef PG8_LDB
#undef PG8_MMA
#undef PG8_WAIT_V
#undef PG8_WAIT_L
#undef PG8_BAR
#undef PG8_SCHED
}
}

constexpr int NWAVES = 8, NTHR = 512;
constexpr int DM = 4096, MP = 16384, MS = 8192, M = MP + MS;
constexpr int LP = 4096, LS = 2048;
constexpr int NIN = 17408, AW = 2048, HW = 2048, FF = 11008, PLE = 256;
constexpr float EPS = 1e-6f;

constexpr size_t WS_CTL = 0, CTL_ZERO_BYTES = 1u << 20;
constexpr size_t SZ_PB = (size_t)M * PLE * 2;
constexpr size_t SZ_WUP = (size_t)2 * FF * DM * 2, SZ_WDN = (size_t)DM * FF * 2, SZ_WPG = (size_t)DM * DM * 2, SZ_WPL = (size_t)DM * PLE * 2;
constexpr size_t SZ_WIN = (size_t)NIN * DM * 2, SZ_WAO = (size_t)DM * AW * 2, SZ_WHO = (size_t)DM * HW * 2, SZ_WOUT = (size_t)DM * DM * 2;
constexpr size_t SZ_QKV = (size_t)M * 3072 * 2, SZ_HY = (size_t)M * 6144 * 2, SZ_GT = (size_t)M * 8192 * 2, SZ_XN = (size_t)M * DM * 2;
constexpr size_t WS_PB = CTL_ZERO_BYTES;
constexpr size_t WS_WUP = WS_PB + SZ_PB, WS_WDN = WS_WUP + SZ_WUP, WS_WPG = WS_WDN + SZ_WDN, WS_WPL = WS_WPG + SZ_WPG;
constexpr size_t WS_EARLY = WS_WPL + SZ_WPL;
constexpr size_t WS_WIN = WS_EARLY, WS_WAO = WS_WIN + SZ_WIN, WS_WHO = WS_WAO + SZ_WAO, WS_WOUT = WS_WHO + SZ_WHO;
constexpr size_t WS_QKV = WS_WOUT + SZ_WOUT, WS_HY = WS_QKV + SZ_QKV, WS_GT = WS_HY + SZ_HY, WS_END = WS_GT + SZ_GT;
constexpr size_t WS_HYO = WS_QKV;
constexpr size_t WS_TM = WS_HY;
constexpr size_t WS_XN2 = WS_END - SZ_XN;
constexpr size_t SZ_GU = (size_t)MP * FF * 2;
constexpr size_t WS_GU = WS_EARLY, WS_ACT = WS_GU + SZ_GU;
constexpr size_t WS_PP = WS_EARLY;
static_assert(WS_ACT + SZ_GU <= WS_XN2, "FFN buffers overlap XN2");
static_assert(WS_HYO + (size_t)M * HW * 2 <= WS_HY && WS_TM + SZ_XN <= WS_GT, "overlay map");
static_assert(WS_END <= 1450000000ull, "workspace");
constexpr size_t DO_XN = 0;
constexpr size_t DO_UT = 0;
constexpr size_t DO_KT = SZ_XN;
constexpr size_t DO_ATT = SZ_XN + (size_t)HW * (2 * LP + 2 * LS) * 4;
static_assert(DO_ATT + (size_t)M * AW * 2 <= (size_t)M * DM * 4, "d_out scratch map");
constexpr int CW_BAR = 4096;

constexpr int RING_BYTES = 131072;
constexpr int LDSCTL_OFF = RING_BYTES, MISC_OFF = LDSCTL_OFF + 320;
constexpr int LDS_BYTES = 147456;

#define GAS __attribute__((address_space(1)))
#define LAS __attribute__((address_space(3)))
typedef unsigned short bf16;
typedef unsigned v4u __attribute__((ext_vector_type(4)));
typedef float f32x4 __attribute__((ext_vector_type(4)));
typedef float f32x16 __attribute__((ext_vector_type(16)));
typedef short bf16x8 __attribute__((ext_vector_type(8)));
typedef short s16x4 __attribute__((ext_vector_type(4)));
typedef GAS unsigned gu32;
#define LDS_WAIT() asm volatile("s_waitcnt lgkmcnt(0)" ::: "memory")
using pg8::pk2f; using pg8::bflo; using pg8::bfhi;
#define XB_TMO      128
#define XB_XCNT(j)  (256  + 64 * (j))
#define XB_XSUB(j)  (1280 + 64 * (j))
#define XB_XGEN(j)  (2304 + 64 * (j))
#define XB_TOP      3328
#define XB_TOPGEN   3392
#define XCD_BAR_WORDS 3456
#define XB_SPIN_CAP (1u << 18)

__device__ __forceinline__ unsigned xb_ld(unsigned* p)              { return __hip_atomic_load(p, __ATOMIC_RELAXED, __HIP_MEMORY_SCOPE_AGENT); }
__device__ __forceinline__ unsigned xb_add(unsigned* p, unsigned v) { return __hip_atomic_fetch_add(p, v, __ATOMIC_RELAXED, __HIP_MEMORY_SCOPE_AGENT); }
__device__ __forceinline__ unsigned xb_xcc_id() { return (unsigned)__builtin_amdgcn_s_getreg((3 << 11) | 20) & 0xFu; }
#define XB_SPIN(cond, bar) do { unsigned _sp = 0; while (cond) { __builtin_amdgcn_s_sleep(1); \
    if ((++_sp & 255u) == 0u) { if (xb_ld(&(bar)[XB_TMO])) break; if (_sp > XB_SPIN_CAP) { atomicAdd(&(bar)[XB_TMO], 1u); break; } } } } while (0)

struct XcdBarrier {
    unsigned* bar; unsigned x;
    volatile LAS unsigned* st;
};

__device__ __forceinline__ XcdBarrier xcd_barrier_post(unsigned* bar, volatile LAS unsigned* st) {
    XcdBarrier b; b.bar = bar; b.x = xb_xcc_id(); b.st = st;
    if (threadIdx.x == 0) (void)xb_add(&bar[XB_XCNT(b.x)], 1u);
    return b;
}
__device__ __forceinline__ void xcd_barrier_complete(unsigned* bar, unsigned x, unsigned& nloc, unsigned& nx) {
    const unsigned G = gridDim.x * gridDim.y * gridDim.z;
    unsigned sum, cnt, mine, sp = 0u;
    for (;;) {
        sum = 0u; cnt = 0u; mine = 0u;
#pragma unroll
        for (unsigned j = 0; j < 16; ++j) { const unsigned c = xb_ld(&bar[XB_XCNT(j)]); sum += c; cnt += (c > 0u) ? 1u : 0u; mine = (j == x) ? c : mine; }
        if (sum == G) break;
        __builtin_amdgcn_s_sleep(1);
        if ((++sp & 255u) == 0u) { if (xb_ld(&bar[XB_TMO])) break; if (sp > XB_SPIN_CAP) { atomicAdd(&bar[XB_TMO], 1u); break; } }
    }
    nloc = mine > 0u ? mine : 1u; nx = cnt > 0u ? cnt : 1u;
}

__device__ __forceinline__ void xcd_barrier(const XcdBarrier& b) {
    asm volatile("s_waitcnt vmcnt(0)" ::: "memory");
    __syncthreads();
    if (threadIdx.x == 0) {
        unsigned* bar = b.bar;
        __builtin_amdgcn_s_waitcnt(0);
        unsigned nloc = b.st[0], nx = b.st[1];
        if (nloc == 0u) { xcd_barrier_complete(bar, b.x, nloc, nx); b.st[0] = nloc; b.st[1] = nx; }
        const unsigned old = xb_add(&bar[XB_XSUB(b.x)], 1u);
        const unsigned gen = old / nloc;
        if (old + 1u == (gen + 1u) * nloc) {
            __builtin_amdgcn_fence(__ATOMIC_RELEASE, "agent");
            asm volatile("s_waitcnt vmcnt(0)" ::: "memory");
            const unsigned og = xb_add(&bar[XB_TOP], 1u);
            const unsigned tg = og / nx;
            if (og + 1u == (tg + 1u) * nx) xb_add(&bar[XB_TOPGEN], 1u);
            else XB_SPIN(xb_ld(&bar[XB_TOPGEN]) == tg, bar);
            __builtin_amdgcn_fence(__ATOMIC_ACQUIRE, "agent");
            xb_add(&bar[XB_XGEN(b.x)], 1u);
            asm volatile("s_waitcnt vmcnt(0)" ::: "memory");
        } else {
            XB_SPIN(xb_ld(&bar[XB_XGEN(b.x)]) == gen, bar);
            __builtin_amdgcn_fence(__ATOMIC_ACQUIRE, "agent");
            asm volatile("s_waitcnt vmcnt(0)" ::: "memory");
        }
    }
    __syncthreads();
}

struct Args { const float* in[31]; float* out; unsigned char* ws; int ph_lo, ph_hi; };
struct Frame {
    LAS unsigned char* lds;
    int tid, lane, wave, vcu, G;
};
__device__ __forceinline__ void refresh(Frame& F) { unsigned z_ = 0u; asm volatile("" : "+v"(z_)); const int l_ = (int)__builtin_amdgcn_mbcnt_hi(~0u, __builtin_amdgcn_mbcnt_lo(~0u, z_)); F.lane = l_; F.tid = F.wave * 64 + l_; }
__device__ __forceinline__ float shx(float v, int mask, int lane) { return __int_as_float(__builtin_amdgcn_ds_bpermute((lane ^ mask) << 2, __float_as_int(v))); }

__device__ __forceinline__ void p0_transpose_item(const float* W, int K, int N, bf16* WT, LAS float* scr, int item, int lane) {
    const int nblk = N / 32, kb = item / nblk, nb = item % nblk, k0 = 64 * kb, n0 = 32 * nb;
#pragma unroll 8
    for (int i = 0; i < 32; ++i) { const int kk = 2 * i + (lane >> 5); scr[kk * 33 + (lane & 31)] = W[(size_t)(k0 + kk) * N + n0 + (lane & 31)]; }
    LDS_WAIT(); asm volatile("" ::: "memory");
    const int c = lane & 7;
#pragma unroll
    for (int j = 0; j < 4; ++j) { const int n = (lane >> 3) + 8 * j; const LAS float* s = scr + (8 * c) * 33 + n;
        v4u o; o.x = pk2f(s[0 * 33], s[1 * 33]); o.y = pk2f(s[2 * 33], s[3 * 33]); o.z = pk2f(s[4 * 33], s[5 * 33]); o.w = pk2f(s[6 * 33], s[7 * 33]);
        *(GAS v4u*)(WT + (size_t)(n0 + n) * K + k0 + 8 * c) = o; }
    LDS_WAIT(); asm volatile("" ::: "memory");
}
template <bool BF> __device__ __forceinline__ void rms_row(const float* xrow, const float* g, void* orow, int lane) {
    const GAS f32x4* xr = (const GAS f32x4*)xrow + lane; const GAS f32x4* gr = (const GAS f32x4*)g + lane;
    f32x4 v[16]; float s = 0.f;
#pragma unroll
    for (int j = 0; j < 16; ++j) { v[j] = xr[64 * j]; s += (v[j].x * v[j].x + v[j].y * v[j].y) + (v[j].z * v[j].z + v[j].w * v[j].w); }
#pragma unroll
    for (int o = 1; o < 64; o <<= 1) s += shx(s, o, lane);
    const float r = 1.0f / sqrtf(s * (1.0f / 4096.0f) + EPS);
#pragma unroll
    for (int j = 0; j < 16; ++j) { const f32x4 gg = gr[64 * j]; const f32x4 y = v[j] * r * gg;
        if (BF) { ((GAS unsigned long long*)orow)[lane + 64 * j] = (unsigned long long)pk2f(y.x, y.y) | ((unsigned long long)pk2f(y.z, y.w) << 32); }
        else ((GAS f32x4*)orow)[lane + 64 * j] = y; }
}
__device__ __forceinline__ void rms_phase_bf16(const Frame& F, const float* src0, const float* src1, const float* g, bf16* dst) {
    const int gw = F.vcu * NWAVES + F.wave, NGW = F.G * NWAVES;
    for (int m = gw; m < M; m += NGW) rms_row<true>(m < MP ? src0 + (size_t)m * DM : src1 + (size_t)(m - MP) * DM, g, dst + (size_t)m * DM, F.lane);
}

__device__ __forceinline__ void h0_phase(const Frame& F, const Args& A, float* KT) {
    const float* w1 = A.in[10]; const float* b1 = A.in[11]; const float* f1 = A.in[12]; const float* w2 = A.in[13]; const float* b2 = A.in[14]; const float* f2 = A.in[15];
    const float* w3 = A.in[16]; const float* decay = A.in[17]; const float* skip = A.in[18];
    LAS float* Z = (LAS float*)F.lds; LAS float* H1 = Z + 64 * 33; LAS float* H2 = H1 + 64 * 64; LAS float* T = H2 + 64 * 64;
#pragma unroll 1
    for (int unit = F.vcu; unit < 1536; unit += F.G) {
        int tid = F.tid; asm volatile("" : "+v"(tid));
        const int dct = unit & 15, lt = unit >> 4, dc0 = dct * 256, dir = dc0 >> 11, c0 = dc0 & 2047;
        const int lsel = lt >= 64, L = lsel ? LS : LP, l0 = (lsel ? lt - 64 : lt) * 64;
        float* KTb = KT + (lsel ? (size_t)HW * 2 * LP : 0);
        const float invLm1 = 1.0f / (float)(L - 1);
        for (int idx = tid; idx < 64 * 33; idx += NTHR) { const int li = idx / 33, f = idx - li * 33; const float lf = (float)(l0 + li);
            float v;
            if (f == 0) v = lf * invLm1;
            else { const int i = (f - 1) & 15; const float band = 1e-4f + (float)i * ((15.0f - 1e-4f) / 15.0f); const float a = 2.0f * lf * band / (float)L;
                v = f <= 16 ? cospif(a) : -sinpif(a); }
            Z[idx] = v; }
        __syncthreads();
        { const int j = tid & 63, lg = tid >> 6; float wc[33];
#pragma unroll
          for (int i = 0; i < 33; ++i) wc[i] = w1[i * 64 + j];
          const float bj = b1[j], fj = f1[j];
#pragma unroll 1
          for (int it = 0; it < 8; ++it) { const int li = lg + 8 * it; float a = bj;
#pragma unroll
              for (int i = 0; i < 33; ++i) a += Z[li * 33 + i] * wc[i];
              H1[li * 64 + j] = sinf(fj * a); } }
        __syncthreads();
        { const int j = tid & 63, lg = tid >> 6; float wc[64];
#pragma unroll
          for (int i = 0; i < 64; ++i) wc[i] = w2[i * 64 + j];
          const float bj = b2[j], fj = f2[j];
#pragma unroll 1
          for (int it = 0; it < 8; ++it) { const int li = lg + 8 * it; float a = bj;
#pragma unroll
              for (int i = 0; i < 64; ++i) a += H1[li * 64 + i] * wc[i];
              H2[li * 64 + j] = sinf(fj * a); } }
        __syncthreads();
        { const int dcl = tid & 255, lg = tid >> 8; float wc[64];
#pragma unroll
          for (int i = 0; i < 64; ++i) wc[i] = w3[(size_t)i * 4096 + dc0 + dcl];
          const float dec = decay[dc0 + dcl];
#pragma unroll 1
          for (int i2 = 0; i2 < 32; ++i2) { const int li = lg * 32 + i2; float a = 0.f;
#pragma unroll
              for (int i = 0; i < 64; i += 4) { const f32x4 hv = *(const LAS f32x4*)(H2 + li * 64 + i); a += hv.x * wc[i] + hv.y * wc[i + 1] + hv.z * wc[i + 2] + hv.w * wc[i + 3]; }
              const float t = (float)(l0 + li) * invLm1;
              T[dcl * 65 + li] = a * expf(-t * dec); } }
        __syncthreads();
#pragma unroll 2
        for (int it = 0; it < 32; ++it) { const int row = (tid >> 6) + 8 * it, i = tid & 63, c = c0 + row, l = l0 + i; float v = T[row * 65 + i]; int n;
            if (dir == 0) { n = l; if (l == 0) v += skip[c]; }
            else { if (l == 0) { n = L; v = 0.f; } else n = 2 * L - l; }
            KTb[(size_t)c * (2 * L) + n] = v; }
        __syncthreads();
    }
}

__device__ __forceinline__ void h1_phase(const Frame& F, const Args& A, const bf16* HY, float* UT) {
    const float* sw = A.in[8]; const float* sb = A.in[9];
    LAS float* T = (LAS float*)F.lds;
#pragma unroll 1
    for (int unit = F.vcu; unit < 6144; unit += F.G) {
        int tid = F.tid; asm volatile("" : "+v"(tid)); const int cp = tid & 63, tq = tid >> 6;
        const int ct = unit & 15, tt = unit >> 4;
        int seq, t0, L, rowbase; float* ut;
        if (tt < 256) { seq = tt >> 6; t0 = (tt & 63) * 64; L = LP; rowbase = seq * LP; ut = UT; }
        else { const int t2 = tt - 256; seq = t2 >> 5; t0 = (t2 & 31) * 64; L = LS; rowbase = MP + seq * LS; ut = UT + (size_t)HW * 4 * LP; }
        const int c = ct * 128 + 2 * cp;
        float w[2][2][3], b[2][2];
#pragma unroll
        for (int cm = 0; cm < 2; ++cm)
#pragma unroll
            for (int ch = 0; ch < 2; ++ch) { b[cm][ch] = sb[cm * 2048 + c + ch];
#pragma unroll
                for (int k = 0; k < 3; ++k) w[cm][ch][k] = sw[k * 6144 + cm * 2048 + c + ch]; }
        float x[2][2][10];
#pragma unroll
        for (int i = 0; i < 10; ++i) { const int t = t0 + tq * 8 - 1 + i;
#pragma unroll
            for (int cm = 0; cm < 2; ++cm) { unsigned v = 0u; if (t >= 0 && t < L) v = *(const unsigned*)(HY + (size_t)(rowbase + t) * 6144 + cm * 2048 + c);
                x[cm][0][i] = bflo(v); x[cm][1][i] = bfhi(v); } }
#pragma unroll
        for (int i = 0; i < 8; ++i)
#pragma unroll
            for (int ch = 0; ch < 2; ++ch) {
                const float a = w[0][ch][0] * x[0][ch][i] + w[0][ch][1] * x[0][ch][i + 1] + w[0][ch][2] * x[0][ch][i + 2] + b[0][ch];
                const float d = w[1][ch][0] * x[1][ch][i] + w[1][ch][1] * x[1][ch][i + 1] + w[1][ch][2] * x[1][ch][i + 2] + b[1][ch];
                T[(ch * 64 + cp) * 65 + tq * 8 + i] = a * d; }
        __syncthreads();
#pragma unroll 4
        for (int it = 0; it < 16; ++it) { const int rho = (tid >> 6) + 8 * it, i = tid & 63, cc = ct * 128 + 2 * (rho & 63) + (rho >> 6);
            ut[((size_t)cc * 4 + seq) * L + t0 + i] = T[rho * 65 + i]; }
        __syncthreads();
    }
}
__device__ __forceinline__ void h3_phase(const Frame& F, const Args& A, const bf16* HY, const float* UT, bf16* HYO) {
    const float* sw = A.in[8]; const float* sb = A.in[9];
    LAS float* T = (LAS float*)F.lds;
#pragma unroll 1
    for (int unit = F.vcu; unit < 6144; unit += F.G) {
        int tid = F.tid; asm volatile("" : "+v"(tid)); const int cp = tid & 63, tq = tid >> 6;
        const int ct = unit & 15, tt = unit >> 4;
        int seq, t0, L, rowbase; const float* ut;
        if (tt < 256) { seq = tt >> 6; t0 = (tt & 63) * 64; L = LP; rowbase = seq * LP; ut = UT; }
        else { const int t2 = tt - 256; seq = t2 >> 5; t0 = (t2 & 31) * 64; L = LS; rowbase = MP + seq * LS; ut = UT + (size_t)HW * 4 * LP; }
#pragma unroll 4
        for (int it = 0; it < 16; ++it) { const int rho = (tid >> 6) + 8 * it, i = tid & 63, cc = ct * 128 + 2 * (rho & 63) + (rho >> 6);
            T[rho * 65 + i] = ut[((size_t)cc * 4 + seq) * L + t0 + i]; }
        const int c = ct * 128 + 2 * cp;
        float w[2][3], b[2];
#pragma unroll
        for (int ch = 0; ch < 2; ++ch) { b[ch] = sb[4096 + c + ch];
#pragma unroll
            for (int k = 0; k < 3; ++k) w[ch][k] = sw[k * 6144 + 4096 + c + ch]; }
        float x[2][10];
#pragma unroll
        for (int i = 0; i < 10; ++i) { const int t = t0 + tq * 8 - 1 + i; unsigned v = 0u; if (t >= 0 && t < L) v = *(const unsigned*)(HY + (size_t)(rowbase + t) * 6144 + 4096 + c);
            x[0][i] = bflo(v); x[1][i] = bfhi(v); }
        __syncthreads();
#pragma unroll
        for (int i = 0; i < 8; ++i) {
            const float g0 = w[0][0] * x[0][i] + w[0][1] * x[0][i + 1] + w[0][2] * x[0][i + 2] + b[0];
            const float g1 = w[1][0] * x[1][i] + w[1][1] * x[1][i + 1] + w[1][2] * x[1][i + 2] + b[1];
            const float y0 = T[cp * 65 + tq * 8 + i], y1 = T[(64 + cp) * 65 + tq * 8 + i];
            *(unsigned*)(HYO + (size_t)(rowbase + t0 + tq * 8 + i) * 2048 + c) = pk2f(y0 * g0, y1 * g1); }
        __syncthreads();
    }
}

#define HD_INLINE __device__ __forceinline__
#define XP(T) LAS T*
#ifndef FFT_CORE_H
#define FFT_CORE_H
#ifdef __HIP_DEVICE_COMPILE__
typedef float cf __attribute__((ext_vector_type(2)));
#elif defined(__clang__)
typedef float cf __attribute__((ext_vector_type(2)));
#else
struct cf { float x, y; };
#endif
#define MKCF(a, b) (cf{(a), (b)})
HD_INLINE cf cadd(cf a, cf b) { return cf{a.x + b.x, a.y + b.y}; }
HD_INLINE cf csub(cf a, cf b) { return cf{a.x - b.x, a.y - b.y}; }
HD_INLINE cf cmul(cf a, cf b) { return cf{a.x * b.x - a.y * b.y, a.x * b.y + a.y * b.x}; }
HD_INLINE cf cmulc(cf a, cf b) { return cf{a.x * b.x + a.y * b.y, a.y * b.x - a.x * b.y}; }
HD_INLINE int fpad(int i) { return i + (i >> 4); }
template <int LR> HD_INLINE void dif_regs(cf (&v)[1 << LR], XP(const cf) W, int N, int q, int o) {
    constexpr int R = 1 << LR;
#pragma unroll
    for (int st = 0; st < LR; ++st) {
        const int half = R >> (st + 1);
        const int mul = N / (2 * half * q);
#pragma unroll
        for (int j = 0; j < R; ++j) {
            if ((j & half) == 0) {
                const int e = (o + (j & (half - 1)) * q) * mul;
                const cf a = v[j], b = v[j + half];
                v[j] = cadd(a, b);
                v[j + half] = cmul(csub(a, b), W[e]);
            }
        }
    }
}
template <int LR> HD_INLINE void dit_regs(cf (&v)[1 << LR], XP(const cf) W, int N, int s0, int o) {
    constexpr int R = 1 << LR;
#pragma unroll
    for (int st = 0; st < LR; ++st) {
        const int half = 1 << st;
        const int mul = N / (2 * half * s0);
#pragma unroll
        for (int j = 0; j < R; ++j) {
            if ((j & half) == 0) {
                const int e = (o + (j & (half - 1)) * s0) * mul;
                const cf a = v[j], b = cmulc(v[j + half], W[e]);
                v[j] = cadd(a, b);
                v[j + half] = csub(a, b);
            }
        }
    }
}
template <int LR> HD_INLINE void dif_pass(XP(cf) X, XP(const cf) W, int N, int S, int tid, int nthr) {
    constexpr int R = 1 << LR;
    const int q = S >> (LR - 1);
#pragma unroll 1
    for (int bf = tid; bf < N / R; bf += nthr) {
        const int blk = bf / q, o = bf - blk * q, base = blk * 2 * S + o;
        cf v[R];
#pragma unroll
        for (int j = 0; j < R; ++j) v[j] = X[fpad(base + j * q)];
        dif_regs<LR>(v, W, N, q, o);
#pragma unroll
        for (int j = 0; j < R; ++j) X[fpad(base + j * q)] = v[j];
    }
}
template <int LR> HD_INLINE void dit_pass(XP(cf) X, XP(const cf) W, int N, int s0, int tid, int nthr) {
    constexpr int R = 1 << LR;
#pragma unroll 1
    for (int bf = tid; bf < N / R; bf += nthr) {
        const int blk = bf / s0, o = bf - blk * s0, base = blk * R * s0 + o;
        cf v[R];
#pragma unroll
        for (int j = 0; j < R; ++j) v[j] = X[fpad(base + j * s0)];
        dit_regs<LR>(v, W, N, s0, o);
#pragma unroll
        for (int j = 0; j < R; ++j) X[fpad(base + j * s0)] = v[j];
    }
}
#endif
#undef HD_INLINE
#undef XP
constexpr int FFT_W_OFF = (8192 + 512 + 16) * 8;
template <int LOG2N> __device__ __forceinline__ void fft_conv_channel(const Frame& F, const float* kt, float* u, int L) {
    constexpr int N = 1 << LOG2N, LRA = (LOG2N == 13) ? 4 : 3, RA = 1 << LRA, NIN_A = RA / 2;
    LAS cf* X = (LAS cf*)F.lds; const LAS cf* W = (const LAS cf*)(F.lds + FFT_W_OFF);
    int tid = F.tid; asm volatile("" : "+v"(tid));
    { cf v[RA];
#pragma unroll
      for (int j = 0; j < RA; ++j) v[j] = cf{kt[tid + 512 * j], 0.f};
      dif_regs<LRA>(v, W, N, 512, tid);
#pragma unroll
      for (int j = 0; j < RA; ++j) X[fpad(tid + 512 * j)] = v[j]; }
    __syncthreads();
    if (LOG2N == 13) { dif_pass<4>(X, W, N, 256, tid, NTHR); __syncthreads(); dif_pass<1>(X, W, N, 16, tid, NTHR); }
    else { dif_pass<3>(X, W, N, 256, tid, NTHR); __syncthreads(); dif_pass<2>(X, W, N, 32, tid, NTHR); }
    __syncthreads();
    cf kf[16];
    if (tid < N / 16) {
#pragma unroll
        for (int j = 0; j < 16; ++j) kf[j] = X[fpad(tid * 16 + j)];
        dif_regs<4>(kf, W, N, 1, 0);
#pragma unroll
        for (int j = 0; j < 16; ++j) { kf[j].x *= (1.0f / N); kf[j].y *= (1.0f / N); }
    } else {
#pragma unroll
        for (int j = 0; j < 16; ++j) kf[j] = cf{0.f, 0.f};
    }
    __syncthreads();
#pragma unroll 1
    for (int pr = 0; pr < 2; ++pr) {
        float* u0 = u + (size_t)(2 * pr) * L; float* u1 = u0 + L;
        { cf v[RA];
#pragma unroll
          for (int j = 0; j < RA; ++j) v[j] = (j < NIN_A) ? cf{u0[tid + 512 * j], u1[tid + 512 * j]} : cf{0.f, 0.f};
          dif_regs<LRA>(v, W, N, 512, tid);
#pragma unroll
          for (int j = 0; j < RA; ++j) X[fpad(tid + 512 * j)] = v[j]; }
        __syncthreads();
        if (LOG2N == 13) { dif_pass<4>(X, W, N, 256, tid, NTHR); __syncthreads(); dif_pass<1>(X, W, N, 16, tid, NTHR); }
        else { dif_pass<3>(X, W, N, 256, tid, NTHR); __syncthreads(); dif_pass<2>(X, W, N, 32, tid, NTHR); }
        __syncthreads();
        if (tid < N / 16) { cf v[16];
#pragma unroll
            for (int j = 0; j < 16; ++j) v[j] = X[fpad(tid * 16 + j)];
            dif_regs<4>(v, W, N, 1, 0);
#pragma unroll
            for (int j = 0; j < 16; ++j) v[j] = cmul(v[j], kf[j]);
            dit_regs<4>(v, W, N, 1, 0);
#pragma unroll
            for (int j = 0; j < 16; ++j) X[fpad(tid * 16 + j)] = v[j]; }
        __syncthreads();
        if (LOG2N == 13) { dit_pass<1>(X, W, N, 16, tid, NTHR); __syncthreads(); dit_pass<4>(X, W, N, 32, tid, NTHR); }
        else { dit_pass<2>(X, W, N, 16, tid, NTHR); __syncthreads(); dit_pass<3>(X, W, N, 64, tid, NTHR); }
        __syncthreads();
        { cf v[RA];
#pragma unroll
          for (int j = 0; j < RA; ++j) v[j] = X[fpad(tid + 512 * j)];
          dit_regs<LRA>(v, W, N, 512, tid);
#pragma unroll
          for (int j = 0; j < NIN_A; ++j) { u0[tid + 512 * j] = v[j].x; u1[tid + 512 * j] = v[j].y; } }
        __syncthreads();
    }
}
__device__ __forceinline__ void h2_phase(const Frame& F, const float* KT, float* UT) {
    LAS cf* W = (LAS cf*)(F.lds + FFT_W_OFF);
    for (int k = F.tid; k < 4096; k += NTHR) { const float a = (float)k * (1.0f / 4096.0f); W[k] = cf{cospif(a), -sinpif(a)}; }
    __syncthreads();
#pragma unroll 1
    for (int c = F.vcu; c < HW; c += F.G) fft_conv_channel<13>(F, KT + (size_t)c * 8192, UT + (size_t)c * 4 * LP, LP);
    __syncthreads();
    for (int k = F.tid; k < 2048; k += NTHR) { const float a = (float)k * (1.0f / 2048.0f); W[k] = cf{cospif(a), -sinpif(a)}; }
    __syncthreads();
#pragma unroll 1
    for (int c = F.vcu; c < HW; c += F.G) fft_conv_channel<12>(F, KT + (size_t)HW * 8192 + (size_t)c * 4096, UT + (size_t)HW * 4 * LP + (size_t)c * 4 * LS, LS);
    __syncthreads();
}

constexpr int ATT_KROW = 272, ATT_VROW = 648, ATT_BIAS_OFF = 320 * ATT_KROW, ATT_OROW = 272;
#define MFMA32(a, b, c) __builtin_amdgcn_mfma_f32_32x32x16_bf16((a), (b), (c), 0, 0, 0)
__device__ __forceinline__ void attn_phase(const Frame& F, const Args& A, const bf16* QKV, bf16* ATT) {
    const int g4 = F.wave >> 1, sub = F.wave & 1;
    LAS unsigned char* lds = F.lds;
    LAS float* BIAS = (LAS float*)(lds + ATT_BIAS_OFF);
    { const float* rel_bias = A.in[4];
      for (int idx = F.tid; idx < 16 * 257; idx += NTHR) { const int hh = idx / 257, ri = idx - hh * 257, rel = ri - 128, n = rel < 0 ? -rel : rel; int b;
          if (n < 8) b = n; else { int e = 0; while ((64 << (e + 1)) <= n * n) ++e; b = 8 + e; if (b > 15) b = 15; }
          if (rel > 0) b += 16;
          BIAS[hh * 260 + ri] = rel_bias[b * 16 + hh]; } }
    __syncthreads();
#pragma unroll 1
    for (int unit = F.vcu; unit < 1536; unit += F.G) {
        int lane = F.lane; asm volatile("" : "+v"(lane));
        const int r = lane & 31, h = lane >> 5;
        const int kvh = unit & 3, tile = unit >> 2;
        int q0, L, rowbase;
        if (tile < 256) { rowbase = (tile >> 6) * LP; q0 = (tile & 63) * 64; L = LP; } else { const int t2 = tile - 256; rowbase = MP + (t2 >> 5) * LS; q0 = (t2 & 31) * 64; L = LS; }
        const int hq = kvh * 4 + g4;
        { const int rl = lane >> 4, ch = lane & 15;
#pragma unroll
          for (int i = 0; i < 10; ++i) { const int row = (F.wave * 10 + i) * 4 + rl, kp = q0 - 128 + row; v4u v = {0u, 0u, 0u, 0u};
              if (kp >= 0 && kp < L) v = *(const v4u*)(QKV + (size_t)(rowbase + kp) * 3072 + 2048 + kvh * 128 + ch * 8);
              *(LAS v4u*)(lds + row * ATT_KROW + ch * 16) = v; } }
        bf16x8 qf[8];
        { const bf16* qp = QKV + (size_t)(rowbase + q0 + sub * 32 + r) * 3072 + hq * 128 + 8 * h;
#pragma unroll
          for (int s = 0; s < 8; ++s) qf[s] = *(const bf16x8*)(qp + 16 * s); }
        __syncthreads();
        f32x16 sacc[9];
        { const LAS unsigned char* kb = lds + (sub * 32 + r) * ATT_KROW + h * 16;
#pragma unroll
          for (int kt = 0; kt < 9; ++kt) {
#pragma unroll
              for (int e = 0; e < 16; ++e) sacc[kt][e] = 0.f;
#pragma unroll
              for (int s = 0; s < 8; ++s) { const bf16x8 a = *(const LAS bf16x8*)(kb + kt * 32 * ATT_KROW + s * 32); sacc[kt] = MFMA32(a, qf[s], sacc[kt]); }
              __builtin_amdgcn_sched_barrier(0);
          } }
        const float sink = A.in[7][hq];
        float mx = sink;
        { const int qpos = q0 + sub * 32 + r, relb = 4 * h - 128 - r; const LAS float* bh = BIAS + hq * 260 + 128 + relb;
#pragma unroll
          for (int kt = 0; kt < 9; ++kt) {
#pragma unroll
              for (int e = 0; e < 16; ++e) { const int ro = kt * 32 + (e & 3) + 8 * (e >> 2); const int rel = relb + ro; const int kp = qpos + rel;
                  bool ok = kp >= 0 && kp < L; float bv;
                  if (kt == 0) { ok = ok && rel >= -128; bv = bh[ok ? ro : -relb]; }
                  else if (kt == 8) { ok = ok && rel <= 128; bv = bh[ok ? ro : -relb]; }
                  else bv = bh[ro];
                  const float sv = ok ? sacc[kt][e] + bv : -1e30f; sacc[kt][e] = sv; mx = fmaxf(mx, sv); }
              __builtin_amdgcn_sched_barrier(0);
          } }
        mx = fmaxf(mx, shx(mx, 32, lane));
        float sum = 0.f;
        bf16x8 pf[9][2];
#pragma unroll
        for (int kt = 0; kt < 9; ++kt) {
#pragma unroll
            for (int e = 0; e < 16; ++e) { const float p = __builtin_amdgcn_exp2f((sacc[kt][e] - mx) * 1.44269504089f); sacc[kt][e] = p; sum += p; }
#pragma unroll
            for (int s2 = 0; s2 < 2; ++s2) { v4u w;
                w.x = pk2f(sacc[kt][8 * s2 + 0], sacc[kt][8 * s2 + 1]); w.y = pk2f(sacc[kt][8 * s2 + 2], sacc[kt][8 * s2 + 3]);
                w.z = pk2f(sacc[kt][8 * s2 + 4], sacc[kt][8 * s2 + 5]); w.w = pk2f(sacc[kt][8 * s2 + 6], sacc[kt][8 * s2 + 7]);
                pf[kt][s2] = __builtin_bit_cast(bf16x8, w); }
            __builtin_amdgcn_sched_barrier(0);
        }
        sum += shx(sum, 32, lane);
        const float inv = 1.0f / (sum + __builtin_amdgcn_exp2f((sink - mx) * 1.44269504089f));
        v4u vv[10];
#pragma unroll
        for (int i = 0; i < 10; ++i) { const int combo = F.wave * 10 + i, kg = combo % 5, ch = combo / 5, kp = q0 - 128 + kg * 64 + lane; vv[i] = (v4u){0u, 0u, 0u, 0u};
            if (kp >= 0 && kp < L) vv[i] = *(const v4u*)(QKV + (size_t)(rowbase + kp) * 3072 + 2560 + kvh * 128 + ch * 8); }
        __syncthreads();
#pragma unroll
        for (int i = 0; i < 10; ++i) { const int combo = F.wave * 10 + i, kg = combo % 5, ch = combo / 5; LAS bf16* vp = (LAS bf16*)(lds + (ch * 8) * ATT_VROW + (kg * 64 + lane) * 2);
            vp[0 * 324] = (bf16)(vv[i].x & 0xffffu); vp[1 * 324] = (bf16)(vv[i].x >> 16); vp[2 * 324] = (bf16)(vv[i].y & 0xffffu); vp[3 * 324] = (bf16)(vv[i].y >> 16);
            vp[4 * 324] = (bf16)(vv[i].z & 0xffffu); vp[5 * 324] = (bf16)(vv[i].z >> 16); vp[6 * 324] = (bf16)(vv[i].w & 0xffffu); vp[7 * 324] = (bf16)(vv[i].w >> 16); }
        __syncthreads();
        f32x16 oacc[4];
#pragma unroll
        for (int dt = 0; dt < 4; ++dt)
#pragma unroll
            for (int e = 0; e < 16; ++e) oacc[dt][e] = 0.f;
        { const LAS unsigned char* vb0 = lds + r * ATT_VROW + (sub * 32 + 4 * h) * 2;
#pragma unroll
          for (int kt = 0; kt < 9; ++kt)
#pragma unroll
              for (int s2 = 0; s2 < 2; ++s2) {
#pragma unroll
                  for (int dt = 0; dt < 4; ++dt) { const LAS unsigned char* vb = vb0 + dt * 32 * ATT_VROW + (kt * 32 + 16 * s2) * 2;
                      const s16x4 lo = *(const LAS s16x4*)vb, hi = *(const LAS s16x4*)(vb + 16);
                      const bf16x8 bfr = {lo[0], lo[1], lo[2], lo[3], hi[0], hi[1], hi[2], hi[3]};
                      oacc[dt] = MFMA32(pf[kt][s2], bfr, oacc[dt]); }
                  __builtin_amdgcn_sched_barrier(0); } }
        __syncthreads();
        { LAS unsigned char* ob = lds + F.wave * (32 * ATT_OROW);
          LAS bf16* ow = (LAS bf16*)(ob + (4 * h) * ATT_OROW + r * 2);
          float invq[16];
#pragma unroll
          for (int e = 0; e < 16; ++e) invq[e] = __int_as_float(__builtin_amdgcn_ds_bpermute(((e & 3) + 8 * (e >> 2) + 4 * h) << 2, __float_as_int(inv)));
#pragma unroll
          for (int dt = 0; dt < 4; ++dt)
#pragma unroll
              for (int e = 0; e < 16; ++e) ow[((e & 3) + 8 * (e >> 2)) * (ATT_OROW / 2) + dt * 32] = (bf16)(pk2f(oacc[dt][e] * invq[e], 0.f) & 0xffffu);
          LDS_WAIT(); asm volatile("" ::: "memory");
          bf16* op = ATT + (size_t)(rowbase + q0 + sub * 32 + (lane >> 4)) * 2048 + hq * 128 + (lane & 15) * 8;
          const LAS unsigned char* orp = ob + (lane >> 4) * ATT_OROW + (lane & 15) * 16;
#pragma unroll
          for (int i = 0; i < 8; ++i) *(v4u*)(op + (size_t)i * 4 * 2048) = *(const LAS v4u*)(orp + i * 4 * ATT_OROW); }
        __syncthreads();
    }
}

__device__ __forceinline__ void attn_naive(const Frame& F, const Args& A, const bf16* QKV, bf16* ATT) {
    const float* rel_bias = A.in[4]; const int lane = F.lane;
    const int gw = F.vcu * NWAVES + F.wave, NGW = F.G * NWAVES;
#pragma unroll 1
    for (int item = gw; item < M * 16; item += NGW) {
        const int row = item >> 4, hq = item & 15, kvh = hq >> 2;
        int L, rowbase, t;
        if (row < MP) { L = LP; rowbase = row & ~(LP - 1); t = row & (LP - 1); } else { L = LS; const int r2 = row - MP; rowbase = MP + (r2 & ~(LS - 1)); t = r2 & (LS - 1); }
        const bf16* qp = QKV + (size_t)row * 3072 + hq * 128;
        const float q0 = __uint_as_float((unsigned)qp[lane] << 16), q1 = __uint_as_float((unsigned)qp[64 + lane] << 16);
        float m = A.in[7][hq], l = 1.0f, o0 = 0.f, o1 = 0.f;
        const int jlo = t - 128 < 0 ? 0 : t - 128, jhi = t + 128 > L - 1 ? L - 1 : t + 128;
#pragma unroll 1
        for (int j = jlo; j <= jhi; ++j) {
            const bf16* kp = QKV + (size_t)(rowbase + j) * 3072 + 2048 + kvh * 128; const bf16* vp = kp + 512;
            float s = q0 * __uint_as_float((unsigned)kp[lane] << 16) + q1 * __uint_as_float((unsigned)kp[64 + lane] << 16);
#pragma unroll
            for (int o = 1; o < 64; o <<= 1) s += shx(s, o, lane);
            const int rel = j - t, n = rel < 0 ? -rel : rel; int b;
            if (n < 8) b = n; else { int e = 0; while ((64 << (e + 1)) <= n * n) ++e; b = 8 + e; if (b > 15) b = 15; }
            if (rel > 0) b += 16;
            s += rel_bias[b * 16 + hq];
            const float mn = fmaxf(m, s), sc = __expf(m - mn), p = __expf(s - mn);
            l = l * sc + p; o0 = o0 * sc + p * __uint_as_float((unsigned)vp[lane] << 16); o1 = o1 * sc + p * __uint_as_float((unsigned)vp[64 + lane] << 16); m = mn;
        }
        bf16* op = ATT + (size_t)row * 2048 + hq * 128;
        op[lane] = (bf16)(pk2f(o0 / l, 0.f) & 0xffffu); op[64 + lane] = (bf16)(pk2f(o1 / l, 0.f) & 0xffffu);
    }
}

__device__ __forceinline__ void p0_prologue(Frame F, const Args& A, unsigned char* ws, unsigned char* dob) {
    LAS float* scr = (LAS float*)(F.lds + F.wave * 16384);
    const int gw = F.vcu * NWAVES + F.wave, NGW = F.G * NWAVES;
    constexpr int I_IN = (DM / 64) * (NIN / 32), I_AO = (AW / 64) * (DM / 32), I_HO = (HW / 64) * (DM / 32), I_OUT = (DM / 64) * (DM / 32), I_UP = (DM / 64) * (2 * FF / 32), I_DN = (FF / 64) * (DM / 32), I_PG = (DM / 64) * (DM / 32), I_PL = (PLE / 64) * (DM / 32);
    constexpr int NITEMS = I_IN + I_AO + I_HO + I_OUT + I_UP + I_DN + I_PG + I_PL;
    for (int it = gw; it < NITEMS; it += NGW) {
        int r = it;
        if (r < I_IN) { p0_transpose_item(A.in[6], DM, NIN, (bf16*)(ws + WS_WIN), scr, r, F.lane); continue; } r -= I_IN;
        if (r < I_AO) { p0_transpose_item(A.in[19], AW, DM, (bf16*)(ws + WS_WAO), scr, r, F.lane); continue; } r -= I_AO;
        if (r < I_HO) { p0_transpose_item(A.in[20], HW, DM, (bf16*)(ws + WS_WHO), scr, r, F.lane); continue; } r -= I_HO;
        if (r < I_OUT) { p0_transpose_item(A.in[21], DM, DM, (bf16*)(ws + WS_WOUT), scr, r, F.lane); continue; } r -= I_OUT;
        if (r < I_UP) { p0_transpose_item(A.in[23], DM, 2 * FF, (bf16*)(ws + WS_WUP), scr, r, F.lane); continue; } r -= I_UP;
        if (r < I_DN) { p0_transpose_item(A.in[26], FF, DM, (bf16*)(ws + WS_WDN), scr, r, F.lane); continue; } r -= I_DN;
        if (r < I_PG) { p0_transpose_item(A.in[28], DM, DM, (bf16*)(ws + WS_WPG), scr, r, F.lane); continue; } r -= I_PG;
        p0_transpose_item(A.in[29], PLE, DM, (bf16*)(ws + WS_WPL), scr, r, F.lane);
    }
    refresh(F);
    rms_phase_bf16(F, A.in[0], A.in[1], A.in[5], (bf16*)(dob + DO_XN));
    refresh(F);
    { bf16* PB = (bf16*)(ws + WS_PB); const size_t gt = (size_t)F.vcu * NTHR + F.tid, GT_ = (size_t)F.G * NTHR;
      for (size_t i = gt; i < (size_t)M * PLE / 4; i += GT_) { const size_t e = i * 4; const float* src = e < (size_t)MP * PLE ? A.in[2] + e : A.in[3] + (e - (size_t)MP * PLE);
          const f32x4 v = *(const f32x4*)src; *(unsigned long long*)(PB + e) = (unsigned long long)pk2f(v.x, v.y) | ((unsigned long long)pk2f(v.z, v.w) << 32); } }
    __syncthreads();
    refresh(F);
    h0_phase(F, A, (float*)(dob + DO_KT));
}

constexpr int N_PHASES = 16;
#ifndef DIAG_NAIVE_ATTN
#define DIAG_NAIVE_ATTN 0
#endif
__global__ void __launch_bounds__(NTHR, 2) fwd_kernel(Args args) {
    extern __shared__ __attribute__((aligned(16))) unsigned char lds[];
    Frame F;
    F.lds = (LAS unsigned char*)lds;
    volatile LAS unsigned* MISC = (volatile LAS unsigned*)(F.lds + MISC_OFF);
    F.wave = __builtin_amdgcn_readfirstlane((int)threadIdx.x >> 6); refresh(F);
    F.G = gridDim.x; { const int bx = blockIdx.x; F.vcu = (F.G % 8 == 0) ? (bx % 8) * (F.G / 8) + bx / 8 : bx; }
    unsigned char* ws = args.ws; unsigned char* dob = (unsigned char*)args.out;
    for (int u = F.tid; u < (LDS_BYTES - LDSCTL_OFF) / 4; u += NTHR) ((LAS unsigned*)(F.lds + LDSCTL_OFF))[u] = 0u;
    __syncthreads();
    XcdBarrier bar = xcd_barrier_post((unsigned*)(ws + WS_CTL) + CW_BAR, MISC + 8);
    const int lo = args.ph_lo, hi = args.ph_hi;
#ifdef ONLY_PHASE
#define IN(k) ((k) == ONLY_PHASE && lo <= (k))
#else
#define IN(k) (lo <= (k) && (k) < hi)
#endif
#define SEAM(k) do { if (IN(k) && IN((k) + 1)) xcd_barrier(bar); } while (0)
#define REF() refresh(F)
    bf16* const QKV = (bf16*)(ws + WS_QKV); bf16* const HY = (bf16*)(ws + WS_HY); bf16* const GT = (bf16*)(ws + WS_GT);
    bf16* const ATT = (bf16*)(dob + DO_ATT); bf16* const HYO = (bf16*)(ws + WS_HYO); bf16* const TM = (bf16*)(ws + WS_TM);
    bf16* const XN2 = (bf16*)(ws + WS_XN2); bf16* const GU = (bf16*)(ws + WS_GU); bf16* const ACT = (bf16*)(ws + WS_ACT); bf16* const PP = (bf16*)(ws + WS_PP);
    float* const UT = (float*)(dob + DO_UT); float* const KT = (float*)(dob + DO_KT); float* const OUT = args.out;

    if (IN(0)) { REF(); p0_prologue(F, args, ws, dob); } SEAM(0);
    if (IN(1)) { REF(); pg8::Gemm g{(const bf16*)(dob + DO_XN), (const bf16*)(ws + WS_WIN), M, NIN, DM}; pg8::StaticOrder S; S.init(M, NIN, F.G, (int)blockIdx.x);
        pg8::EpiIn E{QKV, HY, GT}; pg8::gemm_phase<pg8::EpiIn, pg8::StaticOrder, true, true>(F.lds, g, S, E, F.tid); } SEAM(1);
    if (IN(2)) { REF(); if (DIAG_NAIVE_ATTN) attn_naive(F, args, QKV, ATT); else attn_phase(F, args, QKV, ATT); __syncthreads(); REF(); h1_phase(F, args, HY, UT); } SEAM(2);
    if (IN(3)) { REF(); h2_phase(F, KT, UT); } SEAM(3);
    if (IN(4)) { REF(); h3_phase(F, args, HY, UT, HYO); } SEAM(4);
    if (IN(5)) { REF();
        { pg8::Gemm g{ATT, (const bf16*)(ws + WS_WAO), M, DM, AW}; pg8::StaticOrder S; S.init(M, DM, F.G, (int)blockIdx.x);
          pg8::EpiGate<0> E{GT, TM}; pg8::gemm_phase<pg8::EpiGate<0>, pg8::StaticOrder, true, true>(F.lds, g, S, E, F.tid); }
        { pg8::Gemm g{HYO, (const bf16*)(ws + WS_WHO), M, DM, HW}; pg8::StaticOrder S; S.init(M, DM, F.G, (int)blockIdx.x);
          pg8::EpiGate<1> E{GT, TM}; pg8::gemm_phase<pg8::EpiGate<1>, pg8::StaticOrder, true, true>(F.lds, g, S, E, F.tid); }
    } SEAM(5);
    if (IN(6)) { REF(); pg8::Gemm g{TM, (const bf16*)(ws + WS_WOUT), M, DM, DM}; pg8::StaticOrder S; S.init(M, DM, F.G, (int)blockIdx.x);
        pg8::EpiRes E{args.in[0], args.in[1], MP, OUT}; pg8::gemm_phase<pg8::EpiRes, pg8::StaticOrder, true, true>(F.lds, g, S, E, F.tid); } SEAM(6);
    if (IN(7)) { REF(); rms_phase_bf16(F, OUT, OUT + (size_t)MP * DM, args.in[22], XN2); } SEAM(7);
    if (IN(8)) { REF(); pg8::Gemm g{XN2, (const bf16*)(ws + WS_WUP), MP, FF, DM}; pg8::StaticOrder S; S.init(MP, FF, F.G, (int)blockIdx.x);
        pg8::EpiStore E{GU, FF}; pg8::gemm_phase<pg8::EpiStore, pg8::StaticOrder, true, true>(F.lds, g, S, E, F.tid); } SEAM(8);
    if (IN(9)) { REF(); pg8::Gemm g{XN2, (const bf16*)(ws + WS_WUP) + (size_t)FF * DM, MP, FF, DM}; pg8::StaticOrder S; S.init(MP, FF, F.G, (int)blockIdx.x);
        pg8::EpiGlu E{GU, ACT, args.in[24], args.in[25], LP}; pg8::gemm_phase<pg8::EpiGlu, pg8::StaticOrder, true, true>(F.lds, g, S, E, F.tid); } SEAM(9);
    if (IN(10)) { REF();
        { pg8::Gemm g{ACT, (const bf16*)(ws + WS_WDN), MP, DM, FF}; pg8::StaticOrder S; S.init(MP, DM, F.G, (int)blockIdx.x);
          pg8::EpiRes E{OUT, OUT, 1 << 30, OUT}; pg8::gemm_phase<pg8::EpiRes, pg8::StaticOrder, true, true>(F.lds, g, S, E, F.tid); }
        { pg8::Gemm g{XN2 + (size_t)MP * DM, (const bf16*)(ws + WS_WUP), MS, FF, DM}; pg8::StaticOrder S; S.init(MS, FF, F.G, (int)blockIdx.x);
          pg8::EpiStore E{GU, FF}; pg8::gemm_phase<pg8::EpiStore, pg8::StaticOrder, true, true>(F.lds, g, S, E, F.tid); }
    } SEAM(10);
    if (IN(11)) { REF(); pg8::Gemm g{XN2 + (size_t)MP * DM, (const bf16*)(ws + WS_WUP) + (size_t)FF * DM, MS, FF, DM}; pg8::StaticOrder S; S.init(MS, FF, F.G, (int)blockIdx.x);
        pg8::EpiGlu E{GU, ACT, args.in[24], args.in[25], LS}; pg8::gemm_phase<pg8::EpiGlu, pg8::StaticOrder, true, true>(F.lds, g, S, E, F.tid); } SEAM(11);
    if (IN(12)) { REF(); pg8::Gemm g{ACT, (const bf16*)(ws + WS_WDN), MS, DM, FF}; pg8::StaticOrder S; S.init(MS, DM, F.G, (int)blockIdx.x);
        float* o2 = OUT + (size_t)MP * DM; pg8::EpiRes E{o2, o2, 1 << 30, o2}; pg8::gemm_phase<pg8::EpiRes, pg8::StaticOrder, true, true>(F.lds, g, S, E, F.tid); } SEAM(12);
    if (IN(13)) { REF(); rms_phase_bf16(F, OUT, OUT + (size_t)MP * DM, args.in[27], XN2); } SEAM(13);
    if (IN(14)) { REF();
        { pg8::Gemm g{(const bf16*)(ws + WS_PB), (const bf16*)(ws + WS_WPL), M, DM, PLE}; pg8::StaticOrder S; S.init(M, DM, F.G, (int)blockIdx.x);
          pg8::EpiPP E{PP}; pg8::gemm_phase<pg8::EpiPP, pg8::StaticOrder, true, true>(F.lds, g, S, E, F.tid); }
        { pg8::Gemm g{XN2, (const bf16*)(ws + WS_WPG), M, DM, DM}; pg8::StaticOrder S; S.init(M, DM, F.G, (int)blockIdx.x);
          pg8::EpiPle E{PP, OUT}; pg8::gemm_phase<pg8::EpiPle, pg8::StaticOrder, true, true>(F.lds, g, S, E, F.tid); }
    } SEAM(14);
    if (IN(15)) { REF(); const int gw = F.vcu * NWAVES + F.wave, NGW = F.G * NWAVES;
        for (int m = gw; m < M; m += NGW) rms_row<false>(OUT + (size_t)m * DM, args.in[30], OUT + (size_t)m * DM, F.lane); }
#undef IN
#undef SEAM
#undef REF
}

#ifndef MK_PER_PHASE
#define MK_PER_PHASE 0
#endif
extern "C" void kernel_launch(void* const* d_in, const int* in_sizes, int n_in, void* d_out, int out_size, void* d_ws, size_t ws_size, hipStream_t stream) {
    static int grid = 0;
    if (grid == 0) {
        if (n_in != 31 || out_size != M * DM || ws_size < WS_END) { fprintf(stderr, "kernel_launch: unexpected shapes (n_in %d out %d ws %zu)\n", n_in, out_size, ws_size); grid = -1; return; }
        int dev = 0, cus = 0, per_cu = 0;
        if (hipGetDevice(&dev) != hipSuccess || hipDeviceGetAttribute(&cus, hipDeviceAttributeMultiprocessorCount, dev) != hipSuccess) { grid = -1; return; }
        if (hipFuncSetAttribute((const void*)fwd_kernel, hipFuncAttributeMaxDynamicSharedMemorySize, LDS_BYTES) != hipSuccess) { fprintf(stderr, "kernel_launch: hipFuncSetAttribute failed\n"); grid = -1; return; }
        if (hipOccupancyMaxActiveBlocksPerMultiprocessor(&per_cu, (const void*)fwd_kernel, NTHR, LDS_BYTES) != hipSuccess || per_cu < 1) fprintf(stderr, "kernel_launch: occupancy query reports %d\n", per_cu);
        (void)hipGetLastError();
        grid = cus;
    }
    if (grid < 0) return;
    if (hipMemsetAsync((char*)d_ws + WS_CTL, 0, CTL_ZERO_BYTES, stream) != hipSuccess) return;
    Args a{};
    for (int i = 0; i < 31; ++i) a.in[i] = (const float*)d_in[i];
    a.out = (float*)d_out; a.ws = (unsigned char*)d_ws;
#if MK_PER_PHASE
    for (int p = 0; p < N_PHASES; ++p) { a.ph_lo = p; a.ph_hi = p + 1; hipLaunchKernelGGL(fwd_kernel, dim3(grid), dim3(NTHR), LDS_BYTES, stream, a); }
#else
    a.ph_lo = 0; a.ph_hi = N_PHASES;
    hipLaunchKernelGGL(fwd_kernel, dim3(grid), dim3(NTHR), LDS_BYTES, stream, a);
#endif
}
```

```cpp
#include <hip/hip_runtime.h>
#include <cstdio>
#include <cstdint>
namespace pg8 {
#define PG8_LAS __attribute__((address_space(3)))
typedef unsigned short bf16_t;
typedef short bf16x8 __attribute__((ext_vector_type(8)));
typedef float f32x4 __attribute__((ext_vector_type(4)));
typedef unsigned u32x4 __attribute__((ext_vector_type(4)));
constexpr int BM = 256, BK = 64, HALF = 128, HTB = HALF * BK * 2  , STAGE_BYTES = 8 * HTB, NXCD = 8, WGM = 4;

__host__ __device__ __forceinline__ int lds_byte(int r, int c) { const int st = (r >> 4) * 2 + (c >> 5), rr = r & 15, cc = c & 31, ob = rr * 64 + cc * 2; return st * 1024 + (ob ^ (((ob >> 9) & 1) << 5)); }
__host__ __device__ __forceinline__ void stage_rc(int b, int& R, int& C) { const int st = b / 1024, sb = b % 1024, swz = sb ^ (((sb >> 9) & 1) << 5); R = (st >> 1) * 16 + swz / 64; C = (st & 1) * 32 + (swz % 64) / 2; }
__host__ __device__ __forceinline__ int perm32(int rho) { const int n = rho >> 4, i = rho & 15; return 8 * (i >> 2) + 4 * n + (i & 3); }

struct Unit { int pm, pn; };
struct Gemm { const bf16_t* A; const bf16_t* Bt; int M, N, K; };

struct StaticOrder {
    int nM, nN, nwg, G, c;
    __host__ __device__ void init(int M, int N, int G_, int c_) { nM = M / BM; nN = N / BM; nwg = nM * nN; G = G_; c = c_; }
    __host__ __device__ bool next(int i, Unit& u) const {
        const long L = (long)i * G + c; if (L >= nwg) return false;
        unit_of(L, u); return true;
    }
    __host__ __device__ void unit_of(long L, Unit& u) const {
        int wgid = (int)L; { const int q = nwg / NXCD, r = nwg % NXCD, xcd = wgid % NXCD, off = wgid / NXCD; wgid = (xcd < r ? xcd * (q + 1) : r * (q + 1) + (xcd - r) * q) + off; }
        const int nig = WGM * nN, gid = wgid / nig, fm = gid * WGM, gsz = (nM - fm) < WGM ? (nM - fm) : WGM;
        u.pm = fm + ((wgid % nig) % gsz); u.pn = (wgid % nig) / gsz;
    }
    __device__ __forceinline__ void a_ready(const Unit&) const {}
    __device__ __forceinline__ void done(const Unit&) const {}
};
struct RangeOrder : StaticOrder {
    int L0, L1, c0, nb;
    __host__ __device__ bool next(int i, Unit& u) const { const int k = (c - c0 + G) % G; if (k >= nb) return false; const long L = (long)L0 + k + (long)i * nb; if (L >= L1) return false; unit_of(L, u); return true; }
};
__device__ __forceinline__ unsigned cvt_pk_bf16(float lo, float hi) { unsigned r; asm volatile("v_cvt_pk_bf16_f32 %0, %1, %2" : "=v"(r) : "v"(lo), "v"(hi)); return r; }
typedef float f32x2 __attribute__((ext_vector_type(2)));
__device__ __forceinline__ f32x2 gelu_pk(f32x2 v) {
    typedef unsigned u2_ __attribute__((ext_vector_type(2)));
    const f32x2 na = __builtin_bit_cast(f32x2, __builtin_bit_cast(u2_, v) | 0x80000000u);
    f32x2 p = na * 5.6212998061e-06f + (-5.1055209042e-05f); p = p * na + 3.9686136006e-05f; p = p * na + (-3.4227392171e-03f); p = p * na + 2.2076997906e-02f; p = p * na + (-5.2075162530e-02f); p = p * na + 1.0442737341f;
    p = p * p; p = p * p; p = p * p; p = p * p;
    f32x2 h; h.x = __builtin_amdgcn_rcpf(p.x); h.y = __builtin_amdgcn_rcpf(p.y);
    f32x2 rl; rl.x = fmaxf(v.x, 0.f); rl.y = fmaxf(v.y, 0.f);
    return __builtin_elementwise_fma(na, h, rl);
}
typedef unsigned u32x2 __attribute__((ext_vector_type(2)));
__device__ __forceinline__ unsigned pk2f(float lo, float hi) { typedef float f2_ __attribute__((ext_vector_type(2))); typedef __bf16 b2_ __attribute__((ext_vector_type(2))); return __builtin_bit_cast(unsigned, __builtin_convertvector((f2_){lo, hi}, b2_)); }
__device__ __forceinline__ float bflo(unsigned u) { return __uint_as_float(u << 16); }
__device__ __forceinline__ float bfhi(unsigned u) { return __uint_as_float(u & 0xffff0000u); }
__device__ __forceinline__ float sg2(float y) { return __builtin_amdgcn_rcpf(1.0f + __builtin_amdgcn_exp2f(y)); }
__device__ __forceinline__ float sigm(float x) { return __builtin_amdgcn_rcpf(1.0f + __builtin_amdgcn_exp2f(-1.44269504089f * x)); }
__device__ __forceinline__ u32x4 pack8(const f32x4 v0, const f32x4 v1) { u32x4 w; w.x = pk2f(v0[0], v0[1]); w.y = pk2f(v0[2], v0[3]); w.z = pk2f(v1[0], v1[1]); w.w = pk2f(v1[2], v1[3]); return w; }

struct EpiIn {
    static constexpr bool PERM = true, AFTER_DRAIN = false;
    bf16_t *QKV, *HY, *GT;
    __device__ __forceinline__ void operator()(const f32x4 (&acc)[2][2][4][2], const Unit& u, int wr, int wc, int fr, int fq) const {
        const int row0 = u.pm * BM + wr * 64 + fr; bf16_t* base; int ldc, colt; bool sg = false;
        if (u.pn < 12) { base = QKV; ldc = 3072; colt = u.pn * 256; }
        else if (u.pn < 36) { base = HY; ldc = 6144; colt = (u.pn - 12) * 256; }
        else { base = GT; ldc = 8192; colt = (u.pn - 36) * 256; sg = true; }
        const int col0 = colt + wc * 32 + 8 * fq;
#pragma unroll
        for (int ai = 0; ai < 2; ++ai)
#pragma unroll
            for (int m = 0; m < 4; ++m) { bf16_t* rowp = base + (size_t)(row0 + ai * HALF + m * 16) * ldc + col0;
#pragma unroll
                for (int bj = 0; bj < 2; ++bj) { f32x4 v0 = acc[ai][bj][m][0], v1 = acc[ai][bj][m][1];
                    if (sg) {
#pragma unroll
                        for (int j = 0; j < 4; ++j) { v0[j] = __builtin_amdgcn_rcpf(1.0f + __builtin_amdgcn_exp2f(v0[j])); v1[j] = __builtin_amdgcn_rcpf(1.0f + __builtin_amdgcn_exp2f(v1[j])); } }

                    if (sg) __builtin_nontemporal_store(pack8(v0, v1), (u32x4*)(rowp + bj * HALF));
                    else *(u32x4*)(rowp + bj * HALF) = pack8(v0, v1); } }
    }
};
__device__ __forceinline__ float row_rstd(const float* ss, int r) { return __builtin_amdgcn_rsqf(ss[r] * (1.0f / 4096.0f) + 1e-6f); }
struct EpiStore {
    static constexpr bool PERM = true, AFTER_DRAIN = false;
    bf16_t* O; int ldc; const float* ss;
    __device__ __forceinline__ void operator()(const f32x4 (&acc)[2][2][4][2], const Unit& u, int wr, int wc, int fr, int fq) const {
        const int row0 = u.pm * BM + wr * 64 + fr, col0 = u.pn * BM + wc * 32 + 8 * fq;
#pragma unroll
        for (int ai = 0; ai < 2; ++ai)
#pragma unroll
            for (int m = 0; m < 4; ++m) { const int r = row0 + ai * HALF + m * 16; const float rr = row_rstd(ss, r); bf16_t* rowp = O + (size_t)r * ldc + col0;
#pragma unroll
                for (int bj = 0; bj < 2; ++bj) *(u32x4*)(rowp + bj * HALF) = pack8(acc[ai][bj][m][0] * rr, acc[ai][bj][m][1] * rr); }
    }
};
template <int MODE> struct EpiGate {
    static constexpr bool PERM = true, AFTER_DRAIN = false;
    const bf16_t* GT; bf16_t* TM;
    __device__ __forceinline__ void operator()(const f32x4 (&acc)[2][2][4][2], const Unit& u, int wr, int wc, int fr, int fq) const {
        const int row0 = u.pm * BM + wr * 64 + fr, col0 = u.pn * BM + wc * 32 + 8 * fq;
        u32x4 gq[2][4][2], tq[4][2];
        if (MODE == 0) {
#pragma unroll
            for (int ai = 0; ai < 2; ++ai)
#pragma unroll
                for (int m = 0; m < 4; ++m) { const size_t r = (size_t)(row0 + ai * HALF + m * 16); const bf16_t* gp = GT + r * 8192 + col0;
#pragma unroll
                    for (int bj = 0; bj < 2; ++bj) gq[ai][m][bj] = *(const u32x4*)(gp + bj * HALF); } }
#pragma unroll
        for (int ai = 0; ai < 2; ++ai) {
            if (MODE == 1) {
#pragma unroll
                for (int m = 0; m < 4; ++m) { const size_t r = (size_t)(row0 + ai * HALF + m * 16); const bf16_t* gp = GT + r * 8192 + 4096 + col0; const bf16_t* tp = TM + r * 4096 + col0;
#pragma unroll
                    for (int bj = 0; bj < 2; ++bj) { gq[ai][m][bj] = *(const u32x4*)(gp + bj * HALF); tq[m][bj] = *(const u32x4*)(tp + bj * HALF); } } }
#pragma unroll
            for (int m = 0; m < 4; ++m) { const size_t r = (size_t)(row0 + ai * HALF + m * 16); bf16_t* tp = TM + r * 4096 + col0;
#pragma unroll
                for (int bj = 0; bj < 2; ++bj) { const u32x4 g = gq[ai][m][bj]; f32x4 v0 = acc[ai][bj][m][0], v1 = acc[ai][bj][m][1];
                    v0[0] *= bflo(g.x); v0[1] *= bfhi(g.x); v0[2] *= bflo(g.y); v0[3] *= bfhi(g.y); v1[0] *= bflo(g.z); v1[1] *= bfhi(g.z); v1[2] *= bflo(g.w); v1[3] *= bfhi(g.w);
                    if (MODE == 1) { const u32x4 t = tq[m][bj];
                        v0[0] += bflo(t.x); v0[1] += bfhi(t.x); v0[2] += bflo(t.y); v0[3] += bfhi(t.y); v1[0] += bflo(t.z); v1[1] += bfhi(t.z); v1[2] += bflo(t.w); v1[3] += bfhi(t.w); }
                    *(u32x4*)(tp + bj * HALF) = pack8(v0, v1); } }
            asm volatile("" ::: "memory"); }
    }
};
struct EpiRes {
    static constexpr bool PERM = false, AFTER_DRAIN = false;
    const float* b0; const float* b1; int split; bf16_t* XB; float* ss;
    __device__ __forceinline__ void operator()(const f32x4 (&acc)[2][2][4][2], const Unit& u, int wr, int wc, int fr, int fq) const {
        const int row0 = u.pm * BM + wr * 64 + fr, col0 = u.pn * BM + wc * 32 + 4 * fq, lane = fq * 16 + fr;
#pragma unroll
        for (int ai = 0; ai < 2; ++ai) {
        f32x4 bv[2][4][2][2];
#pragma unroll
            for (int m = 0; m < 4; ++m) { const int r = row0 + ai * HALF + m * 16; const float* bp = (r < split ? b0 + (size_t)r * 4096 : b1 + (size_t)(r - split) * 4096) + col0;
#pragma unroll
                for (int bj = 0; bj < 2; ++bj)
#pragma unroll
                    for (int n = 0; n < 2; ++n) bv[ai][m][bj][n] = *(const f32x4*)(bp + bj * HALF + n * 16); }
#pragma unroll
            for (int m = 0; m < 4; ++m) { const int r = row0 + ai * HALF + m * 16; bf16_t* xp = XB + (size_t)r * 4096 + col0;
                float s = 0.f;
#pragma unroll
                for (int bj = 0; bj < 2; ++bj)
#pragma unroll
                    for (int n = 0; n < 2; ++n) { const f32x4 v = bv[ai][m][bj][n] + acc[ai][bj][m][n];
                        s += (v[0] * v[0] + v[1] * v[1]) + (v[2] * v[2] + v[3] * v[3]);
                        u32x2 w; w.x = pk2f(v[0], v[1]); w.y = pk2f(v[2], v[3]); *(u32x2*)(xp + bj * HALF + n * 16) = w; }
                s += __int_as_float(__builtin_amdgcn_ds_bpermute((lane ^ 16) << 2, __float_as_int(s)));
                s += __int_as_float(__builtin_amdgcn_ds_bpermute((lane ^ 32) << 2, __float_as_int(s)));
                if (fq == 0) (void)__hip_atomic_fetch_add(ss + r, s, __ATOMIC_RELAXED, __HIP_MEMORY_SCOPE_AGENT);
                }
            asm volatile("" ::: "memory"); }
    }
};
struct EpiResB {
    static constexpr bool PERM = false, AFTER_DRAIN = false;
    bf16_t* XB; float* ss;
    __device__ __forceinline__ void operator()(const f32x4 (&acc)[2][2][4][2], const Unit& u, int wr, int wc, int fr, int fq) const {
        const int row0 = u.pm * BM + wr * 64 + fr, col0 = u.pn * BM + wc * 32 + 4 * fq, lane = fq * 16 + fr;
        u32x2 bv[2][4][2][2];
#pragma unroll
        for (int ai = 0; ai < 2; ++ai)
#pragma unroll
            for (int m = 0; m < 4; ++m) { const bf16_t* bp = XB + (size_t)(row0 + ai * HALF + m * 16) * 4096 + col0;
#pragma unroll
                for (int bj = 0; bj < 2; ++bj)
#pragma unroll
                    for (int n = 0; n < 2; ++n) bv[ai][m][bj][n] = *(const u32x2*)(bp + bj * HALF + n * 16); }
#pragma unroll
        for (int ai = 0; ai < 2; ++ai)
#pragma unroll
            for (int m = 0; m < 4; ++m) { const int r = row0 + ai * HALF + m * 16; bf16_t* xp = XB + (size_t)r * 4096 + col0;
                float s = 0.f;
#pragma unroll
                for (int bj = 0; bj < 2; ++bj)
#pragma unroll
                    for (int n = 0; n < 2; ++n) { const u32x2 b = bv[ai][m][bj][n]; f32x4 v = acc[ai][bj][m][n];
                        v[0] += bflo(b.x); v[1] += bfhi(b.x); v[2] += bflo(b.y); v[3] += bfhi(b.y);
                        s += (v[0] * v[0] + v[1] * v[1]) + (v[2] * v[2] + v[3] * v[3]);
                        u32x2 w; w.x = pk2f(v[0], v[1]); w.y = pk2f(v[2], v[3]); *(u32x2*)(xp + bj * HALF + n * 16) = w; }
                s += __int_as_float(__builtin_amdgcn_ds_bpermute((lane ^ 16) << 2, __float_as_int(s)));
                s += __int_as_float(__builtin_amdgcn_ds_bpermute((lane ^ 32) << 2, __float_as_int(s)));
                if (fq == 0) (void)__hip_atomic_fetch_add(ss + r, s, __ATOMIC_RELAXED, __HIP_MEMORY_SCOPE_AGENT); }
    }
};
struct EpiGlu {
    static constexpr bool PERM = true, AFTER_DRAIN = false;
    const bf16_t* GU; bf16_t* ACT; const float* cw; const float* cb; int L; const float* ss;
    __device__ __forceinline__ void operator()(const f32x4 (&acc)[2][2][4][2], const Unit& u, int wr, int wc, int fr, int fq) const {
        const int row0 = u.pm * BM + wr * 64 + fr;
        float rr[2][4];
#pragma unroll
        for (int ai = 0; ai < 2; ++ai)
#pragma unroll
            for (int m = 0; m < 4; ++m) rr[ai][m] = row_rstd(ss, row0 + ai * HALF + m * 16);
        const u32x4 z4 = {0u, 0u, 0u, 0u};
        auto gaddr = [&](int b) __attribute__((always_inline)) -> const bf16_t* { const int bj = b >> 1, ai = b & 1; return GU + (size_t)(row0 + ai * HALF) * 11008 + (u.pn * BM + bj * HALF + wc * 32 + 8 * fq); };
        auto ld_hu = [&](int b) __attribute__((always_inline)) -> u32x4 { const int rA = row0 + (b & 1) * HALF; u32x4 h = z4; if (fr == 0 && (rA & (L - 1)) > 0) h = *(const u32x4*)(gaddr(b) - 11008); return h; };
        auto ld_hd = [&](int b) __attribute__((always_inline)) -> u32x4 { const int rA = row0 + (b & 1) * HALF; u32x4 h = z4; if (fr == 15 && ((rA + 48) & (L - 1)) < L - 1) h = *(const u32x4*)(gaddr(b) + (size_t)49 * 11008); return h; };
        u32x4 gq[4], hu, hd;
#pragma unroll
        for (int m = 0; m < 4; ++m) gq[m] = *(const u32x4*)(gaddr(0) + (size_t)(m * 16) * 11008);
        hu = ld_hu(0); hd = ld_hd(0);
        f32x4 w0[2], w1[2], w2[2], bb[2];
#pragma unroll
        for (int b = 0; b < 4; ++b) { const int bj = b >> 1, ai = b & 1, c0 = u.pn * BM + bj * HALF + wc * 32 + 8 * fq, rA = row0 + ai * HALF;
            if (ai == 0) {
#pragma unroll
                for (int n = 0; n < 2; ++n) { w0[n] = *(const f32x4*)(cw + c0 + 4 * n); w1[n] = *(const f32x4*)(cw + 11008 + c0 + 4 * n); w2[n] = *(const f32x4*)(cw + 22016 + c0 + 4 * n); bb[n] = *(const f32x4*)(cb + c0 + 4 * n); } }
#pragma unroll
            for (int m = 0; m < 4; ++m) { const int r = rA + m * 16;
                const u32x4 gc = gq[m]; u32x4 gm, gn;
#pragma unroll
                for (int q = 0; q < 4; ++q) {
                    const int au = m > 0 ? __builtin_amdgcn_update_dpp(0, (int)gq[m > 0 ? m - 1 : 0][q], 0x121, 0xf, 0xf, false) : (int)hu[q];
                    const int ad = m < 3 ? __builtin_amdgcn_update_dpp(0, (int)gq[m < 3 ? m + 1 : 3][q], 0x12f, 0xf, 0xf, false) : (int)hd[q];
                    gm[q] = (unsigned)__builtin_amdgcn_update_dpp(au, (int)gc[q], 0x111, 0xf, 0xf, false);
                    gn[q] = (unsigned)__builtin_amdgcn_update_dpp(ad, (int)gc[q], 0x101, 0xf, 0xf, false); }
                if (b < 3) {
                    if (m == 0) hu = ld_hu(b + 1);
                    if (m == 2) { gq[0] = *(const u32x4*)gaddr(b + 1); gq[1] = *(const u32x4*)(gaddr(b + 1) + (size_t)16 * 11008); }
                    if (m == 3) { gq[2] = *(const u32x4*)(gaddr(b + 1) + (size_t)32 * 11008); gq[3] = *(const u32x4*)(gaddr(b + 1) + (size_t)48 * 11008); hd = ld_hd(b + 1); } }
                f32x4 xm[2], xc[2], xn[2];
                xm[0] = (f32x4){bflo(gm.x), bfhi(gm.x), bflo(gm.y), bfhi(gm.y)}; xm[1] = (f32x4){bflo(gm.z), bfhi(gm.z), bflo(gm.w), bfhi(gm.w)};
                xc[0] = (f32x4){bflo(gc.x), bfhi(gc.x), bflo(gc.y), bfhi(gc.y)}; xc[1] = (f32x4){bflo(gc.z), bfhi(gc.z), bflo(gc.w), bfhi(gc.w)};
                xn[0] = (f32x4){bflo(gn.x), bfhi(gn.x), bflo(gn.y), bfhi(gn.y)}; xn[1] = (f32x4){bflo(gn.z), bfhi(gn.z), bflo(gn.w), bfhi(gn.w)};
                f32x4 o[2];
#pragma unroll
                for (int n = 0; n < 2; ++n) { const f32x4 pre = w0[n] * xm[n] + w1[n] * xc[n] + w2[n] * xn[n] + bb[n];
                    const f32x2 ga = gelu_pk((f32x2){pre[0], pre[1]}), gb = gelu_pk((f32x2){pre[2], pre[3]});
                    o[n] = (f32x4){ga.x, ga.y, gb.x, gb.y} * (acc[ai][bj][m][n] * rr[ai][m]); }
                *(u32x4*)(ACT + (size_t)r * 11008 + c0) = pack8(o[0], o[1]);
                asm volatile("" ::: "memory"); } }
    }
};
struct EpiPP {
    static constexpr bool PERM = false, AFTER_DRAIN = false;
    bf16_t* PP;
    __device__ __forceinline__ void operator()(const f32x4 (&acc)[2][2][4][2], const Unit& u, int wr, int wc, int fr, int fq) const {
        const int row0 = u.pm * BM + wr * 64 + fr, col0 = u.pn * BM + wc * 32 + 4 * fq;
#pragma unroll
        for (int ai = 0; ai < 2; ++ai)
#pragma unroll
            for (int m = 0; m < 4; ++m) { bf16_t* pp = PP + (size_t)(row0 + ai * HALF + m * 16) * 4096 + col0;
#pragma unroll
                for (int bj = 0; bj < 2; ++bj)
#pragma unroll
                    for (int n = 0; n < 2; ++n) { const f32x4 v = acc[ai][bj][m][n]; u32x2 w; w.x = pk2f(v[0], v[1]); w.y = pk2f(v[2], v[3]); *(u32x2*)(pp + bj * HALF + n * 16) = w; } }
    }
};
struct EpiPle {
    static constexpr bool PERM = false, AFTER_DRAIN = false;
    const bf16_t* PP; const bf16_t* XB; bf16_t* X3; const float* ss; float* ss3;
    __device__ __forceinline__ void operator()(const f32x4 (&acc)[2][2][4][2], const Unit& u, int wr, int wc, int fr, int fq) const {
        const int row0 = u.pm * BM + wr * 64 + fr, col0 = u.pn * BM + wc * 32 + 4 * fq, lane = fq * 16 + fr;
#pragma unroll
        for (int ai = 0; ai < 2; ++ai) {
            u32x2 pq[4][2][2], xq[4][2][2]; float rq[4];
#pragma unroll
            for (int m = 0; m < 4; ++m) { const size_t ro = (size_t)(row0 + ai * HALF + m * 16) * 4096 + col0; rq[m] = row_rstd(ss, row0 + ai * HALF + m * 16) * -1.44269504089f;
#pragma unroll
                for (int bj = 0; bj < 2; ++bj)
#pragma unroll
                    for (int n = 0; n < 2; ++n) { pq[m][bj][n] = *(const u32x2*)(PP + ro + bj * HALF + n * 16); xq[m][bj][n] = *(const u32x2*)(XB + ro + bj * HALF + n * 16); } }
#pragma unroll
            for (int m = 0; m < 4; ++m) { const int r = row0 + ai * HALF + m * 16; const size_t ro = (size_t)r * 4096 + col0; float s = 0.f;
#pragma unroll
                for (int bj = 0; bj < 2; ++bj)
#pragma unroll
                    for (int n = 0; n < 2; ++n) { const f32x4 v = acc[ai][bj][m][n] * rq[m]; const u32x2 p = pq[m][bj][n], xb = xq[m][bj][n]; f32x4 x;
                        x[0] = bflo(xb.x) + sg2(v[0]) * bflo(p.x); x[1] = bfhi(xb.x) + sg2(v[1]) * bfhi(p.x); x[2] = bflo(xb.y) + sg2(v[2]) * bflo(p.y); x[3] = bfhi(xb.y) + sg2(v[3]) * bfhi(p.y);
                        s += (x[0] * x[0] + x[1] * x[1]) + (x[2] * x[2] + x[3] * x[3]);
                        u32x2 w; w.x = pk2f(x[0], x[1]); w.y = pk2f(x[2], x[3]); *(u32x2*)(X3 + ro + bj * HALF + n * 16) = w; }
                s += __int_as_float(__builtin_amdgcn_ds_bpermute((lane ^ 16) << 2, __float_as_int(s)));
                s += __int_as_float(__builtin_amdgcn_ds_bpermute((lane ^ 32) << 2, __float_as_int(s)));
                if (fq == 0) (void)__hip_atomic_fetch_add(ss3 + r, s, __ATOMIC_RELAXED, __HIP_MEMORY_SCOPE_AGENT); }
            asm volatile("" ::: "memory"); }
    }
};
template <class Epi, class Sched, bool ALIGN_EPI = false, bool SP2 = false>
__device__ __forceinline__ void gemm_phase(PG8_LAS unsigned char* lds, const Gemm g, const Sched& S, const Epi& E, int tid_in, float* probe = nullptr, unsigned* dynq = nullptr, volatile PG8_LAS unsigned* dslot = nullptr) {
    int tid_ = tid_in; asm volatile("" : "+v"(tid_));
    const int tid = tid_, wid = __builtin_amdgcn_readfirstlane(tid >> 6), lane = tid & 63, wr = wid >> 2, wc = wid & 3, fr = lane & 15, fq = lane >> 4;
    const int K = g.K, nt = K / BK;
    unsigned voffA[2], voffB[2];
#pragma unroll
    for (int i = 0; i < 2; ++i) { int R, C; stage_rc(tid * 16 + i * 8192, R, C); const int Rb = Epi::PERM ? ((R & ~31) + perm32(R & 31)) : R;
        voffA[i] = (unsigned)(R * K + C) * 2u; voffB[i] = (unsigned)(Rb * K + C) * 2u; }
    const size_t kstep = (size_t)(BK * 2);
    const size_t hstep = (size_t)HALF * K * 2;
    const size_t tstep = 2 * hstep;
    const unsigned ldsw = (unsigned)wid * 1024u;
    const int aoff = lds_byte(wr * 64 + fr, fq * 8), boff = lds_byte(wc * 32 + fr, fq * 8);
#define PG8_SA(b, h) (((b) * 2 + (h)) * HTB)
#define PG8_SB(b, h) ((4 + (b) * 2 + (h)) * HTB)
#define PG8_STAGE(bufoff, gbase, voff) do { _Pragma("unroll") for (int _i = 0; _i < 2; ++_i) \
        __builtin_amdgcn_global_load_lds((const unsigned*)((const char*)(gbase) + (voff)[_i]), (PG8_LAS unsigned*)(lds + (bufoff) + ldsw + _i * 8192), 16, 0, 0); } while (0)
#define PG8_LDA(dst, b, h) do { _Pragma("unroll") for (int m = 0; m < 4; ++m) _Pragma("unroll") for (int k = 0; k < 2; ++k) dst[m][k] = *(const PG8_LAS bf16x8*)(lds + PG8_SA(b, h) + aoff + m * 2048 + k * 1024); } while (0)
#define PG8_LDB(dst, b, h) do { _Pragma("unroll") for (int n = 0; n < 2; ++n) _Pragma("unroll") for (int k = 0; k < 2; ++k) dst[n][k] = *(const PG8_LAS bf16x8*)(lds + PG8_SB(b, h) + boff + n * 2048 + k * 1024); } while (0)
#define PG8_MMA(ai, bj, At, Bt) do { __builtin_amdgcn_s_setprio(1); _Pragma("unroll") for (int m = 0; m < 4; ++m) _Pragma("unroll") for (int n = 0; n < 2; ++n) _Pragma("unroll") for (int k = 0; k < 2; ++k) \
        acc[ai][bj][m][n] = __builtin_amdgcn_mfma_f32_16x16x32_bf16(Bt[n][k], At[m][k], acc[ai][bj][m][n], 0, 0, 0); __builtin_amdgcn_s_setprio(0); } while (0)
#define PG8_WAIT_V(n) asm volatile("s_waitcnt vmcnt(" #n ")" ::: "memory")
#define PG8_WAIT_L(n) asm volatile("s_waitcnt lgkmcnt(" #n ")" ::: "memory")
#define PG8_BAR __builtin_amdgcn_s_barrier()
#define PG8_SCHED __builtin_amdgcn_sched_barrier(0)
    Unit cur, nxt; int ui = 0;
    if (!S.next(0, cur)) return;
    f32x4 acc[2][2][4][2];
#pragma unroll
    for (int a = 0; a < 2; ++a)
#pragma unroll
        for (int b = 0; b < 2; ++b)
#pragma unroll
            for (int m = 0; m < 4; ++m)
#pragma unroll
                for (int n = 0; n < 2; ++n) acc[a][b][m][n] = (f32x4){0.f, 0.f, 0.f, 0.f};
    bf16x8 At[4][2], B0[2][2], B1[2][2];
    const char* cA = (const char*)g.A + (size_t)cur.pm * tstep; const char* cB = (const char*)g.Bt + (size_t)cur.pn * tstep;
    S.a_ready(cur);
    if constexpr (SP2) {
        PG8_STAGE(PG8_SB(0, 0), cB, voffB); PG8_STAGE(PG8_SB(0, 1), cB + hstep, voffB); PG8_STAGE(PG8_SA(0, 0), cA, voffA); PG8_STAGE(PG8_SA(0, 1), cA + hstep, voffA);
        if (wr == 1) PG8_BAR;
        PG8_WAIT_V(2); PG8_BAR;
        PG8_STAGE(PG8_SB(1, 0), cB + kstep, voffB); PG8_STAGE(PG8_SA(1, 0), cA + kstep, voffA); PG8_STAGE(PG8_SB(1, 1), cB + hstep + kstep, voffB);
        PG8_WAIT_V(6); PG8_BAR;
    } else {
        PG8_STAGE(PG8_SB(0, 0), cB, voffB); PG8_STAGE(PG8_SA(0, 0), cA, voffA); PG8_STAGE(PG8_SB(0, 1), cB + hstep, voffB); PG8_STAGE(PG8_SA(0, 1), cA + hstep, voffA);
        if (wr == 1) PG8_BAR;
        PG8_WAIT_V(4); PG8_BAR;
        PG8_STAGE(PG8_SB(1, 0), cB + kstep, voffB); PG8_STAGE(PG8_SA(1, 0), cA + kstep, voffA); PG8_STAGE(PG8_SB(1, 1), cB + hstep + kstep, voffB);
        PG8_WAIT_V(6); PG8_BAR;
    }
    unsigned dyn_ret = 0; int dq = S.c & 7;
    unsigned long long pr_prev = 0, pr_sumk = 0, pr_sume = 0; if (probe) pr_prev = wall_clock64();
    for (;;) {
        bool has_next = false;
        if (dynq) {
            if (wid == 0) {
                if (ui >= 1) {
                    unsigned v = (unsigned)__builtin_amdgcn_readfirstlane((int)dyn_ret) + (unsigned)(2 * S.G / 8);
                    for (int tries = 0; v >= (unsigned)((S.nwg - dq + 7) >> 3) && tries < 7; ++tries) {
                        dq = (dq + 1) & 7; unsigned r_ = 0;
                        if (lane == 0) r_ = __hip_atomic_fetch_add(dynq + 64 * dq, 1u, __ATOMIC_RELAXED, __HIP_MEMORY_SCOPE_AGENT);
                        v = (unsigned)__builtin_amdgcn_readfirstlane((int)r_) + (unsigned)(2 * S.G / 8); }
                    const unsigned code = (v < (unsigned)((S.nwg - dq + 7) >> 3)) ? (8u * v + (unsigned)dq) : 0xffffffffu;
                    if (lane == 0) dslot[(ui + 1) & 1] = code;
                }
                dyn_ret = 0u;
                if (lane == 0) dyn_ret = __hip_atomic_fetch_add(dynq + 64 * dq, 1u, __ATOMIC_RELAXED, __HIP_MEMORY_SCOPE_AGENT);
            }
        } else has_next = S.next(ui + 1, nxt);
        const char* nA_ = has_next ? (const char*)g.A + (size_t)nxt.pm * tstep : cA; const char* nB_ = has_next ? (const char*)g.Bt + (size_t)nxt.pn * tstep : cB;
        const char* nA = nA_; const char* nB = nB_;
        for (int t = 0; t < nt; t += 2) {
            const bool last = (t == nt - 2);
            if (dynq && last) {
                long L1;
                if (ui == 0) { L1 = (long)S.G + S.c; has_next = L1 < S.nwg; }
                else { const unsigned code = (unsigned)__builtin_amdgcn_readfirstlane((int)dslot[(ui + 1) & 1]); has_next = code != 0xffffffffu; L1 = (long)code; }
                if (has_next) { S.unit_of(L1, nxt); nA = (const char*)g.A + (size_t)nxt.pm * tstep; nB = (const char*)g.Bt + (size_t)nxt.pn * tstep; } else { nA = cA; nB = cB; }
            }
            const char* a1 = cA + (size_t)(t + 1) * kstep;
            const char* a2 = last ? nA : cA + (size_t)(t + 2) * kstep; const char* b2 = last ? nB : cB + (size_t)(t + 2) * kstep;
            const char* a3 = a2 + kstep; const char* b3 = b2 + kstep;
            if (last && has_next) S.a_ready(nxt);
            if constexpr (SP2) {
            PG8_LDB(B0, 0, 0); PG8_LDB(B1, 0, 1); PG8_SCHED; PG8_LDA(At, 0, 0); PG8_STAGE(PG8_SA(1, 1), a1 + hstep, voffA);
            PG8_WAIT_V(8); PG8_WAIT_L(0); PG8_BAR; PG8_MMA(0, 0, At, B0); PG8_MMA(0, 1, At, B1); PG8_BAR; PG8_SCHED;
            PG8_LDA(At, 0, 1); PG8_STAGE(PG8_SB(0, 0), b2, voffB); PG8_STAGE(PG8_SB(0, 1), b2 + hstep, voffB); PG8_STAGE(PG8_SA(0, 0), a2, voffA);
            PG8_WAIT_V(8); PG8_WAIT_L(0); PG8_BAR; PG8_MMA(1, 0, At, B0); PG8_MMA(1, 1, At, B1); PG8_BAR; PG8_SCHED;
            PG8_LDB(B0, 1, 0); PG8_LDB(B1, 1, 1); PG8_SCHED; PG8_LDA(At, 1, 0); PG8_STAGE(PG8_SA(0, 1), a2 + hstep, voffA);
            PG8_WAIT_V(8); PG8_WAIT_L(0); PG8_BAR; PG8_MMA(0, 0, At, B0); PG8_MMA(0, 1, At, B1); PG8_BAR; PG8_SCHED;
            PG8_LDA(At, 1, 1); PG8_STAGE(PG8_SB(1, 0), b3, voffB); PG8_STAGE(PG8_SB(1, 1), b3 + hstep, voffB); PG8_STAGE(PG8_SA(1, 0), a3, voffA);
            PG8_WAIT_V(8); PG8_WAIT_L(0); PG8_BAR; PG8_MMA(1, 0, At, B0); PG8_MMA(1, 1, At, B1); PG8_BAR; PG8_SCHED;
            } else {
            PG8_LDB(B0, 0, 0); PG8_SCHED; PG8_LDA(At, 0, 0); PG8_STAGE(PG8_SA(1, 1), a1 + hstep, voffA);
            PG8_WAIT_L(8); PG8_BAR; PG8_WAIT_L(0); PG8_MMA(0, 0, At, B0); PG8_BAR; PG8_SCHED;
            PG8_LDB(B1, 0, 1); PG8_STAGE(PG8_SB(0, 0), b2, voffB);
            PG8_BAR; PG8_WAIT_L(0); PG8_MMA(0, 1, At, B1); PG8_BAR;
            PG8_LDA(At, 0, 1); PG8_STAGE(PG8_SA(0, 0), a2, voffA);
            PG8_BAR; PG8_WAIT_L(0); PG8_MMA(1, 0, At, B0); PG8_BAR; PG8_SCHED;
            PG8_STAGE(PG8_SB(0, 1), b2 + hstep, voffB);
            PG8_WAIT_V(6); PG8_BAR; PG8_MMA(1, 1, At, B1); PG8_BAR;
            PG8_LDB(B0, 1, 0); PG8_SCHED; PG8_LDA(At, 1, 0); PG8_STAGE(PG8_SA(0, 1), a2 + hstep, voffA);
            PG8_WAIT_L(8); PG8_BAR; PG8_WAIT_L(0); PG8_MMA(0, 0, At, B0); PG8_BAR; PG8_SCHED;
            PG8_LDB(B1, 1, 1); PG8_STAGE(PG8_SB(1, 0), b3, voffB);
            PG8_BAR; PG8_WAIT_L(0); PG8_MMA(0, 1, At, B1); PG8_BAR;
            PG8_LDA(At, 1, 1); PG8_STAGE(PG8_SA(1, 0), a3, voffA);
            PG8_BAR; PG8_WAIT_L(0); PG8_MMA(1, 0, At, B0); PG8_BAR; PG8_SCHED;
            PG8_STAGE(PG8_SB(1, 1), b3 + hstep, voffB);
            PG8_WAIT_V(6); PG8_BAR; PG8_MMA(1, 1, At, B1); PG8_BAR;
            }
        }
        unsigned long long pr_tk = 0; if (probe) { pr_tk = wall_clock64(); pr_sumk += pr_tk - pr_prev; }
        if constexpr (ALIGN_EPI) { if (wr == 0) PG8_BAR; }
        if constexpr (!Epi::AFTER_DRAIN) { int le_ = lane; asm volatile("" : "+v"(le_));
            E(acc, cur, wr, wc, le_ & 15, le_ >> 4); S.done(cur); }
        if (probe) { const unsigned long long pr_te = wall_clock64(); pr_sume += pr_te - pr_tk; pr_prev = pr_te; }
        if (!has_next) break;
#pragma unroll
        for (int a = 0; a < 2; ++a)
#pragma unroll
            for (int b = 0; b < 2; ++b)
#pragma unroll
                for (int m = 0; m < 4; ++m)
#pragma unroll
                    for (int n = 0; n < 2; ++n) acc[a][b][m][n] = (f32x4){0.f, 0.f, 0.f, 0.f};
        cur = nxt; cA = nA; cB = nB; ++ui;
        if constexpr (ALIGN_EPI) { if (wr == 1) PG8_BAR; }
    }
    if (probe && blockIdx.x == 0 && tid == 0) { probe[0] = (float)pr_sumk * 0.01f / (float)(ui + 1); probe[1] = (float)pr_sume * 0.01f / (float)(ui + 1); }
    PG8_WAIT_V(0);
    if constexpr (!ALIGN_EPI) { if (wr == 0) PG8_BAR; }
    PG8_BAR;
    if constexpr (Epi::AFTER_DRAIN) { E.fused(acc, cur, wr, wc, fr, fq, lds, wid, lane); S.done(cur); }
#undef PG8_SA
#undef PG8_SB
#undef PG8_STAGE
#undef PG8_LDA
#undef PG8_LDB
#undef PG8_MMA
#undef PG8_WAIT_V
#undef PG8_WAIT_L
#undef PG8_BAR
#undef PG8_SCHED
}
}

constexpr int NWAVES = 8, NTHR = 512;
constexpr int DM = 4096, MP = 16384, MS = 8192, M = MP + MS;
constexpr int LP = 4096, LS = 2048;
constexpr int NIN = 17408, AW = 2048, HW = 2048, FF = 11008, PLE = 256;
constexpr float EPS = 1e-6f;

constexpr size_t WS_CTL = 0, CTL_ZERO_BYTES = 1u << 20;
constexpr size_t SZ_PB = (size_t)M * PLE * 2;
constexpr size_t SZ_WUP = (size_t)2 * FF * DM * 2, SZ_WDN = (size_t)DM * FF * 2, SZ_WPG = (size_t)DM * DM * 2, SZ_WPL = (size_t)DM * PLE * 2;
constexpr size_t SZ_WIN = (size_t)NIN * DM * 2, SZ_WAO = (size_t)DM * AW * 2, SZ_WHO = (size_t)DM * HW * 2, SZ_WOUT = (size_t)DM * DM * 2;
constexpr size_t SZ_QKV = (size_t)M * 3072 * 2, SZ_HY = (size_t)M * 6144 * 2, SZ_GT = (size_t)M * 8192 * 2, SZ_XN = (size_t)M * DM * 2;
constexpr size_t WS_PB = CTL_ZERO_BYTES;
constexpr size_t WS_WUP = WS_PB + SZ_PB, WS_WDN = WS_WUP + SZ_WUP, WS_WPG = WS_WDN + SZ_WDN, WS_WPL = WS_WPG + SZ_WPG;
constexpr size_t WS_EARLY = WS_WPL + SZ_WPL;
constexpr size_t WS_WIN = WS_EARLY, WS_WAO = WS_WIN + SZ_WIN, WS_WHO = WS_WAO + SZ_WAO, WS_WOUT = WS_WHO + SZ_WHO;
constexpr size_t WS_QKV = WS_WOUT + SZ_WOUT, WS_HY = WS_QKV + SZ_QKV, WS_GT = WS_HY + SZ_HY, WS_END = WS_GT + SZ_GT;
constexpr size_t WS_HYO = WS_QKV;
constexpr size_t WS_TM = WS_HY;
constexpr size_t WS_XN2 = WS_END - SZ_XN;
constexpr size_t SZ_GU = (size_t)MP * FF * 2;
constexpr size_t WS_GU = WS_EARLY, WS_ACT = WS_GU + SZ_GU;
constexpr size_t WS_PP = WS_EARLY;
static_assert(WS_ACT + SZ_GU <= WS_XN2, "FFN buffers overlap XN2");
static_assert(WS_HYO + (size_t)M * HW * 2 <= WS_HY && WS_TM + SZ_XN <= WS_GT, "overlay map");
static_assert(WS_END <= 1450000000ull, "workspace");
constexpr size_t DO_XN = 0;
constexpr size_t DO_UT = 0;
constexpr size_t DO_KT = SZ_XN;
constexpr size_t DO_ATT = SZ_XN + (size_t)HW * (2 * LP + 2 * LS) * 4;
static_assert(DO_ATT + (size_t)M * AW * 2 <= (size_t)M * DM * 4, "d_out scratch map");
constexpr int CW_BAR = 4096;

constexpr int RING_BYTES = 131072;
constexpr int LDSCTL_OFF = RING_BYTES, MISC_OFF = LDSCTL_OFF + 320;
constexpr int LDS_BYTES = 147456;

#define GAS __attribute__((address_space(1)))
#define LAS __attribute__((address_space(3)))
typedef unsigned short bf16;
typedef unsigned v4u __attribute__((ext_vector_type(4)));
typedef float f32x4 __attribute__((ext_vector_type(4)));
typedef float f32x16 __attribute__((ext_vector_type(16)));
typedef short bf16x8 __attribute__((ext_vector_type(8)));
typedef short s16x4 __attribute__((ext_vector_type(4)));
typedef GAS unsigned gu32;
#define LDS_WAIT() asm volatile("s_waitcnt lgkmcnt(0)" ::: "memory")
using pg8::pk2f; using pg8::bflo; using pg8::bfhi;
#define XB_TMO      128
#define XB_XCNT(j)  (256  + 64 * (j))
#define XB_XSUB(j)  (1280 + 64 * (j))
#define XB_XGEN(j)  (2304 + 64 * (j))
#define XB_TOP      3328
#define XB_TOPGEN   3392
#define XCD_BAR_WORDS 3456
#define XB_SPIN_CAP (1u << 18)

__device__ __forceinline__ unsigned xb_ld(unsigned* p)              { return __hip_atomic_load(p, __ATOMIC_RELAXED, __HIP_MEMORY_SCOPE_AGENT); }
__device__ __forceinline__ unsigned xb_add(unsigned* p, unsigned v) { return __hip_atomic_fetch_add(p, v, __ATOMIC_RELAXED, __HIP_MEMORY_SCOPE_AGENT); }
__device__ __forceinline__ unsigned xb_xcc_id() { return (unsigned)__builtin_amdgcn_s_getreg((3 << 11) | 20) & 0xFu; }
#define XB_SPIN(cond, bar) do { unsigned _sp = 0; while (cond) { __builtin_amdgcn_s_sleep(1); \
    if ((++_sp & 255u) == 0u) { if (xb_ld(&(bar)[XB_TMO])) break; if (_sp > XB_SPIN_CAP) { atomicAdd(&(bar)[XB_TMO], 1u); break; } } } } while (0)

struct XcdBarrier {
    unsigned* bar; unsigned x;
    volatile LAS unsigned* st;
};

__device__ __forceinline__ XcdBarrier xcd_barrier_post(unsigned* bar, volatile LAS unsigned* st) {
    XcdBarrier b; b.bar = bar; b.x = xb_xcc_id(); b.st = st;
    if (threadIdx.x == 0) (void)xb_add(&bar[XB_XCNT(b.x)], 1u);
    return b;
}
__device__ __forceinline__ void xcd_barrier_complete(unsigned* bar, unsigned x, unsigned& nloc, unsigned& nx) {
    const unsigned G = gridDim.x * gridDim.y * gridDim.z;
    unsigned sum, cnt, mine, sp = 0u;
    for (;;) {
        sum = 0u; cnt = 0u; mine = 0u;
#pragma unroll
        for (unsigned j = 0; j < 16; ++j) { const unsigned c = xb_ld(&bar[XB_XCNT(j)]); sum += c; cnt += (c > 0u) ? 1u : 0u; mine = (j == x) ? c : mine; }
        if (sum == G) break;
        __builtin_amdgcn_s_sleep(1);
        if ((++sp & 255u) == 0u) { if (xb_ld(&bar[XB_TMO])) break; if (sp > XB_SPIN_CAP) { atomicAdd(&bar[XB_TMO], 1u); break; } }
    }
    nloc = mine > 0u ? mine : 1u; nx = cnt > 0u ? cnt : 1u;
}

__device__ __forceinline__ void xcd_barrier(const XcdBarrier& b) {
    asm volatile("s_waitcnt vmcnt(0)" ::: "memory");
    __syncthreads();
    if (threadIdx.x == 0) {
        unsigned* bar = b.bar;
        __builtin_amdgcn_s_waitcnt(0);
        unsigned nloc = b.st[0], nx = b.st[1];
        if (nloc == 0u) { xcd_barrier_complete(bar, b.x, nloc, nx); b.st[0] = nloc; b.st[1] = nx; }
        const unsigned old = xb_add(&bar[XB_XSUB(b.x)], 1u);
        const unsigned gen = old / nloc;
        if (old + 1u == (gen + 1u) * nloc) {
            __builtin_amdgcn_fence(__ATOMIC_RELEASE, "agent");
            asm volatile("s_waitcnt vmcnt(0)" ::: "memory");
            const unsigned og = xb_add(&bar[XB_TOP], 1u);
            const unsigned tg = og / nx;
            if (og + 1u == (tg + 1u) * nx) xb_add(&bar[XB_TOPGEN], 1u);
            else XB_SPIN(xb_ld(&bar[XB_TOPGEN]) == tg, bar);
            __builtin_amdgcn_fence(__ATOMIC_ACQUIRE, "agent");
            xb_add(&bar[XB_XGEN(b.x)], 1u);
            asm volatile("s_waitcnt vmcnt(0)" ::: "memory");
        } else {
            XB_SPIN(xb_ld(&bar[XB_XGEN(b.x)]) == gen, bar);
            __builtin_amdgcn_fence(__ATOMIC_ACQUIRE, "agent");
            asm volatile("s_waitcnt vmcnt(0)" ::: "memory");
        }
    }
    __syncthreads();
}

struct Args { const float* in[31]; float* out; unsigned char* ws; int ph_lo, ph_hi; };
typedef unsigned u32x2_t __attribute__((ext_vector_type(2)));
struct Frame {
    LAS unsigned char* lds;
    int tid, lane, wave, vcu, G;
};
__device__ __forceinline__ void refresh(Frame& F) { unsigned z_ = 0u; asm volatile("" : "+v"(z_)); const int l_ = (int)__builtin_amdgcn_mbcnt_hi(~0u, __builtin_amdgcn_mbcnt_lo(~0u, z_)); F.lane = l_; F.tid = F.wave * 64 + l_; }
__device__ __forceinline__ float shx(float v, int mask, int lane) { return __int_as_float(__builtin_amdgcn_ds_bpermute((lane ^ mask) << 2, __float_as_int(v))); }

struct TrItem { const float* W; bf16* WT; const float* gk; int K, N, k0, n0; float sc = 1.0f; };
__device__ __forceinline__ void tr_load(const TrItem& t, int lane, float (&wv)[32]) {
    const float* src = t.W + (size_t)(t.k0 + (lane >> 5)) * t.N + t.n0 + (lane & 31);
#pragma unroll
    for (int i = 0; i < 32; ++i) wv[i] = src[(size_t)(2 * i) * t.N];
}
__device__ __forceinline__ void tr_store(const TrItem& t, int lane, const float (&wv)[32], LAS float* scr) {
#pragma unroll
    for (int i = 0; i < 32; ++i) { const int kk = 2 * i + (lane >> 5); scr[kk * 33 + (lane & 31)] = (t.gk ? wv[i] * t.gk[t.k0 + kk] : wv[i]) * t.sc; }
    LDS_WAIT(); asm volatile("" ::: "memory");
    const int c = lane & 7;
#pragma unroll
    for (int j = 0; j < 4; ++j) { const int n = (lane >> 3) + 8 * j; const LAS float* s = scr + (8 * c) * 33 + n;
        v4u o; o.x = pk2f(s[0 * 33], s[1 * 33]); o.y = pk2f(s[2 * 33], s[3 * 33]); o.z = pk2f(s[4 * 33], s[5 * 33]); o.w = pk2f(s[6 * 33], s[7 * 33]);
        *(GAS v4u*)(t.WT + (size_t)(t.n0 + n) * t.K + t.k0 + 8 * c) = o; }
    LDS_WAIT(); asm volatile("" ::: "memory");
}
__device__ __forceinline__ TrItem tr_item(const float* W, int K, int N, bf16* WT, const float* gk, int r) { const int nblk = N / 32, kb = r / nblk, nb = r - kb * nblk; return TrItem{W, WT, gk, K, N, 64 * kb, 32 * nb}; }
template <bool BF> __device__ __forceinline__ void rms_row(const float* xrow, const float* g, void* orow, int lane) {
    const GAS f32x4* xr = (const GAS f32x4*)xrow + lane; const GAS f32x4* gr = (const GAS f32x4*)g + lane;
    f32x4 v[16]; float s = 0.f;
#pragma unroll
    for (int j = 0; j < 16; ++j) { v[j] = xr[64 * j]; s += (v[j].x * v[j].x + v[j].y * v[j].y) + (v[j].z * v[j].z + v[j].w * v[j].w); }
#pragma unroll
    for (int o = 1; o < 64; o <<= 1) s += shx(s, o, lane);
    const float r = 1.0f / sqrtf(s * (1.0f / 4096.0f) + EPS);
#pragma unroll
    for (int j = 0; j < 16; ++j) { const f32x4 gg = gr[64 * j]; const f32x4 y = v[j] * r * gg;
        if (BF) { ((GAS unsigned long long*)orow)[lane + 64 * j] = (unsigned long long)pk2f(y.x, y.y) | ((unsigned long long)pk2f(y.z, y.w) << 32); }
        else ((GAS f32x4*)orow)[lane + 64 * j] = y; }
}
__device__ __forceinline__ void final_row(const bf16* xrow, float rstd, const float* g, float* orow, int lane) {
    const GAS u32x2_t* xr = (const GAS u32x2_t*)xrow + lane; const GAS f32x4* gr = (const GAS f32x4*)g + lane; GAS f32x4* o = (GAS f32x4*)orow + lane;
    u32x2_t v[16];
#pragma unroll
    for (int j = 0; j < 16; ++j) v[j] = xr[64 * j];
#pragma unroll
    for (int j = 0; j < 16; ++j) { const f32x4 gg = gr[64 * j]; f32x4 y; y.x = bflo(v[j].x) * rstd * gg.x; y.y = bfhi(v[j].x) * rstd * gg.y; y.z = bflo(v[j].y) * rstd * gg.z; y.w = bfhi(v[j].y) * rstd * gg.w; o[64 * j] = y; }
}
__device__ __forceinline__ void rms_phase_bf16(const Frame& F, const float* src0, const float* src1, const float* g, bf16* dst) {
    const int gw = F.vcu * NWAVES + F.wave, NGW = F.G * NWAVES, lane = F.lane;
    if (gw >= M) return;
    f32x4 gv[16], cur[16], nxt[16];
#pragma unroll
    for (int j = 0; j < 16; ++j) gv[j] = ((const GAS f32x4*)g)[lane + 64 * j];
    { const GAS f32x4* xr = (const GAS f32x4*)(gw < MP ? src0 + (size_t)gw * DM : src1 + (size_t)(gw - MP) * DM) + lane;
#pragma unroll
      for (int j = 0; j < 16; ++j) cur[j] = xr[64 * j]; }
#pragma unroll 1
    for (int m = gw; m < M; m += NGW) {
        const int mn = m + NGW;
        if (mn < M) { const GAS f32x4* xr = (const GAS f32x4*)(mn < MP ? src0 + (size_t)mn * DM : src1 + (size_t)(mn - MP) * DM) + lane;
#pragma unroll
            for (int j = 0; j < 16; ++j) nxt[j] = xr[64 * j]; }
        float s = 0.f;
#pragma unroll
        for (int j = 0; j < 16; ++j) s += (cur[j].x * cur[j].x + cur[j].y * cur[j].y) + (cur[j].z * cur[j].z + cur[j].w * cur[j].w);
#pragma unroll
        for (int o = 1; o < 64; o <<= 1) s += shx(s, o, lane);
        const float r = 1.0f / sqrtf(s * (1.0f / 4096.0f) + EPS);
        GAS unsigned long long* orow = (GAS unsigned long long*)(dst + (size_t)m * DM);
#pragma unroll
        for (int j = 0; j < 16; ++j) { const f32x4 y = cur[j] * r * gv[j]; orow[lane + 64 * j] = (unsigned long long)pk2f(y.x, y.y) | ((unsigned long long)pk2f(y.z, y.w) << 32); }
        if (mn < M) {
#pragma unroll
            for (int j = 0; j < 16; ++j) cur[j] = nxt[j]; }
    }
}
__device__ __forceinline__ void final_phase(const Frame& F, const bf16* XB, const float* ss, const float* g, float* out, float dadd = 0.f) {
    const int gw = F.vcu * NWAVES + F.wave, NGW = F.G * NWAVES, lane = F.lane;
    if (gw >= M) return;
    f32x4 gv[16]; u32x2_t cur[16], nxt[16];
#pragma unroll
    for (int j = 0; j < 16; ++j) gv[j] = ((const GAS f32x4*)g)[lane + 64 * j];
    { const GAS u32x2_t* xr = (const GAS u32x2_t*)(XB + (size_t)gw * DM) + lane;
#pragma unroll
      for (int j = 0; j < 16; ++j) cur[j] = xr[64 * j]; }
    float sc = ss[gw];
#pragma unroll 1
    for (int m = gw; m < M; m += NGW) {
        const int mn = m + NGW; float sn = 0.f;
        if (mn < M) { const GAS u32x2_t* xr = (const GAS u32x2_t*)(XB + (size_t)mn * DM) + lane; sn = ss[mn];
#pragma unroll
            for (int j = 0; j < 16; ++j) nxt[j] = xr[64 * j]; }
        const float rstd = 1.0f / sqrtf(sc * (1.0f / 4096.0f) + EPS);
        GAS f32x4* o = (GAS f32x4*)(out + (size_t)m * DM) + lane;
#pragma unroll
        for (int j = 0; j < 16; ++j) { const f32x4 gg = gv[j]; f32x4 y; y.x = bflo(cur[j].x) * rstd * gg.x; y.y = bfhi(cur[j].x) * rstd * gg.y; y.z = bflo(cur[j].y) * rstd * gg.z; y.w = bfhi(cur[j].y) * rstd * gg.w; if (dadd != 0.f && m < MP) y = y + dadd; o[64 * j] = y; }
        if (mn < M) { sc = sn;
#pragma unroll
            for (int j = 0; j < 16; ++j) cur[j] = nxt[j]; }
    }
}

#define MFMAF32(a, b, c) __builtin_amdgcn_mfma_f32_32x32x2f32((a), (b), (c), 0, 0, 0)
__device__ __forceinline__ void h0_phase(const Frame& F, const Args& A, float* KT) {
    const float* w1 = A.in[10]; const float* b1 = A.in[11]; const float* f1 = A.in[12]; const float* w2 = A.in[13]; const float* b2 = A.in[14]; const float* f2 = A.in[15];
    const float* w3 = A.in[16]; const float* decay = A.in[17]; const float* skip = A.in[18];
    LAS float* Z = (LAS float*)F.lds; LAS float* H1 = Z + 64 * 35; LAS float* H2 = H1 + 64 * 65; LAS float* T = H2 + 64 * 65;
    const int per = (1536 % F.G == 0) ? 1536 / F.G : 0;
    int prev_lt = -1;
#pragma unroll 1
    for (int i = 0, unit = per ? F.vcu * per : F.vcu; per ? i < per : unit < 1536; ++i, unit += per ? 1 : F.G) {
        int tid = F.tid; asm volatile("" : "+v"(tid));
        const int lane = tid & 63, r = lane & 31, kh = lane >> 5, wv = F.wave;
        const int dct = unit & 15, lt = unit >> 4, dc0 = dct * 256, dir = dc0 >> 11, c0 = dc0 & 2047;
        const int lsel = lt >= 64, L = lsel ? LS : LP, l0 = (lsel ? lt - 64 : lt) * 64;
        float* KTb = KT + (lsel ? (size_t)HW * 2 * LP : 0);
        const float invLm1 = 1.0f / (float)(L - 1);
        float bw[32];
#pragma unroll
        for (int s = 0; s < 32; ++s) bw[s] = w3[(size_t)(2 * s + kh) * 4096 + dc0 + wv * 32 + r];
        const float dec = decay[dc0 + wv * 32 + r];
        if (lt != prev_lt) { prev_lt = lt;
        for (int idx = tid; idx < 64 * 35; idx += NTHR) { const int li = idx / 35, f = idx - li * 35; const float lf = (float)(l0 + li);
            float v;
            if (f == 0) v = lf * invLm1;
            else if (f >= 33) v = 0.f;
            else { const int i = (f - 1) & 15; const float band = 1e-4f + (float)i * ((15.0f - 1e-4f) / 15.0f); const float a = 2.0f * lf * band / (float)L;
                v = f <= 16 ? cospif(a) : -sinpif(a); }
            Z[idx] = v; }
        __syncthreads();
        if (wv < 4) { const int lt2 = wv >> 1, j = (wv & 1) * 32 + r; f32x16 acc;
#pragma unroll
            for (int e = 0; e < 16; ++e) acc[e] = 0.f;
#pragma unroll
            for (int s = 0; s < 17; ++s) { const int k = 2 * s + kh; const float a = Z[(lt2 * 32 + r) * 35 + k], b = k < 33 ? w1[k * 64 + j] : 0.f; acc = MFMAF32(a, b, acc); }
            const float bj = b1[j], fj = f1[j];
#pragma unroll
            for (int e = 0; e < 16; ++e) H1[(lt2 * 32 + (e & 3) + 8 * (e >> 2) + 4 * kh) * 65 + j] = __sinf(fj * (acc[e] + bj)); }
        __syncthreads();
        if (wv < 4) { const int lt2 = wv >> 1, j = (wv & 1) * 32 + r; f32x16 acc;
#pragma unroll
            for (int e = 0; e < 16; ++e) acc[e] = 0.f;
#pragma unroll
            for (int s = 0; s < 32; ++s) { const int k = 2 * s + kh; acc = MFMAF32(H1[(lt2 * 32 + r) * 65 + k], w2[k * 64 + j], acc); }
            const float bj = b2[j], fj = f2[j];
#pragma unroll
            for (int e = 0; e < 16; ++e) H2[(lt2 * 32 + (e & 3) + 8 * (e >> 2) + 4 * kh) * 65 + j] = __sinf(fj * (acc[e] + bj)); }
        __syncthreads();
        }
        { const int dcl = wv * 32 + r;
#pragma unroll
          for (int lt2 = 0; lt2 < 2; ++lt2) { f32x16 acc;
#pragma unroll
              for (int e = 0; e < 16; ++e) acc[e] = 0.f;
#pragma unroll
              for (int s = 0; s < 32; ++s) acc = MFMAF32(H2[(lt2 * 32 + r) * 65 + 2 * s + kh], bw[s], acc);
#pragma unroll
              for (int e = 0; e < 16; ++e) { const int li = lt2 * 32 + (e & 3) + 8 * (e >> 2) + 4 * kh; const float t = (float)(l0 + li) * invLm1; T[dcl * 65 + li] = acc[e] * __expf(-t * dec); } } }
        __syncthreads();
#pragma unroll 2
        for (int it = 0; it < 32; ++it) { const int row = (tid >> 6) + 8 * it, i = tid & 63, c = c0 + row, l = l0 + i; float v = T[row * 65 + i]; int n;
            if (dir == 0) { n = l; if (l == 0) v += skip[c]; }
            else { if (l == 0) { n = L; v = 0.f; } else n = 2 * L - l; }
            KTb[(size_t)c * (2 * L) + n] = v; }
        __syncthreads();
    }
}

struct HyUnit { int ct, seq, t0, L, rowbase; size_t uoff; };
__device__ __forceinline__ HyUnit hy_unit(int unit) { HyUnit u; u.ct = unit & 15; const int tt = unit >> 4;
    if (tt < 256) { u.seq = tt >> 6; u.t0 = (tt & 63) * 64; u.L = LP; u.rowbase = u.seq * LP; u.uoff = 0; }
    else { const int t2 = tt - 256; u.seq = t2 >> 5; u.t0 = (t2 & 31) * 64; u.L = LS; u.rowbase = MP + u.seq * LS; u.uoff = (size_t)HW * 4 * LP; }
    return u; }
template <int NC> __device__ __forceinline__ void hy_load(const bf16* HY, const HyUnit& u, int comp0, int cp, int tq, unsigned (&xr)[NC][10]) {
    const int c = u.ct * 128 + 2 * cp;
#pragma unroll
    for (int i = 0; i < 10; ++i) { const int t = u.t0 + tq * 8 - 1 + i;
#pragma unroll
        for (int cm = 0; cm < NC; ++cm) { unsigned v = 0u; if (t >= 0 && t < u.L) v = *(const unsigned*)(HY + (size_t)(u.rowbase + t) * 6144 + (comp0 + cm) * 2048 + c); xr[cm][i] = v; } }
}
__device__ __forceinline__ void h1_phase(const Frame& F, const Args& A, const bf16* HY, bf16* UT) {
    const float* sw = A.in[8]; const float* sb = A.in[9];
    LAS float* T = (LAS float*)F.lds;
    if (F.vcu >= 6144) return;
    unsigned xr[2][10], xn[2][10];
    { const int tid0 = F.tid; hy_load<2>(HY, hy_unit(F.vcu), 0, tid0 & 63, tid0 >> 6, xr); }
#pragma unroll 1
    for (int unit = F.vcu; unit < 6144; unit += F.G) {
        int tid = F.tid; asm volatile("" : "+v"(tid)); const int cp = tid & 63, tq = tid >> 6;
        const HyUnit u = hy_unit(unit); const bool more = unit + F.G < 6144;
        if (more) hy_load<2>(HY, hy_unit(unit + F.G), 0, cp, tq, xn);
        const int ct = u.ct, seq = u.seq, t0 = u.t0, L = u.L; bf16* ut = UT + u.uoff;
        const int c = ct * 128 + 2 * cp;
        float w[2][2][3], b[2][2];
#pragma unroll
        for (int cm = 0; cm < 2; ++cm)
#pragma unroll
            for (int ch = 0; ch < 2; ++ch) { b[cm][ch] = sb[cm * 2048 + c + ch];
#pragma unroll
                for (int k = 0; k < 3; ++k) w[cm][ch][k] = sw[k * 6144 + cm * 2048 + c + ch]; }
        float x[2][2][10];
#pragma unroll
        for (int i = 0; i < 10; ++i)
#pragma unroll
            for (int cm = 0; cm < 2; ++cm) { x[cm][0][i] = bflo(xr[cm][i]); x[cm][1][i] = bfhi(xr[cm][i]); }
#pragma unroll
        for (int i = 0; i < 8; ++i)
#pragma unroll
            for (int ch = 0; ch < 2; ++ch) {
                const float a = w[0][ch][0] * x[0][ch][i] + w[0][ch][1] * x[0][ch][i + 1] + w[0][ch][2] * x[0][ch][i + 2] + b[0][ch];
                const float d = w[1][ch][0] * x[1][ch][i] + w[1][ch][1] * x[1][ch][i + 1] + w[1][ch][2] * x[1][ch][i + 2] + b[1][ch];
                T[(ch * 64 + cp) * 65 + tq * 8 + i] = a * d; }
        __syncthreads();
#pragma unroll 4
        for (int it = 0; it < 8; ++it) { const int rho = (tid >> 5) + 16 * it, i2 = tid & 31, cc = ct * 128 + 2 * (rho & 63) + (rho >> 6);
            *(unsigned*)(ut + ((size_t)cc * 4 + seq) * L + t0 + 2 * i2) = pk2f(T[rho * 65 + 2 * i2], T[rho * 65 + 2 * i2 + 1]); }
        __syncthreads();
        if (more) {
#pragma unroll
            for (int i = 0; i < 10; ++i) { xr[0][i] = xn[0][i]; xr[1][i] = xn[1][i]; } }
    }
}
__device__ __forceinline__ void h3_phase(const Frame& F, const Args& A, const bf16* HY, const bf16* UT, bf16* HYO) {
    const float* sw = A.in[8]; const float* sb = A.in[9];
    LAS float* T = (LAS float*)F.lds;
    if (F.vcu >= 6144) return;
    unsigned xr[1][10], xn[1][10], yr[8], yn[8];
    auto yload = [&](const HyUnit& u, int tid, unsigned (&y)[8]) {
#pragma unroll
        for (int it = 0; it < 8; ++it) { const int rho = (tid >> 5) + 16 * it, i2 = tid & 31, cc = u.ct * 128 + 2 * (rho & 63) + (rho >> 6);
            y[it] = *(const unsigned*)(UT + u.uoff + ((size_t)cc * 4 + u.seq) * u.L + u.t0 + 2 * i2); } };
    { const int tid0 = F.tid; const HyUnit u0 = hy_unit(F.vcu); yload(u0, tid0, yr); hy_load<1>(HY, u0, 2, tid0 & 63, tid0 >> 6, xr); }
#pragma unroll 1
    for (int unit = F.vcu; unit < 6144; unit += F.G) {
        int tid = F.tid; asm volatile("" : "+v"(tid)); const int cp = tid & 63, tq = tid >> 6;
        const HyUnit u = hy_unit(unit); const bool more = unit + F.G < 6144;
        if (more) { const HyUnit un = hy_unit(unit + F.G); yload(un, tid, yn); hy_load<1>(HY, un, 2, cp, tq, xn); }
        const int ct = u.ct, t0 = u.t0, rowbase = u.rowbase;
#pragma unroll
        for (int it = 0; it < 8; ++it) { const int rho = (tid >> 5) + 16 * it, i2 = tid & 31; T[rho * 65 + 2 * i2] = bflo(yr[it]); T[rho * 65 + 2 * i2 + 1] = bfhi(yr[it]); }
        const int c = ct * 128 + 2 * cp;
        float w[2][3], b[2];
#pragma unroll
        for (int ch = 0; ch < 2; ++ch) { b[ch] = sb[4096 + c + ch];
#pragma unroll
            for (int k = 0; k < 3; ++k) w[ch][k] = sw[k * 6144 + 4096 + c + ch]; }
        float x[2][10];
#pragma unroll
        for (int i = 0; i < 10; ++i) { x[0][i] = bflo(xr[0][i]); x[1][i] = bfhi(xr[0][i]); }
        __syncthreads();
#pragma unroll
        for (int i = 0; i < 8; ++i) {
            const float g0 = w[0][0] * x[0][i] + w[0][1] * x[0][i + 1] + w[0][2] * x[0][i + 2] + b[0];
            const float g1 = w[1][0] * x[1][i] + w[1][1] * x[1][i + 1] + w[1][2] * x[1][i + 2] + b[1];
            const float y0 = T[cp * 65 + tq * 8 + i], y1 = T[(64 + cp) * 65 + tq * 8 + i];
            *(unsigned*)(HYO + (size_t)(rowbase + t0 + tq * 8 + i) * 2048 + c) = pk2f(y0 * g0, y1 * g1); }
        __syncthreads();
        if (more) {
#pragma unroll
            for (int i = 0; i < 10; ++i) xr[0][i] = xn[0][i];
#pragma unroll
            for (int it = 0; it < 8; ++it) yr[it] = yn[it]; }
    }
}


#define HD_INLINE __device__ __forceinline__
#define XP(T) LAS T*
#ifndef FFT_CORE_H
#define FFT_CORE_H
#ifdef __HIP_DEVICE_COMPILE__
typedef float cf __attribute__((ext_vector_type(2)));
#elif defined(__clang__)
typedef float cf __attribute__((ext_vector_type(2)));
#else
struct cf { float x, y; };
#endif
#ifdef __HIPCC__
#define PK_ADD(r, a, b, OS, OH, NL, NH) asm("v_pk_add_f32 %0, %1, %2 op_sel:" OS " op_sel_hi:" OH " neg_lo:" NL " neg_hi:" NH : "=v"(r) : "v"(a), "v"(b))
#define PK_MUL(r, a, b, OS, OH, NL, NH) asm("v_pk_mul_f32 %0, %1, %2 op_sel:" OS " op_sel_hi:" OH " neg_lo:" NL " neg_hi:" NH : "=v"(r) : "v"(a), "v"(b))
#define PK_FMA(r, a, b, c, OS, OH, NL, NH) asm("v_pk_fma_f32 %0, %1, %2, %3 op_sel:" OS " op_sel_hi:" OH " neg_lo:" NL " neg_hi:" NH : "=v"(r) : "v"(a), "v"(b), "v"(c))
HD_INLINE cf cadd(cf a, cf b) { return a + b; }
HD_INLINE cf csub(cf a, cf b) { return a - b; }
HD_INLINE cf cscale(cf a, float s) { return a * s; }
#else
static inline float pk_src(cf v, const char* sel, const char* neg, int i) { const float f = (sel[1 + 2 * i] == '1') ? v.y : v.x; return (neg[1 + 2 * i] == '1') ? -f : f; }
#define PK_ADD(r, a, b, OS, OH, NL, NH) do { cf r_; r_.x = pk_src(a, OS, NL, 0) + pk_src(b, OS, NL, 1); r_.y = pk_src(a, OH, NH, 0) + pk_src(b, OH, NH, 1); r = r_; } while (0)
#define PK_MUL(r, a, b, OS, OH, NL, NH) do { cf r_; r_.x = pk_src(a, OS, NL, 0) * pk_src(b, OS, NL, 1); r_.y = pk_src(a, OH, NH, 0) * pk_src(b, OH, NH, 1); r = r_; } while (0)
#define PK_FMA(r, a, b, c, OS, OH, NL, NH) do { cf r_; r_.x = pk_src(a, OS, NL, 0) * pk_src(b, OS, NL, 1) + pk_src(c, OS, NL, 2); r_.y = pk_src(a, OH, NH, 0) * pk_src(b, OH, NH, 1) + pk_src(c, OH, NH, 2); r = r_; } while (0)
HD_INLINE cf cadd(cf a, cf b) { return cf{a.x + b.x, a.y + b.y}; }
HD_INLINE cf csub(cf a, cf b) { return cf{a.x - b.x, a.y - b.y}; }
HD_INLINE cf cscale(cf a, float s) { return cf{a.x * s, a.y * s}; }
#endif
HD_INLINE cf csub_mi(cf a, cf b) { cf r; PK_ADD(r, a, b, "[1,1]", "[0,0]", "[0,1]", "[1,0]"); return r; }
HD_INLINE cf cadd_pi(cf a, cf b) { cf r; PK_ADD(r, a, b, "[0,1]", "[1,0]", "[0,1]", "[0,0]"); return r; }
HD_INLINE cf csub_pi(cf a, cf b) { cf r; PK_ADD(r, a, b, "[0,1]", "[1,0]", "[0,0]", "[0,1]"); return r; }
HD_INLINE cf cmul(cf a, cf b) { cf t, r; PK_MUL(t, a, b, "[1,0]", "[1,1]", "[0,0]", "[0,0]");
    PK_FMA(r, a, b, t, "[0,0,1]", "[0,1,0]", "[0,0,1]", "[0,0,0]"); return r; }
HD_INLINE cf cmulc(cf a, cf b) { cf t, r; PK_MUL(t, a, b, "[1,0]", "[1,1]", "[0,0]", "[0,0]");
    PK_FMA(r, a, b, t, "[0,0,1]", "[0,1,0]", "[0,0,0]", "[1,0,0]"); return r; }
HD_INLINE cf csqr(cf a) { return cmul(a, a); }
HD_INLINE int fpad(int i) { return i + (i >> 4); }
HD_INLINE int wpad(int k) { return k + (k >> 4) + (k >> 8); }
HD_INLINE cf mul_w32(cf x, int idx, bool conj) {
    const float C[16] = {1.0f, 0.98078528040f, 0.92387953251f, 0.83146961230f, 0.70710678119f, 0.55557023302f, 0.38268343237f, 0.19509032202f, 0.0f, -0.19509032202f, -0.38268343237f, -0.55557023302f, -0.70710678119f, -0.83146961230f, -0.92387953251f, -0.98078528040f};
    const float S[16] = {0.0f, 0.19509032202f, 0.38268343237f, 0.55557023302f, 0.70710678119f, 0.83146961230f, 0.92387953251f, 0.98078528040f, 1.0f, 0.98078528040f, 0.92387953251f, 0.83146961230f, 0.70710678119f, 0.55557023302f, 0.38268343237f, 0.19509032202f};
    if (idx == 0) return x;
    if (idx == 8) return conj ? cf{-x.y, x.x} : cf{x.y, -x.x};
    const float c = C[idx], s = conj ? -S[idx] : S[idx];
#ifdef __HIPCC__
    const cf t = x.yx * cf{s, -s}; return __builtin_elementwise_fma(x, cf{c, c}, t);
#else
    return cf{x.x * c + x.y * s, x.y * c - x.x * s};
#endif
}
HD_INLINE int brev(int j, int lr) { int r = 0; for (int b = 0; b < lr; ++b) r |= ((j >> b) & 1) << (lr - 1 - b); return r; }
template <int R> HD_INLINE void wpowers(cf w, cf (&p)[R]) {
    p[0] = cf{1.0f, 0.0f}; if (R > 1) p[1] = w;
#pragma unroll
    for (int k = 2; k < R; ++k) p[k] = (k & 1) ? cmul(p[k - 1], w) : csqr(p[k >> 1]);
}
template <int LR> HD_INLINE void dif_regs(cf (&v)[1 << LR], XP(const cf) W, int N, int q, int o) {
    constexpr int R = 1 << LR;
#pragma unroll
    for (int st = 0; st < LR; ++st) {
        const int half = R >> (st + 1);
#pragma unroll
        for (int j = 0; j < R; ++j) {
            if ((j & half) == 0) {
                const cf a = v[j], b = v[j + half];
                const int idx = (j & (half - 1)) * (16 / half);
                v[j] = cadd(a, b);
                v[j + half] = (idx == 8) ? csub_mi(a, b) : mul_w32(csub(a, b), idx, false);
            }
        }
    }
    if (q > 1) {
        if (R == 32) {
            cf p[16]; wpowers<16>(W[wpad(o * (N / (R * q)))], p); const cf p16 = csqr(p[8]);
#pragma unroll
            for (int j = 1; j < R; ++j) { const int k = brev(j, LR); v[j] = cmul(v[j], k < 16 ? p[k & 15] : cmul(p[k & 15], p16)); }
        } else {
        cf p[R]; wpowers<R>(W[wpad(o * (N / (R * q)))], p);
#pragma unroll
        for (int j = 1; j < R; ++j) v[j] = cmul(v[j], p[brev(j, LR)]);
        }
    }
}
template <int LR> HD_INLINE void dit_regs(cf (&v)[1 << LR], XP(const cf) W, int N, int s0, int o) {
    constexpr int R = 1 << LR;
    if (s0 > 1) {
        if (R == 32) {
            cf p[16]; wpowers<16>(W[wpad(o * (N / (R * s0)))], p); const cf p16 = csqr(p[8]);
#pragma unroll
            for (int j = 1; j < R; ++j) { const int k = brev(j, LR); v[j] = cmulc(v[j], k < 16 ? p[k & 15] : cmul(p[k & 15], p16)); }
        } else {
        cf p[R]; wpowers<R>(W[wpad(o * (N / (R * s0)))], p);
#pragma unroll
        for (int j = 1; j < R; ++j) v[j] = cmulc(v[j], p[brev(j, LR)]);
        }
    }
#pragma unroll
    for (int st = 0; st < LR; ++st) {
        const int half = 1 << st;
#pragma unroll
        for (int j = 0; j < R; ++j) {
            if ((j & half) == 0) {
                const int idx = (j & (half - 1)) * (16 / half);
                const cf a = v[j];
                if (idx == 8) { const cf x = v[j + half]; v[j] = cadd_pi(a, x); v[j + half] = csub_pi(a, x); }
                else { const cf b = mul_w32(v[j + half], idx, true); v[j] = cadd(a, b); v[j + half] = csub(a, b); }
            }
        }
    }
}
template <int LR> HD_INLINE void dif_pass(XP(cf) X, XP(const cf) W, int N, int S, int tid, int nthr) {
    constexpr int R = 1 << LR;
    const int q = S >> (LR - 1);
#pragma unroll 1
    for (int bf = tid; bf < N / R; bf += nthr) {
        const int blk = bf / q, o = bf - blk * q, base = blk * 2 * S + o;
        cf v[R];
#pragma unroll
        for (int j = 0; j < R; ++j) v[j] = X[fpad(base + j * q)];
        dif_regs<LR>(v, W, N, q, o);
#pragma unroll
        for (int j = 0; j < R; ++j) X[fpad(base + j * q)] = v[j];
    }
}
template <int LR> HD_INLINE void dit_pass(XP(cf) X, XP(const cf) W, int N, int s0, int tid, int nthr) {
    constexpr int R = 1 << LR;
#pragma unroll 1
    for (int bf = tid; bf < N / R; bf += nthr) {
        const int blk = bf / s0, o = bf - blk * s0, base = blk * R * s0 + o;
        cf v[R];
#pragma unroll
        for (int j = 0; j < R; ++j) v[j] = X[fpad(base + j * s0)];
        dit_regs<LR>(v, W, N, s0, o);
#pragma unroll
        for (int j = 0; j < R; ++j) X[fpad(base + j * s0)] = v[j];
    }
}
#endif
#undef HD_INLINE
#undef XP
constexpr int FFT_W_OFF = (8192 + 512 + 16) * 8;
template <int RA> struct FftIn { float ktv[RA]; unsigned up0[RA / 2], up1[RA / 2]; };
template <int RA> __device__ __forceinline__ void fft_load_kt(FftIn<RA>& in, const float* kt, int tid) {
#pragma unroll
    for (int j = 0; j < RA; ++j) in.ktv[j] = kt[tid + 256 * j]; }
template <int RA> __device__ __forceinline__ void fft_load_u(unsigned (&up)[RA / 2], const bf16* u0, int L, int tid) {
#pragma unroll
    for (int j = 0; j < RA / 2; ++j) up[j] = (unsigned)u0[tid + 256 * j] | ((unsigned)u0[(size_t)L + tid + 256 * j] << 16); }
template <int LOG2N> __device__ __forceinline__ void fft_conv_channel(const Frame& F, FftIn<(LOG2N == 13) ? 32 : 16>& in, const float* kt_next, bf16* u, const bf16* u_next, int L) {
    constexpr int N = 1 << LOG2N, LRA = (LOG2N == 13) ? 5 : 4, RA = 1 << LRA, NIN_A = RA / 2, NT1 = N / RA;
    static_assert(NT1 == 256, "stride");
    LAS cf* X = (LAS cf*)F.lds; const LAS cf* W = (const LAS cf*)(F.lds + FFT_W_OFF);
    int tid = F.tid; asm volatile("" : "+v"(tid));
    const bool t1 = tid < NT1;
    const bool hn = kt_next != nullptr;
    if (t1) {
        cf v[RA];
#pragma unroll
        for (int j = 0; j < RA; ++j) v[j] = cf{in.ktv[j], 0.f};
        dif_regs<LRA>(v, W, N, NT1, tid);
#pragma unroll
        for (int j = 0; j < RA; ++j) X[fpad(tid + NT1 * j)] = v[j];
    }
    __syncthreads();
    dif_pass<4>(X, W, N, 128, tid, NTHR);
    __syncthreads();
    cf kf[16];
    if (tid < N / 16) {
#pragma unroll
        for (int j = 0; j < 16; ++j) kf[j] = X[fpad(tid * 16 + j)];
        dif_regs<4>(kf, W, N, 1, 0);
#pragma unroll
        for (int j = 0; j < 16; ++j) kf[j] = cscale(kf[j], 1.0f / N);
    } else {
#pragma unroll
        for (int j = 0; j < 16; ++j) kf[j] = cf{0.f, 0.f};
    }
    __syncthreads();
#pragma unroll
    for (int pr = 0; pr < 2; ++pr) {
        bf16* u0 = u + (size_t)(2 * pr) * L; bf16* u1 = u0 + L;
        if (t1) { cf v[RA];
#pragma unroll
          for (int j = 0; j < RA; ++j) { const unsigned w = (j < NIN_A) ? (pr ? in.up1[j < NIN_A ? j : 0] : in.up0[j < NIN_A ? j : 0]) : 0u; v[j] = (j < NIN_A) ? cf{__uint_as_float(w << 16), __uint_as_float(w & 0xffff0000u)} : cf{0.f, 0.f}; }
          if (hn) { if (pr == 0) fft_load_u<RA>(in.up0, u_next, L, tid); else fft_load_u<RA>(in.up1, u_next + (size_t)2 * L, L, tid); }
          dif_regs<LRA>(v, W, N, NT1, tid);
#pragma unroll
          for (int j = 0; j < RA; ++j) X[fpad(tid + NT1 * j)] = v[j]; }
        __syncthreads();
        dif_pass<4>(X, W, N, 128, tid, NTHR);
        __syncthreads();
        if (tid < N / 16) { cf v[16];
#pragma unroll
            for (int j = 0; j < 16; ++j) v[j] = X[fpad(tid * 16 + j)];
            dif_regs<4>(v, W, N, 1, 0);
#pragma unroll
            for (int j = 0; j < 16; ++j) v[j] = cmul(v[j], kf[j]);
            dit_regs<4>(v, W, N, 1, 0);
#pragma unroll
            for (int j = 0; j < 16; ++j) X[fpad(tid * 16 + j)] = v[j]; }
        if (pr == 1 && hn && t1) fft_load_kt<RA>(in, kt_next, tid);
        __syncthreads();
        dit_pass<4>(X, W, N, 16, tid, NTHR);
        __syncthreads();
        if (t1) { cf v[RA];
#pragma unroll
          for (int j = 0; j < RA; ++j) v[j] = X[fpad(tid + NT1 * j)];
          dit_regs<LRA>(v, W, N, NT1, tid);
#pragma unroll
          for (int j = 0; j < NIN_A; ++j) { u0[tid + NT1 * j] = (bf16)(pk2f(v[j].x, 0.f) & 0xffffu); u1[tid + NT1 * j] = (bf16)(pk2f(v[j].y, 0.f) & 0xffffu); } }
        __syncthreads();
    }
}
template <int LOG2N> __device__ __forceinline__ void fft_channels(const Frame& F, const float* KTb, bf16* UTb, int L) {
    constexpr int RA = (LOG2N == 13) ? 32 : 16; constexpr size_t KS = (size_t)1 << LOG2N;
    int c = F.vcu; if (c >= HW) return;
    FftIn<RA> in;
    { int tid = F.tid; asm volatile("" : "+v"(tid));
      if (tid < 256) { fft_load_kt<RA>(in, KTb + (size_t)c * KS, tid); fft_load_u<RA>(in.up0, UTb + (size_t)c * 4 * L, L, tid); fft_load_u<RA>(in.up1, UTb + (size_t)c * 4 * L + (size_t)2 * L, L, tid); } }
#pragma unroll 1
    for (; c < HW; c += F.G) { const int cn = c + F.G; const bool hn = cn < HW;
        fft_conv_channel<LOG2N>(F, in, hn ? KTb + (size_t)cn * KS : nullptr, UTb + (size_t)c * 4 * L, hn ? UTb + (size_t)cn * 4 * L : nullptr, L); }
}
__device__ __forceinline__ void h2_phase(const Frame& F, const float* KT, bf16* UT) {
    LAS cf* W = (LAS cf*)(F.lds + FFT_W_OFF);
    for (int k = F.tid; k < 4096; k += NTHR) { const float a = (float)k * (1.0f / 4096.0f); W[wpad(k)] = cf{cospif(a), -sinpif(a)}; }
    __syncthreads();
    fft_channels<13>(F, KT, UT, LP);
    __syncthreads();
    for (int k = F.tid; k < 2048; k += NTHR) { const float a = (float)k * (1.0f / 2048.0f); W[wpad(k)] = cf{cospif(a), -sinpif(a)}; }
    __syncthreads();
    fft_channels<12>(F, KT + (size_t)HW * 8192, UT + (size_t)HW * 4 * LP, LS);
    __syncthreads();
}

constexpr int ATT_KROW = 272, ATT_VROW = 648, ATT_BIAS_OFF = 320 * ATT_KROW, ATT_OROW = 272;
#define MFMA32(a, b, c) __builtin_amdgcn_mfma_f32_32x32x16_bf16((a), (b), (c), 0, 0, 0)
__device__ __forceinline__ void attn_phase(const Frame& F, const Args& A, const bf16* QKV, bf16* ATT) {
    const int g4 = F.wave >> 1, sub = F.wave & 1;
    LAS unsigned char* lds = F.lds;
    LAS float* BIAS = (LAS float*)(lds + ATT_BIAS_OFF);
    { const float* rel_bias = A.in[4];
      for (int idx = F.tid; idx < 16 * 257; idx += NTHR) { const int hh = idx / 257, ri = idx - hh * 257, rel = ri - 128, n = rel < 0 ? -rel : rel; int b;
          if (n < 8) b = n; else { int e = 0; while ((64 << (e + 1)) <= n * n) ++e; b = 8 + e; if (b > 15) b = 15; }
          if (rel > 0) b += 16;
          BIAS[hh * 260 + ri] = rel_bias[b * 16 + hh] * 1.44269504089f; } }
    __syncthreads();
    v4u kpre[10]; bf16x8 qf[8];
    auto unit_geom = [&](int unit, int& kvh, int& q0, int& L, int& rowbase) __attribute__((always_inline)) { kvh = unit & 3; const int tile = unit >> 2;
        if (tile < 256) { rowbase = (tile >> 6) * LP; q0 = (tile & 63) * 64; L = LP; } else { const int t2 = tile - 256; rowbase = MP + (t2 >> 5) * LS; q0 = (t2 & 31) * 64; L = LS; } };
    auto issue_k = [&](int unit, int lane) __attribute__((always_inline)) { int kvh, q0, L, rowbase; unit_geom(unit, kvh, q0, L, rowbase); const int rl = lane >> 4, ch = lane & 15;
#pragma unroll
        for (int i = 0; i < 10; ++i) { const int row = (F.wave * 10 + i) * 4 + rl, kp = q0 - 128 + row; kpre[i] = (v4u){0u, 0u, 0u, 0u};
            if (kp >= 0 && kp < L) kpre[i] = *(const v4u*)(QKV + (size_t)(rowbase + kp) * 3072 + 2048 + kvh * 128 + ch * 8); } };
    auto issue_q = [&](int unit, int lane) __attribute__((always_inline)) { int kvh, q0, L, rowbase; unit_geom(unit, kvh, q0, L, rowbase); const int r = lane & 31, h = lane >> 5, hq = kvh * 4 + g4;
        const bf16* qp = QKV + (size_t)(rowbase + q0 + sub * 32 + r) * 3072 + hq * 128 + 8 * h;
#pragma unroll
        for (int s = 0; s < 8; ++s) qf[s] = *(const bf16x8*)(qp + 16 * s); };
    if (F.vcu < 1536) { int lane0 = F.lane; asm volatile("" : "+v"(lane0)); issue_k(F.vcu, lane0); issue_q(F.vcu, lane0); }
#pragma unroll 1
    for (int unit = F.vcu; unit < 1536; unit += F.G) {
        int lane = F.lane; asm volatile("" : "+v"(lane));
        const int r = lane & 31, h = lane >> 5;
        int kvh, q0, L, rowbase; unit_geom(unit, kvh, q0, L, rowbase);
        const int hq = kvh * 4 + g4;
        { const int rl = lane >> 4, ch = lane & 15;
#pragma unroll
          for (int i = 0; i < 10; ++i) { const int row = (F.wave * 10 + i) * 4 + rl; *(LAS v4u*)(lds + row * ATT_KROW + ch * 16) = kpre[i]; } }
        __syncthreads();
        f32x16 sacc[9];
        { const LAS unsigned char* kb = lds + (sub * 32 + r) * ATT_KROW + h * 16;
#pragma unroll
          for (int kt = 0; kt < 9; ++kt) {
#pragma unroll
              for (int e = 0; e < 16; ++e) sacc[kt][e] = 0.f;
#pragma unroll
              for (int s = 0; s < 8; ++s) { const bf16x8 a = *(const LAS bf16x8*)(kb + kt * 32 * ATT_KROW + s * 32); sacc[kt] = MFMA32(a, qf[s], sacc[kt]); }
              __builtin_amdgcn_sched_barrier(0);
          } }
        v4u vv[10];
#pragma unroll
        for (int i = 0; i < 10; ++i) { const int combo = F.wave * 10 + i, kg = combo % 5, ch = combo / 5, kp = q0 - 128 + kg * 64 + lane; vv[i] = (v4u){0u, 0u, 0u, 0u};
            if (kp >= 0 && kp < L) vv[i] = *(const v4u*)(QKV + (size_t)(rowbase + kp) * 3072 + 2560 + kvh * 128 + ch * 8); }
        const float sink = A.in[7][hq] * 1.44269504089f;
        float mx = sink;
        const bool interior = (q0 >= 128) && (q0 + 192 <= L);
        { const int qpos = q0 + sub * 32 + r, relb = 4 * h - 128 - r; const LAS float* bh = BIAS + hq * 260 + 128 + relb;
#pragma unroll
          for (int kt = 0; kt < 9; ++kt) {
              if (interior && kt >= 1 && kt <= 7) {
#pragma unroll
                  for (int e = 0; e < 16; ++e) { const float sv = sacc[kt][e] + bh[kt * 32 + (e & 3) + 8 * (e >> 2)]; sacc[kt][e] = sv; mx = fmaxf(mx, sv); }
              } else {
#pragma unroll
              for (int e = 0; e < 16; ++e) { const int ro = kt * 32 + (e & 3) + 8 * (e >> 2); const int rel = relb + ro; const int kp = qpos + rel;
                  bool ok = kp >= 0 && kp < L; float bv;
                  if (kt == 0) { ok = ok && rel >= -128; bv = bh[ok ? ro : -relb]; }
                  else if (kt == 8) { ok = ok && rel <= 128; bv = bh[ok ? ro : -relb]; }
                  else bv = bh[ro];
                  const float sv = ok ? sacc[kt][e] + bv : -1e30f; sacc[kt][e] = sv; mx = fmaxf(mx, sv); }
              }
              __builtin_amdgcn_sched_barrier(0);
          } }
        mx = fmaxf(mx, shx(mx, 32, lane));
        float sum = 0.f;
        bf16x8 pf[9][2];
#pragma unroll
        for (int kt = 0; kt < 9; ++kt) {
#pragma unroll
            for (int e = 0; e < 16; ++e) { const float p = __builtin_amdgcn_exp2f(sacc[kt][e] - mx); sacc[kt][e] = p; sum += p; }
#pragma unroll
            for (int s2 = 0; s2 < 2; ++s2) { v4u w;
                w.x = pk2f(sacc[kt][8 * s2 + 0], sacc[kt][8 * s2 + 1]); w.y = pk2f(sacc[kt][8 * s2 + 2], sacc[kt][8 * s2 + 3]);
                w.z = pk2f(sacc[kt][8 * s2 + 4], sacc[kt][8 * s2 + 5]); w.w = pk2f(sacc[kt][8 * s2 + 6], sacc[kt][8 * s2 + 7]);
                pf[kt][s2] = __builtin_bit_cast(bf16x8, w); }
            __builtin_amdgcn_sched_barrier(0);
        }
        sum += shx(sum, 32, lane);
        const float inv = 1.0f / (sum + __builtin_amdgcn_exp2f(sink - mx));
        __syncthreads();
#pragma unroll
        for (int i = 0; i < 10; ++i) { const int combo = F.wave * 10 + i, kg = combo % 5, ch = combo / 5; LAS bf16* vp = (LAS bf16*)(lds + (ch * 8) * ATT_VROW + (kg * 64 + lane) * 2);
            vp[0 * 324] = (bf16)(vv[i].x & 0xffffu); vp[1 * 324] = (bf16)(vv[i].x >> 16); vp[2 * 324] = (bf16)(vv[i].y & 0xffffu); vp[3 * 324] = (bf16)(vv[i].y >> 16);
            vp[4 * 324] = (bf16)(vv[i].z & 0xffffu); vp[5 * 324] = (bf16)(vv[i].z >> 16); vp[6 * 324] = (bf16)(vv[i].w & 0xffffu); vp[7 * 324] = (bf16)(vv[i].w >> 16); }
        __syncthreads();
        f32x16 oacc[4];
#pragma unroll
        for (int dt = 0; dt < 4; ++dt)
#pragma unroll
            for (int e = 0; e < 16; ++e) oacc[dt][e] = 0.f;
        { const LAS unsigned char* vb0 = lds + r * ATT_VROW + (sub * 32 + 4 * h) * 2;
#pragma unroll
          for (int kt = 0; kt < 9; ++kt)
#pragma unroll
              for (int s2 = 0; s2 < 2; ++s2) {
#pragma unroll
                  for (int dt = 0; dt < 4; ++dt) { const LAS unsigned char* vb = vb0 + dt * 32 * ATT_VROW + (kt * 32 + 16 * s2) * 2;
                      const s16x4 lo = *(const LAS s16x4*)vb, hi = *(const LAS s16x4*)(vb + 16);
                      const bf16x8 bfr = {lo[0], lo[1], lo[2], lo[3], hi[0], hi[1], hi[2], hi[3]};
                      oacc[dt] = MFMA32(pf[kt][s2], bfr, oacc[dt]); }
                  if (kt == 4 && s2 == 1) issue_k(unit + F.G < 1536 ? unit + F.G : unit, lane);
                  if (kt == 8 && s2 == 1) issue_q(unit + F.G < 1536 ? unit + F.G : unit, lane);
                  __builtin_amdgcn_sched_barrier(0); } }
        __syncthreads();
        { LAS unsigned char* ob = lds + F.wave * (32 * ATT_OROW);
          LAS bf16* ow = (LAS bf16*)(ob + (4 * h) * ATT_OROW + r * 2);
          float invq[16];
#pragma unroll
          for (int e = 0; e < 16; ++e) invq[e] = __int_as_float(__builtin_amdgcn_ds_bpermute(((e & 3) + 8 * (e >> 2) + 4 * h) << 2, __float_as_int(inv)));
#pragma unroll
          for (int dt = 0; dt < 4; ++dt)
#pragma unroll
              for (int e = 0; e < 16; ++e) ow[((e & 3) + 8 * (e >> 2)) * (ATT_OROW / 2) + dt * 32] = (bf16)(pk2f(oacc[dt][e] * invq[e], 0.f) & 0xffffu);
          LDS_WAIT(); asm volatile("" ::: "memory");
          bf16* op = ATT + (size_t)(rowbase + q0 + sub * 32 + (lane >> 4)) * 2048 + hq * 128 + (lane & 15) * 8;
          const LAS unsigned char* orp = ob + (lane >> 4) * ATT_OROW + (lane & 15) * 16;
#pragma unroll
          for (int i = 0; i < 8; ++i) *(v4u*)(op + (size_t)i * 4 * 2048) = *(const LAS v4u*)(orp + i * 4 * ATT_OROW); }
        __syncthreads();
    }
}

__device__ __forceinline__ void attn_naive(const Frame& F, const Args& A, const bf16* QKV, bf16* ATT) {
    const float* rel_bias = A.in[4]; const int lane = F.lane;
    const int gw = F.vcu * NWAVES + F.wave, NGW = F.G * NWAVES;
#pragma unroll 1
    for (int item = gw; item < M * 16; item += NGW) {
        const int row = item >> 4, hq = item & 15, kvh = hq >> 2;
        int L, rowbase, t;
        if (row < MP) { L = LP; rowbase = row & ~(LP - 1); t = row & (LP - 1); } else { L = LS; const int r2 = row - MP; rowbase = MP + (r2 & ~(LS - 1)); t = r2 & (LS - 1); }
        const bf16* qp = QKV + (size_t)row * 3072 + hq * 128;
        const float q0 = __uint_as_float((unsigned)qp[lane] << 16), q1 = __uint_as_float((unsigned)qp[64 + lane] << 16);
        float m = A.in[7][hq] * 1.44269504089f, l = 1.0f, o0 = 0.f, o1 = 0.f;
        const int jlo = t - 128 < 0 ? 0 : t - 128, jhi = t + 128 > L - 1 ? L - 1 : t + 128;
#pragma unroll 1
        for (int j = jlo; j <= jhi; ++j) {
            const bf16* kp = QKV + (size_t)(rowbase + j) * 3072 + 2048 + kvh * 128; const bf16* vp = kp + 512;
            float s = q0 * __uint_as_float((unsigned)kp[lane] << 16) + q1 * __uint_as_float((unsigned)kp[64 + lane] << 16);
#pragma unroll
            for (int o = 1; o < 64; o <<= 1) s += shx(s, o, lane);
            const int rel = j - t, n = rel < 0 ? -rel : rel; int b;
            if (n < 8) b = n; else { int e = 0; while ((64 << (e + 1)) <= n * n) ++e; b = 8 + e; if (b > 15) b = 15; }
            if (rel > 0) b += 16;
            s += rel_bias[b * 16 + hq] * 1.44269504089f;
            const float mn = fmaxf(m, s), sc = exp2f(m - mn), p = exp2f(s - mn);
            l = l * sc + p; o0 = o0 * sc + p * __uint_as_float((unsigned)vp[lane] << 16); o1 = o1 * sc + p * __uint_as_float((unsigned)vp[64 + lane] << 16); m = mn;
        }
        bf16* op = ATT + (size_t)row * 2048 + hq * 128;
        op[lane] = (bf16)(pk2f(o0 / l, 0.f) & 0xffffu); op[64 + lane] = (bf16)(pk2f(o1 / l, 0.f) & 0xffffu);
    }
}

#ifndef DIAG_CLOCK
#define DIAG_CLOCK 0
#endif
__device__ __forceinline__ void p0_prologue(Frame F, const Args& A, unsigned char* ws, unsigned char* dob) {
    LAS float* scr = (LAS float*)(F.lds + F.wave * 16384);
    const int gw = F.vcu * NWAVES + F.wave, NGW = F.G * NWAVES;
    constexpr int I_IN = (DM / 64) * (NIN / 32), I_AO = (AW / 64) * (DM / 32), I_HO = (HW / 64) * (DM / 32), I_OUT = (DM / 64) * (DM / 32), I_UP = (DM / 64) * (2 * FF / 32), I_DN = (FF / 64) * (DM / 32), I_PG = (DM / 64) * (DM / 32), I_PL = (PLE / 64) * (DM / 32);
    constexpr int NITEMS = I_IN + I_AO + I_HO + I_OUT + I_UP;
    auto decode = [&](int it) -> TrItem { int r = it;
        if (r < I_IN) { TrItem t = tr_item(A.in[6], DM, NIN, (bf16*)(ws + WS_WIN), nullptr, r); if (t.n0 >= 36 * 256) t.sc = -1.44269504089f; else if (t.n0 < 2048) t.sc = 0.08838834764831845f * 1.4426950408889634f; return t; } r -= I_IN;
        if (r < I_AO) return tr_item(A.in[19], AW, DM, (bf16*)(ws + WS_WAO), nullptr, r); r -= I_AO;
        if (r < I_HO) return tr_item(A.in[20], HW, DM, (bf16*)(ws + WS_WHO), nullptr, r); r -= I_HO;
        if (r < I_OUT) return tr_item(A.in[21], DM, DM, (bf16*)(ws + WS_WOUT), nullptr, r); r -= I_OUT;
        return tr_item(A.in[23], DM, 2 * FF, (bf16*)(ws + WS_WUP), A.in[22], r); };
    const bool h0first_ = (((int)blockIdx.x >> 3) & 1) != 0;
    if (h0first_) { refresh(F); h0_phase(F, A, (float*)(dob + DO_KT)); __syncthreads(); refresh(F); }
    if (gw < NITEMS) {
        float wa[32], wb[32]; TrItem ci = decode(gw); tr_load(ci, F.lane, wa);
#pragma unroll 1
        for (int it = gw; it < NITEMS; it += NGW) {
            const bool more = it + NGW < NITEMS; TrItem ni = ci;
            if (more) { ni = decode(it + NGW); tr_load(ni, F.lane, wb); }
            tr_store(ci, F.lane, wa, scr);
            if (more) {
#pragma unroll
                for (int i = 0; i < 32; ++i) wa[i] = wb[i];
                ci = ni; }
        }
    }
    if (DIAG_CLOCK >= 15 && blockIdx.x == 0) { __syncthreads(); if (threadIdx.x == 0) ((unsigned long long*)(ws + WS_CTL + 16384))[50] = wall_clock64(); }
    refresh(F);
    rms_phase_bf16(F, A.in[0], A.in[1], A.in[5], (bf16*)(dob + DO_XN));
    refresh(F);
    { bf16* PB = (bf16*)(ws + WS_PB); const size_t gt = (size_t)F.vcu * NTHR + F.tid, GT_ = (size_t)F.G * NTHR;
      constexpr size_t NQ = (size_t)M * PLE / 4;
      f32x4 v[12];
#pragma unroll
      for (int q = 0; q < 12; ++q) { const size_t i = gt + (size_t)q * GT_, e = i * 4; v[q] = (f32x4){0.f, 0.f, 0.f, 0.f}; if (i < NQ) v[q] = *(const f32x4*)(e < (size_t)MP * PLE ? A.in[2] + e : A.in[3] + (e - (size_t)MP * PLE)); }
#pragma unroll
      for (int q = 0; q < 12; ++q) { const size_t i = gt + (size_t)q * GT_, e = i * 4; if (i < NQ) *(unsigned long long*)(PB + e) = (unsigned long long)pk2f(v[q].x, v[q].y) | ((unsigned long long)pk2f(v[q].z, v[q].w) << 32); }
      for (size_t i = gt + 12 * GT_; i < NQ; i += GT_) { const size_t e = i * 4; const float* src = e < (size_t)MP * PLE ? A.in[2] + e : A.in[3] + (e - (size_t)MP * PLE);
          const f32x4 w = *(const f32x4*)src; *(unsigned long long*)(PB + e) = (unsigned long long)pk2f(w.x, w.y) | ((unsigned long long)pk2f(w.z, w.w) << 32); } }
    if (!h0first_) { __syncthreads(); refresh(F); h0_phase(F, A, (float*)(dob + DO_KT)); }
    if (DIAG_CLOCK >= 15 && blockIdx.x == 0) { __syncthreads(); if (threadIdx.x == 0) ((unsigned long long*)(ws + WS_CTL + 16384))[52] = wall_clock64(); }
}

__device__ __forceinline__ void tail_transpose_wdown(Frame F, const Args& A, unsigned char* ws, int blk0, int nblk) {
    const int b = (int)blockIdx.x - blk0; if (b < 0 || b >= nblk) return;
    refresh(F);
    LAS float* scr = (LAS float*)(F.lds + F.wave * 16384);
    constexpr int I_DN0 = (FF / 64) * (DM / 32), I_PG = (DM / 64) * (DM / 32), I_PL = (PLE / 64) * (DM / 32), I_DN = I_DN0 + I_PG + I_PL;
    auto tdec = [&](int r) -> TrItem { if (r < I_DN0) return tr_item(A.in[26], FF, DM, (bf16*)(ws + WS_WDN), nullptr, r); r -= I_DN0;
        if (r < I_PG) return tr_item(A.in[28], DM, DM, (bf16*)(ws + WS_WPG), A.in[27], r); r -= I_PG; return tr_item(A.in[29], PLE, DM, (bf16*)(ws + WS_WPL), nullptr, r); };
    const int w0 = b * NWAVES + F.wave, NW = nblk * NWAVES;
    if (w0 < I_DN) {
        float wa[32], wb[32]; TrItem ci = tdec(w0); tr_load(ci, F.lane, wa);
#pragma unroll 1
        for (int it = w0; it < I_DN; it += NW) {
            const bool more = it + NW < I_DN; TrItem ni = ci;
            if (more) { ni = tdec(it + NW); tr_load(ni, F.lane, wb); }
            tr_store(ci, F.lane, wa, scr);
            if (more) {
#pragma unroll
                for (int i = 0; i < 32; ++i) wa[i] = wb[i];
                ci = ni; }
        }
    }
}
constexpr int N_PHASES = 16;

#ifndef DBL_MASK
#define DBL_MASK 0
#endif
#ifndef DIAG_NAIVE_ATTN
#define DIAG_NAIVE_ATTN 0
#endif
__global__ void __launch_bounds__(NTHR, 2) fwd_kernel(Args args) {
    extern __shared__ __attribute__((aligned(16))) unsigned char lds[];
    Frame F;
    F.lds = (LAS unsigned char*)lds;
    volatile LAS unsigned* MISC = (volatile LAS unsigned*)(F.lds + MISC_OFF);
    F.wave = __builtin_amdgcn_readfirstlane((int)threadIdx.x >> 6); refresh(F);
    F.G = gridDim.x; { const int bx = blockIdx.x; F.vcu = (F.G % 8 == 0) ? (bx % 8) * (F.G / 8) + bx / 8 : bx; }
    unsigned char* ws = args.ws; unsigned char* dob = (unsigned char*)args.out;
    for (int u = F.tid; u < (LDS_BYTES - LDSCTL_OFF) / 4; u += NTHR) ((LAS unsigned*)(F.lds + LDSCTL_OFF))[u] = 0u;
    __syncthreads();
    XcdBarrier bar = xcd_barrier_post((unsigned*)(ws + WS_CTL) + CW_BAR, MISC + 8);
    const int lo = args.ph_lo, hi = args.ph_hi;
#ifdef ONLY_PHASE
#define IN(k) ((k) == ONLY_PHASE && lo <= (k))
#else
#define IN(k) (lo <= (k) && (k) < hi)
#endif
#define SEAM(k) do { if (IN(k) && IN((k) + 1)) xcd_barrier(bar); if (DIAG_CLOCK >= 3 && blockIdx.x == 0 && threadIdx.x == 0) ((unsigned long long*)(ws + WS_CTL + 16384))[(k) + 1] = wall_clock64(); } while (0)
#define REF() refresh(F)
    bf16* const QKV = (bf16*)(ws + WS_QKV); bf16* const HY = (bf16*)(ws + WS_HY); bf16* const GT = (bf16*)(ws + WS_GT);
    bf16* const ATT = (bf16*)(dob + DO_ATT); bf16* const HYO = (bf16*)(ws + WS_HYO); bf16* const TM = (bf16*)(ws + WS_TM);
    bf16* const XN2 = (bf16*)(ws + WS_XN2); bf16* const GU = (bf16*)(ws + WS_GU); bf16* const ACT = (bf16*)(ws + WS_ACT); bf16* const PP = (bf16*)(ws + WS_PP);
#ifndef USE_DYN
#define USE_DYN 0
#endif
#define DQ(i) (USE_DYN ? (unsigned*)(ws + WS_CTL + 786432) + (i) * 512 : (unsigned*)nullptr), (MISC + 16)
    float* const SS1 = (float*)(ws + WS_CTL + 262144); float* const SS2 = (float*)(ws + WS_CTL + 393216); float* const SS3 = (float*)(ws + WS_CTL + 524288); bf16* const X3 = (bf16*)(ws + WS_ACT);
    bf16* const GUS = (bf16*)dob;
    bf16* const UT = (bf16*)(dob + DO_UT); float* const KT = (float*)(dob + DO_KT); float* const OUT = args.out;

    if (DIAG_CLOCK >= 3 && blockIdx.x == 0 && threadIdx.x == 0) ((unsigned long long*)(ws + WS_CTL + 16384))[0] = wall_clock64();
    if (IN(0)) for (int rep_ = 0; rep_ < 1 + ((DBL_MASK >> 0) & 1); ++rep_) { if (rep_) __syncthreads(); REF(); p0_prologue(F, args, ws, dob); } SEAM(0);
    unsigned long long dc0_ = 0, dw0_ = 0; if (DIAG_CLOCK) { dc0_ = clock64(); dw0_ = wall_clock64(); }
    if (IN(1)) for (int rep_ = 0; rep_ < 1 + ((DBL_MASK >> 1) & 1); ++rep_) { if (rep_) __syncthreads(); REF(); pg8::Gemm g{(const bf16*)(dob + DO_XN), (const bf16*)(ws + WS_WIN), M, NIN, DM}; pg8::StaticOrder S; S.init(M, NIN, F.G, (int)blockIdx.x);
        pg8::EpiIn E{QKV, HY, GT}; pg8::gemm_phase<pg8::EpiIn, pg8::StaticOrder, true, true>(F.lds, g, S, E, F.tid, DIAG_CLOCK == 2 ? (float*)(ws + WS_CTL) + 3001 : nullptr, DQ(0)); }
    if (IN(1)) { const int nu = (M / 256) * (NIN / 256), rem = nu % F.G; if (rem) tail_transpose_wdown(F, args, ws, rem, F.G - rem); else tail_transpose_wdown(F, args, ws, 0, F.G); }
    if (DIAG_CLOCK == 8 && blockIdx.x == 0 && threadIdx.x == 0) ((unsigned long long*)(ws + WS_CTL + 16384))[40] = wall_clock64();
    if (DIAG_CLOCK == 7 && threadIdx.x == 0) ((unsigned long long*)(ws + WS_CTL + 32768))[blockIdx.x] = wall_clock64();
    if (DIAG_CLOCK && blockIdx.x == 0 && threadIdx.x == 0) { const unsigned long long dc1_ = clock64(), dw1_ = wall_clock64(); ((float*)(ws + WS_CTL))[3000] = (float)(dc1_ - dc0_) / (float)(dw1_ - dw0_) * 0.1f; }
    SEAM(1);
    if (IN(2)) for (int rep_ = 0; rep_ < 1 + ((DBL_MASK >> 2) & 1); ++rep_) { if (rep_) __syncthreads();
        if (((int)blockIdx.x >> 3) & 1) { REF(); h1_phase(F, args, HY, UT); __syncthreads(); REF(); attn_phase(F, args, QKV, ATT); }
        else { REF(); attn_phase(F, args, QKV, ATT); __syncthreads(); REF(); h1_phase(F, args, HY, UT); } } SEAM(2);
    if (IN(3)) { REF(); h2_phase(F, KT, UT); } SEAM(3);
    if (IN(4)) for (int rep_ = 0; rep_ < 1 + ((DBL_MASK >> 4) & 1); ++rep_) { if (rep_) __syncthreads(); REF(); h3_phase(F, args, HY, UT, HYO); } SEAM(4);
    if (IN(5)) for (int rep_ = 0; rep_ < 1 + ((DBL_MASK >> 5) & 1); ++rep_) { if (rep_) __syncthreads(); REF();
        { pg8::Gemm g{ATT, (const bf16*)(ws + WS_WAO), M, DM, AW}; pg8::StaticOrder S; S.init(M, DM, F.G, (int)blockIdx.x);
          pg8::EpiGate<0> E{GT, TM}; pg8::gemm_phase<pg8::EpiGate<0>, pg8::StaticOrder, true, true>(F.lds, g, S, E, F.tid); }
        { pg8::Gemm g{HYO, (const bf16*)(ws + WS_WHO), M, DM, HW}; pg8::StaticOrder S; S.init(M, DM, F.G, (int)blockIdx.x);
          pg8::EpiGate<1> E{GT, TM}; pg8::gemm_phase<pg8::EpiGate<1>, pg8::StaticOrder, true, true>(F.lds, g, S, E, F.tid); }
    } SEAM(5);
    if (IN(6)) for (int rep_ = 0; rep_ < 1 + ((DBL_MASK >> 6) & 1); ++rep_) { if (rep_) __syncthreads(); REF(); pg8::Gemm g{TM, (const bf16*)(ws + WS_WOUT), M, DM, DM}; pg8::StaticOrder S; S.init(M, DM, F.G, (int)blockIdx.x);
        pg8::EpiRes E{args.in[0], args.in[1], MP, XN2, SS1}; pg8::gemm_phase<pg8::EpiRes, pg8::StaticOrder, true, true>(F.lds, g, S, E, F.tid, nullptr, DQ(1)); } SEAM(6);
    if (IN(8)) for (int rep_ = 0; rep_ < 1 + ((DBL_MASK >> 8) & 1); ++rep_) { if (rep_) __syncthreads(); REF(); pg8::Gemm g{XN2, (const bf16*)(ws + WS_WUP), MP, FF, DM}; pg8::StaticOrder S; S.init(MP, FF, F.G, (int)blockIdx.x);
        pg8::EpiStore E{GU, FF, SS1}; pg8::gemm_phase<pg8::EpiStore, pg8::StaticOrder, true, true>(F.lds, g, S, E, F.tid, nullptr, DQ(2));
        { REF(); pg8::Gemm g2{XN2 + (size_t)MP * DM, (const bf16*)(ws + WS_WUP), MS, FF, DM}; pg8::RangeOrder R; R.init(MS, FF, F.G, (int)blockIdx.x); R.L0 = 0; R.L1 = F.G == 256 ? 64 : 0; R.c0 = 192; R.nb = 64;
          pg8::EpiStore E2{GUS, FF, SS1 + MP}; pg8::gemm_phase<pg8::EpiStore, pg8::RangeOrder, true, true>(F.lds, g2, R, E2, F.tid); } } SEAM(8);
    if (IN(9)) for (int rep_ = 0; rep_ < 1 + ((DBL_MASK >> 9) & 1); ++rep_) { if (rep_) __syncthreads(); REF(); pg8::Gemm g{XN2, (const bf16*)(ws + WS_WUP) + (size_t)FF * DM, MP, FF, DM}; pg8::StaticOrder S; S.init(MP, FF, F.G, (int)blockIdx.x);
        pg8::EpiGlu E{GU, ACT, args.in[24], args.in[25], LP, SS1}; pg8::gemm_phase<pg8::EpiGlu, pg8::StaticOrder, true, true>(F.lds, g, S, E, F.tid, nullptr, DQ(3));
        { REF(); pg8::Gemm g2{XN2 + (size_t)MP * DM, (const bf16*)(ws + WS_WUP), MS, FF, DM}; pg8::RangeOrder R; R.init(MS, FF, F.G, (int)blockIdx.x); R.L0 = 64; R.L1 = F.G == 256 ? 128 : 64; R.c0 = 192; R.nb = 64;
          pg8::EpiStore E2{GUS, FF, SS1 + MP}; pg8::gemm_phase<pg8::EpiStore, pg8::RangeOrder, true, true>(F.lds, g2, R, E2, F.tid); } } SEAM(9);
    if (IN(10)) { REF();
        { pg8::Gemm g{ACT, (const bf16*)(ws + WS_WDN), MP, DM, FF}; pg8::StaticOrder S; S.init(MP, DM, F.G, (int)blockIdx.x);
          pg8::EpiResB E{XN2, SS2}; pg8::gemm_phase<pg8::EpiResB, pg8::StaticOrder, true, true>(F.lds, g, S, E, F.tid, nullptr, DQ(4)); }
        if (DIAG_CLOCK == 11 && blockIdx.x == 0 && threadIdx.x == 0) ((unsigned long long*)(ws + WS_CTL + 16384))[41] = wall_clock64();
        { REF(); pg8::Gemm g{XN2 + (size_t)MP * DM, (const bf16*)(ws + WS_WUP), MS, FF, DM}; pg8::RangeOrder S; S.init(MS, FF, F.G, (int)blockIdx.x); S.L0 = F.G == 256 ? 128 : 0; S.L1 = (MS / 256) * (FF / 256); S.c0 = 0; S.nb = F.G;
          pg8::EpiStore E{GUS, FF, SS1 + MP}; pg8::gemm_phase<pg8::EpiStore, pg8::RangeOrder, true, true>(F.lds, g, S, E, F.tid); }
    } SEAM(10);
    if (IN(11)) for (int rep_ = 0; rep_ < 1 + ((DBL_MASK >> 11) & 1); ++rep_) { if (rep_) __syncthreads(); REF(); pg8::Gemm g{XN2 + (size_t)MP * DM, (const bf16*)(ws + WS_WUP) + (size_t)FF * DM, MS, FF, DM}; pg8::StaticOrder S; S.init(MS, FF, F.G, (int)blockIdx.x);
        pg8::EpiGlu E{GUS, ACT, args.in[24], args.in[25], LS, SS1 + MP}; pg8::gemm_phase<pg8::EpiGlu, pg8::StaticOrder, true, true>(F.lds, g, S, E, F.tid, nullptr, DQ(6));
        { REF(); pg8::Gemm g2{(const bf16*)(ws + WS_PB), (const bf16*)(ws + WS_WPL), M, DM, PLE}; pg8::RangeOrder R; R.init(M, DM, F.G, (int)blockIdx.x); R.L0 = 0; R.L1 = F.G == 256 ? 960 : 0; R.c0 = 96; R.nb = 160;
          pg8::EpiPP E2{PP}; pg8::gemm_phase<pg8::EpiPP, pg8::RangeOrder, true, true>(F.lds, g2, R, E2, F.tid); } } SEAM(11);
    if (IN(12)) { REF(); pg8::Gemm g{ACT, (const bf16*)(ws + WS_WDN), MS, DM, FF}; pg8::StaticOrder S; S.init(MS, DM, F.G, (int)blockIdx.x);
        pg8::EpiResB E{XN2 + (size_t)MP * DM, SS2 + MP}; pg8::gemm_phase<pg8::EpiResB, pg8::StaticOrder, true, true>(F.lds, g, S, E, F.tid, nullptr, DQ(7)); } SEAM(12);
    if (IN(14)) { REF();
        { pg8::Gemm g{(const bf16*)(ws + WS_PB), (const bf16*)(ws + WS_WPL), M, DM, PLE}; pg8::RangeOrder S; S.init(M, DM, F.G, (int)blockIdx.x); S.L0 = F.G == 256 ? 960 : 0; S.L1 = (M / 256) * (DM / 256); S.c0 = F.G == 256 ? 192 : 0; S.nb = F.G;
          pg8::EpiPP E{PP}; pg8::gemm_phase<pg8::EpiPP, pg8::RangeOrder, true, true>(F.lds, g, S, E, F.tid); }
        { pg8::Gemm g{XN2, (const bf16*)(ws + WS_WPG), M, DM, DM}; pg8::StaticOrder S; S.init(M, DM, F.G, (int)blockIdx.x);
          pg8::EpiPle E{PP, XN2, X3, SS2, SS3}; pg8::gemm_phase<pg8::EpiPle, pg8::StaticOrder, true, true>(F.lds, g, S, E, F.tid); }
    } SEAM(14);
    float dadd_ = 0.f;
    if (DIAG_CLOCK >= 3) { const unsigned long long* st_ = (const unsigned long long*)(ws + WS_CTL + 16384);
        auto T = [&](int a, int b) { return (float)(st_[b] - st_[a]) * 1e-5f; };
        float rv_ = 0.f;
        if (DIAG_CLOCK == 3) rv_ = 1e-4f * T(0, 1);
        if (DIAG_CLOCK == 4) rv_ = 3e-5f * T(1, 2);
        if (DIAG_CLOCK == 5) rv_ = 1e-4f * T(2, 5);
        if (DIAG_CLOCK == 6) rv_ = 3e-5f * T(5, 7);
        if (DIAG_CLOCK == 7) rv_ = 2e-5f * T(7, 13);
        if (DIAG_CLOCK == 9) rv_ = 1e-4f * T(13, 15);
        dadd_ = sqrtf(rv_); }
    if (IN(15)) { REF(); final_phase(F, X3, SS3, args.in[30], OUT, dadd_); }
#undef IN
#undef SEAM
#undef REF
#undef DQ
}

#ifndef MK_PER_PHASE
#define MK_PER_PHASE 0
#endif
extern "C" void kernel_launch(void* const* d_in, const int* in_sizes, int n_in, void* d_out, int out_size, void* d_ws, size_t ws_size, hipStream_t stream) {
    static int grid = 0;
    if (grid == 0) {
        if (n_in != 31 || out_size != M * DM || ws_size < WS_END) { fprintf(stderr, "kernel_launch: unexpected shapes (n_in %d out %d ws %zu)\n", n_in, out_size, ws_size); grid = -1; return; }
        int dev = 0, cus = 0, per_cu = 0;
        if (hipGetDevice(&dev) != hipSuccess || hipDeviceGetAttribute(&cus, hipDeviceAttributeMultiprocessorCount, dev) != hipSuccess) { grid = -1; return; }
        if (hipFuncSetAttribute((const void*)fwd_kernel, hipFuncAttributeMaxDynamicSharedMemorySize, LDS_BYTES) != hipSuccess) { fprintf(stderr, "kernel_launch: hipFuncSetAttribute failed\n"); grid = -1; return; }
        if (hipOccupancyMaxActiveBlocksPerMultiprocessor(&per_cu, (const void*)fwd_kernel, NTHR, LDS_BYTES) != hipSuccess || per_cu < 1) fprintf(stderr, "kernel_launch: occupancy query reports %d\n", per_cu);
        (void)hipGetLastError();
        grid = cus;
    }
    if (grid < 0) return;
    if (hipMemsetAsync((char*)d_ws + WS_CTL, 0, CTL_ZERO_BYTES, stream) != hipSuccess) return;
    Args a{};
    for (int i = 0; i < 31; ++i) a.in[i] = (const float*)d_in[i];
    a.out = (float*)d_out; a.ws = (unsigned char*)d_ws;
#if MK_PER_PHASE
    for (int p = 0; p < N_PHASES; ++p) { a.ph_lo = p; a.ph_hi = p + 1; hipLaunchKernelGGL(fwd_kernel, dim3(grid), dim3(NTHR), LDS_BYTES, stream, a); }
#else
    a.ph_lo = 0; a.ph_hi = N_PHASES;
    hipLaunchKernelGGL(fwd_kernel, dim3(grid), dim3(NTHR), LDS_BYTES, stream, a);
#endif
}
```

```cpp
#include <hip/hip_runtime.h>
#include <cstdio>
#include <cstdint>
namespace pg8 {
#define PG8_LAS __attribute__((address_space(3)))
typedef unsigned short bf16_t;
typedef short bf16x8 __attribute__((ext_vector_type(8)));
typedef float f32x4 __attribute__((ext_vector_type(4)));
typedef unsigned u32x4 __attribute__((ext_vector_type(4)));
constexpr int BM = 256, BK = 64, HALF = 128, HTB = HALF * BK * 2  , STAGE_BYTES = 8 * HTB, NXCD = 8, WGM = 4;

__host__ __device__ __forceinline__ int lds_byte(int r, int c) { const int st = (r >> 4) * 2 + (c >> 5), rr = r & 15, cc = c & 31, ob = rr * 64 + cc * 2; return st * 1024 + (ob ^ (((ob >> 9) & 1) << 5)); }
__host__ __device__ __forceinline__ void stage_rc(int b, int& R, int& C) { const int st = b / 1024, sb = b % 1024, swz = sb ^ (((sb >> 9) & 1) << 5); R = (st >> 1) * 16 + swz / 64; C = (st & 1) * 32 + (swz % 64) / 2; }
__host__ __device__ __forceinline__ int perm32(int rho) { const int n = rho >> 4, i = rho & 15; return 8 * (i >> 2) + 4 * n + (i & 3); }

struct Unit { int pm, pn; };
struct Gemm { const bf16_t* A; const bf16_t* Bt; int M, N, K; };

struct StaticOrder {
    int nM, nN, nwg, G, c;
    __host__ __device__ void init(int M, int N, int G_, int c_) { nM = M / BM; nN = N / BM; nwg = nM * nN; G = G_; c = c_; }
    __host__ __device__ bool next(int i, Unit& u) const {
        const long L = (long)i * G + c; if (L >= nwg) return false;
        unit_of(L, u); return true;
    }
    __host__ __device__ void unit_of(long L, Unit& u) const {
        int wgid = (int)L; { const int q = nwg / NXCD, r = nwg % NXCD, xcd = wgid % NXCD, off = wgid / NXCD; wgid = (xcd < r ? xcd * (q + 1) : r * (q + 1) + (xcd - r) * q) + off; }
        const int nig = WGM * nN, gid = wgid / nig, fm = gid * WGM, gsz = (nM - fm) < WGM ? (nM - fm) : WGM;
        u.pm = fm + ((wgid % nig) % gsz); u.pn = (wgid % nig) / gsz;
    }
    __device__ __forceinline__ void a_ready(const Unit&) const {}
    __device__ __forceinline__ void done(const Unit&) const {}
};
struct RangeOrder : StaticOrder {
    int L0, L1, c0, nb;
    __host__ __device__ bool next(int i, Unit& u) const { const int k = (c - c0 + G) % G; if (k >= nb) return false; const long L = (long)L0 + k + (long)i * nb; if (L >= L1) return false; unit_of(L, u); return true; }
};
__device__ __forceinline__ unsigned cvt_pk_bf16(float lo, float hi) { unsigned r; asm volatile("v_cvt_pk_bf16_f32 %0, %1, %2" : "=v"(r) : "v"(lo), "v"(hi)); return r; }
typedef float f32x2 __attribute__((ext_vector_type(2)));
__device__ __forceinline__ f32x2 gelu_pk(f32x2 v) {
    typedef unsigned u2_ __attribute__((ext_vector_type(2)));
    const f32x2 na = __builtin_bit_cast(f32x2, __builtin_bit_cast(u2_, v) | 0x80000000u);
    f32x2 p = na * 5.6212998061e-06f + (-5.1055209042e-05f); p = p * na + 3.9686136006e-05f; p = p * na + (-3.4227392171e-03f); p = p * na + 2.2076997906e-02f; p = p * na + (-5.2075162530e-02f); p = p * na + 1.0442737341f;
    p = p * p; p = p * p; p = p * p; p = p * p;
    f32x2 h; h.x = __builtin_amdgcn_rcpf(p.x); h.y = __builtin_amdgcn_rcpf(p.y);
    f32x2 rl; rl.x = fmaxf(v.x, 0.f); rl.y = fmaxf(v.y, 0.f);
    return __builtin_elementwise_fma(na, h, rl);
}
typedef unsigned u32x2 __attribute__((ext_vector_type(2)));
__device__ __forceinline__ unsigned pk2f(float lo, float hi) { typedef float f2_ __attribute__((ext_vector_type(2))); typedef __bf16 b2_ __attribute__((ext_vector_type(2))); return __builtin_bit_cast(unsigned, __builtin_convertvector((f2_){lo, hi}, b2_)); }
__device__ __forceinline__ float bflo(unsigned u) { return __uint_as_float(u << 16); }
__device__ __forceinline__ float bfhi(unsigned u) { return __uint_as_float(u & 0xffff0000u); }
__device__ __forceinline__ float sg2(float y) { return __builtin_amdgcn_rcpf(1.0f + __builtin_amdgcn_exp2f(y)); }
__device__ __forceinline__ float sigm(float x) { return __builtin_amdgcn_rcpf(1.0f + __builtin_amdgcn_exp2f(-1.44269504089f * x)); }
__device__ __forceinline__ u32x4 pack8(const f32x4 v0, const f32x4 v1) { u32x4 w; w.x = pk2f(v0[0], v0[1]); w.y = pk2f(v0[2], v0[3]); w.z = pk2f(v1[0], v1[1]); w.w = pk2f(v1[2], v1[3]); return w; }

struct EpiIn {
    static constexpr bool PERM = true, AFTER_DRAIN = false;
    bf16_t *QKV, *HY, *GT;
    __device__ __forceinline__ void operator()(const f32x4 (&acc)[2][2][4][2], const Unit& u, int wr, int wc, int fr, int fq) const {
        const int row0 = u.pm * BM + wr * 64 + fr; bf16_t* base; int ldc, colt; bool sg = false;
        if (u.pn < 12) { base = QKV; ldc = 3072; colt = u.pn * 256; }
        else if (u.pn < 36) { base = HY; ldc = 6144; colt = (u.pn - 12) * 256; }
        else { base = GT; ldc = 8192; colt = (u.pn - 36) * 256; sg = true; }
        const int col0 = colt + wc * 32 + 8 * fq;
#pragma unroll
        for (int ai = 0; ai < 2; ++ai)
#pragma unroll
            for (int m = 0; m < 4; ++m) { bf16_t* rowp = base + (size_t)(row0 + ai * HALF + m * 16) * ldc + col0;
#pragma unroll
                for (int bj = 0; bj < 2; ++bj) { f32x4 v0 = acc[ai][bj][m][0], v1 = acc[ai][bj][m][1];
                    if (sg) {
#pragma unroll
                        for (int j = 0; j < 4; ++j) { v0[j] = __builtin_amdgcn_rcpf(1.0f + __builtin_amdgcn_exp2f(v0[j])); v1[j] = __builtin_amdgcn_rcpf(1.0f + __builtin_amdgcn_exp2f(v1[j])); } }

                    if (sg) __builtin_nontemporal_store(pack8(v0, v1), (u32x4*)(rowp + bj * HALF));
                    else *(u32x4*)(rowp + bj * HALF) = pack8(v0, v1); } }
    }
};
__device__ __forceinline__ float row_rstd(const float* ss, int r) { return __builtin_amdgcn_rsqf(ss[r] * (1.0f / 4096.0f) + 1e-6f); }
struct EpiStore {
    static constexpr bool PERM = true, AFTER_DRAIN = false;
    bf16_t* O; int ldc; const float* ss;
    __device__ __forceinline__ void operator()(const f32x4 (&acc)[2][2][4][2], const Unit& u, int wr, int wc, int fr, int fq) const {
        const int row0 = u.pm * BM + wr * 64 + fr, col0 = u.pn * BM + wc * 32 + 8 * fq;
#pragma unroll
        for (int ai = 0; ai < 2; ++ai)
#pragma unroll
            for (int m = 0; m < 4; ++m) { const int r = row0 + ai * HALF + m * 16; const float rr = row_rstd(ss, r); bf16_t* rowp = O + (size_t)r * ldc + col0;
#pragma unroll
                for (int bj = 0; bj < 2; ++bj) *(u32x4*)(rowp + bj * HALF) = pack8(acc[ai][bj][m][0] * rr, acc[ai][bj][m][1] * rr); }
    }
};
template <int MODE> struct EpiGate {
    static constexpr bool PERM = true, AFTER_DRAIN = false;
    const bf16_t* GT; bf16_t* TM;
    __device__ __forceinline__ void operator()(const f32x4 (&acc)[2][2][4][2], const Unit& u, int wr, int wc, int fr, int fq) const {
        const int row0 = u.pm * BM + wr * 64 + fr, col0 = u.pn * BM + wc * 32 + 8 * fq;
        u32x4 gq[2][4][2], tq[4][2];
        if (MODE == 0) {
#pragma unroll
            for (int ai = 0; ai < 2; ++ai)
#pragma unroll
                for (int m = 0; m < 4; ++m) { const size_t r = (size_t)(row0 + ai * HALF + m * 16); const bf16_t* gp = GT + r * 8192 + col0;
#pragma unroll
                    for (int bj = 0; bj < 2; ++bj) gq[ai][m][bj] = *(const u32x4*)(gp + bj * HALF); } }
#pragma unroll
        for (int ai = 0; ai < 2; ++ai) {
            if (MODE == 1) {
#pragma unroll
                for (int m = 0; m < 4; ++m) { const size_t r = (size_t)(row0 + ai * HALF + m * 16); const bf16_t* gp = GT + r * 8192 + 4096 + col0; const bf16_t* tp = TM + r * 4096 + col0;
#pragma unroll
                    for (int bj = 0; bj < 2; ++bj) { gq[ai][m][bj] = *(const u32x4*)(gp + bj * HALF); tq[m][bj] = *(const u32x4*)(tp + bj * HALF); } } }
#pragma unroll
            for (int m = 0; m < 4; ++m) { const size_t r = (size_t)(row0 + ai * HALF + m * 16); bf16_t* tp = TM + r * 4096 + col0;
#pragma unroll
                for (int bj = 0; bj < 2; ++bj) { const u32x4 g = gq[ai][m][bj]; f32x4 v0 = acc[ai][bj][m][0], v1 = acc[ai][bj][m][1];
                    v0[0] *= bflo(g.x); v0[1] *= bfhi(g.x); v0[2] *= bflo(g.y); v0[3] *= bfhi(g.y); v1[0] *= bflo(g.z); v1[1] *= bfhi(g.z); v1[2] *= bflo(g.w); v1[3] *= bfhi(g.w);
                    if (MODE == 1) { const u32x4 t = tq[m][bj];
                        v0[0] += bflo(t.x); v0[1] += bfhi(t.x); v0[2] += bflo(t.y); v0[3] += bfhi(t.y); v1[0] += bflo(t.z); v1[1] += bfhi(t.z); v1[2] += bflo(t.w); v1[3] += bfhi(t.w); }
                    *(u32x4*)(tp + bj * HALF) = pack8(v0, v1); } }
            asm volatile("" ::: "memory"); }
    }
};
struct EpiRes {
    static constexpr bool PERM = false, AFTER_DRAIN = false;
    const float* b0; const float* b1; int split; bf16_t* XB; float* ss;
    __device__ __forceinline__ void operator()(const f32x4 (&acc)[2][2][4][2], const Unit& u, int wr, int wc, int fr, int fq) const {
        const int row0 = u.pm * BM + wr * 64 + fr, col0 = u.pn * BM + wc * 32 + 4 * fq, lane = fq * 16 + fr;
#pragma unroll
        for (int ai = 0; ai < 2; ++ai) {
        f32x4 bv[2][4][2][2];
#pragma unroll
            for (int m = 0; m < 4; ++m) { const int r = row0 + ai * HALF + m * 16; const float* bp = (r < split ? b0 + (size_t)r * 4096 : b1 + (size_t)(r - split) * 4096) + col0;
#pragma unroll
                for (int bj = 0; bj < 2; ++bj)
#pragma unroll
                    for (int n = 0; n < 2; ++n) bv[ai][m][bj][n] = *(const f32x4*)(bp + bj * HALF + n * 16); }
#pragma unroll
            for (int m = 0; m < 4; ++m) { const int r = row0 + ai * HALF + m * 16; bf16_t* xp = XB + (size_t)r * 4096 + col0;
                float s = 0.f;
#pragma unroll
                for (int bj = 0; bj < 2; ++bj)
#pragma unroll
                    for (int n = 0; n < 2; ++n) { const f32x4 v = bv[ai][m][bj][n] + acc[ai][bj][m][n];
                        s += (v[0] * v[0] + v[1] * v[1]) + (v[2] * v[2] + v[3] * v[3]);
                        u32x2 w; w.x = pk2f(v[0], v[1]); w.y = pk2f(v[2], v[3]); *(u32x2*)(xp + bj * HALF + n * 16) = w; }
                s += __int_as_float(__builtin_amdgcn_ds_bpermute((lane ^ 16) << 2, __float_as_int(s)));
                s += __int_as_float(__builtin_amdgcn_ds_bpermute((lane ^ 32) << 2, __float_as_int(s)));
                if (fq == 0) (void)__hip_atomic_fetch_add(ss + r, s, __ATOMIC_RELAXED, __HIP_MEMORY_SCOPE_AGENT);
                }
            asm volatile("" ::: "memory"); }
    }
};
struct EpiResB {
    static constexpr bool PERM = false, AFTER_DRAIN = false;
    bf16_t* XB; float* ss;
    __device__ __forceinline__ void operator()(const f32x4 (&acc)[2][2][4][2], const Unit& u, int wr, int wc, int fr, int fq) const {
        const int row0 = u.pm * BM + wr * 64 + fr, col0 = u.pn * BM + wc * 32 + 4 * fq, lane = fq * 16 + fr;
        u32x2 bv[2][4][2][2];
#pragma unroll
        for (int ai = 0; ai < 2; ++ai)
#pragma unroll
            for (int m = 0; m < 4; ++m) { const bf16_t* bp = XB + (size_t)(row0 + ai * HALF + m * 16) * 4096 + col0;
#pragma unroll
                for (int bj = 0; bj < 2; ++bj)
#pragma unroll
                    for (int n = 0; n < 2; ++n) bv[ai][m][bj][n] = *(const u32x2*)(bp + bj * HALF + n * 16); }
#pragma unroll
        for (int ai = 0; ai < 2; ++ai)
#pragma unroll
            for (int m = 0; m < 4; ++m) { const int r = row0 + ai * HALF + m * 16; bf16_t* xp = XB + (size_t)r * 4096 + col0;
                float s = 0.f;
#pragma unroll
                for (int bj = 0; bj < 2; ++bj)
#pragma unroll
                    for (int n = 0; n < 2; ++n) { const u32x2 b = bv[ai][m][bj][n]; f32x4 v = acc[ai][bj][m][n];
                        v[0] += bflo(b.x); v[1] += bfhi(b.x); v[2] += bflo(b.y); v[3] += bfhi(b.y);
                        s += (v[0] * v[0] + v[1] * v[1]) + (v[2] * v[2] + v[3] * v[3]);
                        u32x2 w; w.x = pk2f(v[0], v[1]); w.y = pk2f(v[2], v[3]); *(u32x2*)(xp + bj * HALF + n * 16) = w; }
                s += __int_as_float(__builtin_amdgcn_ds_bpermute((lane ^ 16) << 2, __float_as_int(s)));
                s += __int_as_float(__builtin_amdgcn_ds_bpermute((lane ^ 32) << 2, __float_as_int(s)));
                if (fq == 0) (void)__hip_atomic_fetch_add(ss + r, s, __ATOMIC_RELAXED, __HIP_MEMORY_SCOPE_AGENT); }
    }
};
struct EpiGlu {
    static constexpr bool PERM = true, AFTER_DRAIN = false;
    const bf16_t* GU; bf16_t* ACT; const float* cw; const float* cb; int L; const float* ss;
    __device__ __forceinline__ void operator()(const f32x4 (&acc)[2][2][4][2], const Unit& u, int wr, int wc, int fr, int fq) const {
        const int row0 = u.pm * BM + wr * 64 + fr;
        float rr[2][4];
#pragma unroll
        for (int ai = 0; ai < 2; ++ai)
#pragma unroll
            for (int m = 0; m < 4; ++m) rr[ai][m] = row_rstd(ss, row0 + ai * HALF + m * 16);
        const u32x4 z4 = {0u, 0u, 0u, 0u};
        auto gaddr = [&](int b) __attribute__((always_inline)) -> const bf16_t* { const int bj = b >> 1, ai = b & 1; return GU + (size_t)(row0 + ai * HALF) * 11008 + (u.pn * BM + bj * HALF + wc * 32 + 8 * fq); };
        auto ld_hu = [&](int b) __attribute__((always_inline)) -> u32x4 { const int rA = row0 + (b & 1) * HALF; u32x4 h = z4; if (fr == 0 && (rA & (L - 1)) > 0) h = *(const u32x4*)(gaddr(b) - 11008); return h; };
        auto ld_hd = [&](int b) __attribute__((always_inline)) -> u32x4 { const int rA = row0 + (b & 1) * HALF; u32x4 h = z4; if (fr == 15 && ((rA + 48) & (L - 1)) < L - 1) h = *(const u32x4*)(gaddr(b) + (size_t)49 * 11008); return h; };
        u32x4 gq[4], hu, hd;
#pragma unroll
        for (int m = 0; m < 4; ++m) gq[m] = *(const u32x4*)(gaddr(0) + (size_t)(m * 16) * 11008);
        hu = ld_hu(0); hd = ld_hd(0);
        f32x4 w0[2], w1[2], w2[2], bb[2];
#pragma unroll
        for (int b = 0; b < 4; ++b) { const int bj = b >> 1, ai = b & 1, c0 = u.pn * BM + bj * HALF + wc * 32 + 8 * fq, rA = row0 + ai * HALF;
            if (ai == 0) {
#pragma unroll
                for (int n = 0; n < 2; ++n) { w0[n] = *(const f32x4*)(cw + c0 + 4 * n); w1[n] = *(const f32x4*)(cw + 11008 + c0 + 4 * n); w2[n] = *(const f32x4*)(cw + 22016 + c0 + 4 * n); bb[n] = *(const f32x4*)(cb + c0 + 4 * n); } }
#pragma unroll
            for (int m = 0; m < 4; ++m) { const int r = rA + m * 16;
                const u32x4 gc = gq[m]; u32x4 gm, gn;
#pragma unroll
                for (int q = 0; q < 4; ++q) {
                    const int au = m > 0 ? __builtin_amdgcn_update_dpp(0, (int)gq[m > 0 ? m - 1 : 0][q], 0x121, 0xf, 0xf, false) : (int)hu[q];
                    const int ad = m < 3 ? __builtin_amdgcn_update_dpp(0, (int)gq[m < 3 ? m + 1 : 3][q], 0x12f, 0xf, 0xf, false) : (int)hd[q];
                    gm[q] = (unsigned)__builtin_amdgcn_update_dpp(au, (int)gc[q], 0x111, 0xf, 0xf, false);
                    gn[q] = (unsigned)__builtin_amdgcn_update_dpp(ad, (int)gc[q], 0x101, 0xf, 0xf, false); }
                if (b < 3) {
                    if (m == 0) hu = ld_hu(b + 1);
                    if (m == 2) { gq[0] = *(const u32x4*)gaddr(b + 1); gq[1] = *(const u32x4*)(gaddr(b + 1) + (size_t)16 * 11008); }
                    if (m == 3) { gq[2] = *(const u32x4*)(gaddr(b + 1) + (size_t)32 * 11008); gq[3] = *(const u32x4*)(gaddr(b + 1) + (size_t)48 * 11008); hd = ld_hd(b + 1); } }
                f32x4 xm[2], xc[2], xn[2];
                xm[0] = (f32x4){bflo(gm.x), bfhi(gm.x), bflo(gm.y), bfhi(gm.y)}; xm[1] = (f32x4){bflo(gm.z), bfhi(gm.z), bflo(gm.w), bfhi(gm.w)};
                xc[0] = (f32x4){bflo(gc.x), bfhi(gc.x), bflo(gc.y), bfhi(gc.y)}; xc[1] = (f32x4){bflo(gc.z), bfhi(gc.z), bflo(gc.w), bfhi(gc.w)};
                xn[0] = (f32x4){bflo(gn.x), bfhi(gn.x), bflo(gn.y), bfhi(gn.y)}; xn[1] = (f32x4){bflo(gn.z), bfhi(gn.z), bflo(gn.w), bfhi(gn.w)};
                f32x4 o[2];
#pragma unroll
                for (int n = 0; n < 2; ++n) { const f32x4 pre = w0[n] * xm[n] + w1[n] * xc[n] + w2[n] * xn[n] + bb[n];
                    const f32x2 ga = gelu_pk((f32x2){pre[0], pre[1]}), gb = gelu_pk((f32x2){pre[2], pre[3]});
                    o[n] = (f32x4){ga.x, ga.y, gb.x, gb.y} * (acc[ai][bj][m][n] * rr[ai][m]); }
                *(u32x4*)(ACT + (size_t)r * 11008 + c0) = pack8(o[0], o[1]);
                asm volatile("" ::: "memory"); } }
    }
};
struct EpiPP {
    static constexpr bool PERM = false, AFTER_DRAIN = false;
    bf16_t* PP;
    __device__ __forceinline__ void operator()(const f32x4 (&acc)[2][2][4][2], const Unit& u, int wr, int wc, int fr, int fq) const {
        const int row0 = u.pm * BM + wr * 64 + fr, col0 = u.pn * BM + wc * 32 + 4 * fq;
#pragma unroll
        for (int ai = 0; ai < 2; ++ai)
#pragma unroll
            for (int m = 0; m < 4; ++m) { bf16_t* pp = PP + (size_t)(row0 + ai * HALF + m * 16) * 4096 + col0;
#pragma unroll
                for (int bj = 0; bj < 2; ++bj)
#pragma unroll
                    for (int n = 0; n < 2; ++n) { const f32x4 v = acc[ai][bj][m][n]; u32x2 w; w.x = pk2f(v[0], v[1]); w.y = pk2f(v[2], v[3]); *(u32x2*)(pp + bj * HALF + n * 16) = w; } }
    }
};
struct EpiPle {
    static constexpr bool PERM = false, AFTER_DRAIN = false;
    const bf16_t* PP; const bf16_t* XB; bf16_t* X3; const float* ss; float* ss3;
    __device__ __forceinline__ void operator()(const f32x4 (&acc)[2][2][4][2], const Unit& u, int wr, int wc, int fr, int fq) const {
        const int row0 = u.pm * BM + wr * 64 + fr, col0 = u.pn * BM + wc * 32 + 4 * fq, lane = fq * 16 + fr;
#pragma unroll
        for (int ai = 0; ai < 2; ++ai) {
            u32x2 pq[4][2][2], xq[4][2][2]; float rq[4];
#pragma unroll
            for (int m = 0; m < 4; ++m) { const size_t ro = (size_t)(row0 + ai * HALF + m * 16) * 4096 + col0; rq[m] = row_rstd(ss, row0 + ai * HALF + m * 16) * -1.44269504089f;
#pragma unroll
                for (int bj = 0; bj < 2; ++bj)
#pragma unroll
                    for (int n = 0; n < 2; ++n) { pq[m][bj][n] = *(const u32x2*)(PP + ro + bj * HALF + n * 16); xq[m][bj][n] = *(const u32x2*)(XB + ro + bj * HALF + n * 16); } }
#pragma unroll
            for (int m = 0; m < 4; ++m) { const int r = row0 + ai * HALF + m * 16; const size_t ro = (size_t)r * 4096 + col0; float s = 0.f;
#pragma unroll
                for (int bj = 0; bj < 2; ++bj)
#pragma unroll
                    for (int n = 0; n < 2; ++n) { const f32x4 v = acc[ai][bj][m][n] * rq[m]; const u32x2 p = pq[m][bj][n], xb = xq[m][bj][n]; f32x4 x;
                        x[0] = bflo(xb.x) + sg2(v[0]) * bflo(p.x); x[1] = bfhi(xb.x) + sg2(v[1]) * bfhi(p.x); x[2] = bflo(xb.y) + sg2(v[2]) * bflo(p.y); x[3] = bfhi(xb.y) + sg2(v[3]) * bfhi(p.y);
                        s += (x[0] * x[0] + x[1] * x[1]) + (x[2] * x[2] + x[3] * x[3]);
                        u32x2 w; w.x = pk2f(x[0], x[1]); w.y = pk2f(x[2], x[3]); *(u32x2*)(X3 + ro + bj * HALF + n * 16) = w; }
                s += __int_as_float(__builtin_amdgcn_ds_bpermute((lane ^ 16) << 2, __float_as_int(s)));
                s += __int_as_float(__builtin_amdgcn_ds_bpermute((lane ^ 32) << 2, __float_as_int(s)));
                if (fq == 0) (void)__hip_atomic_fetch_add(ss3 + r, s, __ATOMIC_RELAXED, __HIP_MEMORY_SCOPE_AGENT); }
            asm volatile("" ::: "memory"); }
    }
};
template <class Epi, class Sched, bool ALIGN_EPI = false, bool SP2 = false>
__device__ __forceinline__ void gemm_phase(PG8_LAS unsigned char* lds, const Gemm g, const Sched& S, const Epi& E, int tid_in, float* probe = nullptr, unsigned* dynq = nullptr, volatile PG8_LAS unsigned* dslot = nullptr) {
    int tid_ = tid_in; asm volatile("" : "+v"(tid_));
    const int tid = tid_, wid = __builtin_amdgcn_readfirstlane(tid >> 6), lane = tid & 63, wr = wid >> 2, wc = wid & 3, fr = lane & 15, fq = lane >> 4;
    const int K = g.K, nt = K / BK;
    unsigned voffA[2], voffB[2];
#pragma unroll
    for (int i = 0; i < 2; ++i) { int R, C; stage_rc(tid * 16 + i * 8192, R, C); const int Rb = Epi::PERM ? ((R & ~31) + perm32(R & 31)) : R;
        voffA[i] = (unsigned)(R * K + C) * 2u; voffB[i] = (unsigned)(Rb * K + C) * 2u; }
    const size_t kstep = (size_t)(BK * 2);
    const size_t hstep = (size_t)HALF * K * 2;
    const size_t tstep = 2 * hstep;
    const unsigned ldsw = (unsigned)wid * 1024u;
    const int aoff = lds_byte(wr * 64 + fr, fq * 8), boff = lds_byte(wc * 32 + fr, fq * 8);
#define PG8_SA(b, h) (((b) * 2 + (h)) * HTB)
#define PG8_SB(b, h) ((4 + (b) * 2 + (h)) * HTB)
#define PG8_STAGE(bufoff, gbase, voff) do { _Pragma("unroll") for (int _i = 0; _i < 2; ++_i) \
        __builtin_amdgcn_global_load_lds((const unsigned*)((const char*)(gbase) + (voff)[_i]), (PG8_LAS unsigned*)(lds + (bufoff) + ldsw + _i * 8192), 16, 0, 0); } while (0)
#define PG8_LDA(dst, b, h) do { _Pragma("unroll") for (int m = 0; m < 4; ++m) _Pragma("unroll") for (int k = 0; k < 2; ++k) dst[m][k] = *(const PG8_LAS bf16x8*)(lds + PG8_SA(b, h) + aoff + m * 2048 + k * 1024); } while (0)
#define PG8_LDB(dst, b, h) do { _Pragma("unroll") for (int n = 0; n < 2; ++n) _Pragma("unroll") for (int k = 0; k < 2; ++k) dst[n][k] = *(const PG8_LAS bf16x8*)(lds + PG8_SB(b, h) + boff + n * 2048 + k * 1024); } while (0)
#define PG8_MMA(ai, bj, At, Bt) do { __builtin_amdgcn_s_setprio(1); _Pragma("unroll") for (int m = 0; m < 4; ++m) _Pragma("unroll") for (int n = 0; n < 2; ++n) _Pragma("unroll") for (int k = 0; k < 2; ++k) \
        acc[ai][bj][m][n] = __builtin_amdgcn_mfma_f32_16x16x32_bf16(Bt[n][k], At[m][k], acc[ai][bj][m][n], 0, 0, 0); __builtin_amdgcn_s_setprio(0); } while (0)
#define PG8_WAIT_V(n) asm volatile("s_waitcnt vmcnt(" #n ")" ::: "memory")
#define PG8_WAIT_L(n) asm volatile("s_waitcnt lgkmcnt(" #n ")" ::: "memory")
#define PG8_BAR __builtin_amdgcn_s_barrier()
#define PG8_SCHED __builtin_amdgcn_sched_barrier(0)
    Unit cur, nxt; int ui = 0;
    if (!S.next(0, cur)) return;
    f32x4 acc[2][2][4][2];
#pragma unroll
    for (int a = 0; a < 2; ++a)
#pragma unroll
        for (int b = 0; b < 2; ++b)
#pragma unroll
            for (int m = 0; m < 4; ++m)
#pragma unroll
                for (int n = 0; n < 2; ++n) acc[a][b][m][n] = (f32x4){0.f, 0.f, 0.f, 0.f};
    bf16x8 At[4][2], B0[2][2], B1[2][2];
    const char* cA = (const char*)g.A + (size_t)cur.pm * tstep; const char* cB = (const char*)g.Bt + (size_t)cur.pn * tstep;
    S.a_ready(cur);
    if constexpr (SP2) {
        PG8_STAGE(PG8_SB(0, 0), cB, voffB); PG8_STAGE(PG8_SB(0, 1), cB + hstep, voffB); PG8_STAGE(PG8_SA(0, 0), cA, voffA); PG8_STAGE(PG8_SA(0, 1), cA + hstep, voffA);
        if (wr == 1) PG8_BAR;
        PG8_WAIT_V(2); PG8_BAR;
        PG8_STAGE(PG8_SB(1, 0), cB + kstep, voffB); PG8_STAGE(PG8_SA(1, 0), cA + kstep, voffA); PG8_STAGE(PG8_SB(1, 1), cB + hstep + kstep, voffB);
        PG8_WAIT_V(6); PG8_BAR;
    } else {
        PG8_STAGE(PG8_SB(0, 0), cB, voffB); PG8_STAGE(PG8_SA(0, 0), cA, voffA); PG8_STAGE(PG8_SB(0, 1), cB + hstep, voffB); PG8_STAGE(PG8_SA(0, 1), cA + hstep, voffA);
        if (wr == 1) PG8_BAR;
        PG8_WAIT_V(4); PG8_BAR;
        PG8_STAGE(PG8_SB(1, 0), cB + kstep, voffB); PG8_STAGE(PG8_SA(1, 0), cA + kstep, voffA); PG8_STAGE(PG8_SB(1, 1), cB + hstep + kstep, voffB);
        PG8_WAIT_V(6); PG8_BAR;
    }
    unsigned dyn_ret = 0; int dq = S.c & 7;
    unsigned long long pr_prev = 0, pr_sumk = 0, pr_sume = 0; if (probe) pr_prev = wall_clock64();
    for (;;) {
        bool has_next = false;
        if (dynq) {
            if (wid == 0) {
                if (ui >= 1) {
                    unsigned v = (unsigned)__builtin_amdgcn_readfirstlane((int)dyn_ret) + (unsigned)(2 * S.G / 8);
                    for (int tries = 0; v >= (unsigned)((S.nwg - dq + 7) >> 3) && tries < 7; ++tries) {
                        dq = (dq + 1) & 7; unsigned r_ = 0;
                        if (lane == 0) r_ = __hip_atomic_fetch_add(dynq + 64 * dq, 1u, __ATOMIC_RELAXED, __HIP_MEMORY_SCOPE_AGENT);
                        v = (unsigned)__builtin_amdgcn_readfirstlane((int)r_) + (unsigned)(2 * S.G / 8); }
                    const unsigned code = (v < (unsigned)((S.nwg - dq + 7) >> 3)) ? (8u * v + (unsigned)dq) : 0xffffffffu;
                    if (lane == 0) dslot[(ui + 1) & 1] = code;
                }
                dyn_ret = 0u;
                if (lane == 0) dyn_ret = __hip_atomic_fetch_add(dynq + 64 * dq, 1u, __ATOMIC_RELAXED, __HIP_MEMORY_SCOPE_AGENT);
            }
        } else has_next = S.next(ui + 1, nxt);
        const char* nA_ = has_next ? (const char*)g.A + (size_t)nxt.pm * tstep : cA; const char* nB_ = has_next ? (const char*)g.Bt + (size_t)nxt.pn * tstep : cB;
        const char* nA = nA_; const char* nB = nB_;
        for (int t = 0; t < nt; t += 2) {
            const bool last = (t == nt - 2);
            if (dynq && last) {
                long L1;
                if (ui == 0) { L1 = (long)S.G + S.c; has_next = L1 < S.nwg; }
                else { const unsigned code = (unsigned)__builtin_amdgcn_readfirstlane((int)dslot[(ui + 1) & 1]); has_next = code != 0xffffffffu; L1 = (long)code; }
                if (has_next) { S.unit_of(L1, nxt); nA = (const char*)g.A + (size_t)nxt.pm * tstep; nB = (const char*)g.Bt + (size_t)nxt.pn * tstep; } else { nA = cA; nB = cB; }
            }
            const char* a1 = cA + (size_t)(t + 1) * kstep;
            const char* a2 = last ? nA : cA + (size_t)(t + 2) * kstep; const char* b2 = last ? nB : cB + (size_t)(t + 2) * kstep;
            const char* a3 = a2 + kstep; const char* b3 = b2 + kstep;
            if (last && has_next) S.a_ready(nxt);
            if constexpr (SP2) {
            PG8_LDB(B0, 0, 0); PG8_LDB(B1, 0, 1); PG8_SCHED; PG8_LDA(At, 0, 0); PG8_STAGE(PG8_SA(1, 1), a1 + hstep, voffA);
            PG8_WAIT_V(8); PG8_WAIT_L(0); PG8_BAR; PG8_MMA(0, 0, At, B0); PG8_MMA(0, 1, At, B1); PG8_BAR; PG8_SCHED;
            PG8_LDA(At, 0, 1); PG8_STAGE(PG8_SB(0, 0), b2, voffB); PG8_STAGE(PG8_SB(0, 1), b2 + hstep, voffB); PG8_STAGE(PG8_SA(0, 0), a2, voffA);
            PG8_WAIT_V(8); PG8_WAIT_L(0); PG8_BAR; PG8_MMA(1, 0, At, B0); PG8_MMA(1, 1, At, B1); PG8_BAR; PG8_SCHED;
            PG8_LDB(B0, 1, 0); PG8_LDB(B1, 1, 1); PG8_SCHED; PG8_LDA(At, 1, 0); PG8_STAGE(PG8_SA(0, 1), a2 + hstep, voffA);
            PG8_WAIT_V(8); PG8_WAIT_L(0); PG8_BAR; PG8_MMA(0, 0, At, B0); PG8_MMA(0, 1, At, B1); PG8_BAR; PG8_SCHED;
            PG8_LDA(At, 1, 1); PG8_STAGE(PG8_SB(1, 0), b3, voffB); PG8_STAGE(PG8_SB(1, 1), b3 + hstep, voffB); PG8_STAGE(PG8_SA(1, 0), a3, voffA);
            PG8_WAIT_V(8); PG8_WAIT_L(0); PG8_BAR; PG8_MMA(1, 0, At, B0); PG8_MMA(1, 1, At, B1); PG8_BAR; PG8_SCHED;
            } else {
            PG8_LDB(B0, 0, 0); PG8_SCHED; PG8_LDA(At, 0, 0); PG8_STAGE(PG8_SA(1, 1), a1 + hstep, voffA);
            PG8_WAIT_L(8); PG8_BAR; PG8_WAIT_L(0); PG8_MMA(0, 0, At, B0); PG8_BAR; PG8_SCHED;
            PG8_LDB(B1, 0, 1); PG8_STAGE(PG8_SB(0, 0), b2, voffB);
            PG8_BAR; PG8_WAIT_L(0); PG8_MMA(0, 1, At, B1); PG8_BAR;
            PG8_LDA(At, 0, 1); PG8_STAGE(PG8_SA(0, 0), a2, voffA);
            PG8_BAR; PG8_WAIT_L(0); PG8_MMA(1, 0, At, B0); PG8_BAR; PG8_SCHED;
            PG8_STAGE(PG8_SB(0, 1), b2 + hstep, voffB);
            PG8_WAIT_V(6); PG8_BAR; PG8_MMA(1, 1, At, B1); PG8_BAR;
            PG8_LDB(B0, 1, 0); PG8_SCHED; PG8_LDA(At, 1, 0); PG8_STAGE(PG8_SA(0, 1), a2 + hstep, voffA);
            PG8_WAIT_L(8); PG8_BAR; PG8_WAIT_L(0); PG8_MMA(0, 0, At, B0); PG8_BAR; PG8_SCHED;
            PG8_LDB(B1, 1, 1); PG8_STAGE(PG8_SB(1, 0), b3, voffB);
            PG8_BAR; PG8_WAIT_L(0); PG8_MMA(0, 1, At, B1); PG8_BAR;
            PG8_LDA(At, 1, 1); PG8_STAGE(PG8_SA(1, 0), a3, voffA);
            PG8_BAR; PG8_WAIT_L(0); PG8_MMA(1, 0, At, B0); PG8_BAR; PG8_SCHED;
            PG8_STAGE(PG8_SB(1, 1), b3 + hstep, voffB);
            PG8_WAIT_V(6); PG8_BAR; PG8_MMA(1, 1, At, B1); PG8_BAR;
            }
        }
        unsigned long long pr_tk = 0; if (probe) { pr_tk = wall_clock64(); pr_sumk += pr_tk - pr_prev; }
        if constexpr (ALIGN_EPI) { if (wr == 0) PG8_BAR; }
        if constexpr (!Epi::AFTER_DRAIN) { int le_ = lane; asm volatile("" : "+v"(le_));
            E(acc, cur, wr, wc, le_ & 15, le_ >> 4); S.done(cur); }
        if (probe) { const unsigned long long pr_te = wall_clock64(); pr_sume += pr_te - pr_tk; pr_prev = pr_te; }
        if (!has_next) break;
#pragma unroll
        for (int a = 0; a < 2; ++a)
#pragma unroll
            for (int b = 0; b < 2; ++b)
#pragma unroll
                for (int m = 0; m < 4; ++m)
#pragma unroll
                    for (int n = 0; n < 2; ++n) acc[a][b][m][n] = (f32x4){0.f, 0.f, 0.f, 0.f};
        cur = nxt; cA = nA; cB = nB; ++ui;
        if constexpr (ALIGN_EPI) { if (wr == 1) PG8_BAR; }
    }
    if (probe && blockIdx.x == 0 && tid == 0) { probe[0] = (float)pr_sumk * 0.01f / (float)(ui + 1); probe[1] = (float)pr_sume * 0.01f / (float)(ui + 1); }
    PG8_WAIT_V(0);
    if constexpr (!ALIGN_EPI) { if (wr == 0) PG8_BAR; }
    PG8_BAR;
    if constexpr (Epi::AFTER_DRAIN) { E.fused(acc, cur, wr, wc, fr, fq, lds, wid, lane); S.done(cur); }
#undef PG8_SA
#undef PG8_SB
#undef PG8_STAGE
#undef PG8_LDA
#undef PG8_LDB
#undef PG8_MMA
#undef PG8_WAIT_V
#undef PG8_WAIT_L
#undef PG8_BAR
#undef PG8_SCHED
}
}

constexpr int NWAVES = 8, NTHR = 512;
constexpr int DM = 4096, MP = 16384, MS = 8192, M = MP + MS;
constexpr int LP = 4096, LS = 2048;
constexpr int NIN = 17408, AW = 2048, HW = 2048, FF = 11008, PLE = 256;
constexpr float EPS = 1e-6f;

constexpr size_t WS_CTL = 0, CTL_ZERO_BYTES = 1u << 20;
constexpr size_t SZ_PB = (size_t)M * PLE * 2;
constexpr size_t SZ_WUP = (size_t)2 * FF * DM * 2, SZ_WDN = (size_t)DM * FF * 2, SZ_WPG = (size_t)DM * DM * 2, SZ_WPL = (size_t)DM * PLE * 2;
constexpr size_t SZ_WIN = (size_t)NIN * DM * 2, SZ_WAO = (size_t)DM * AW * 2, SZ_WHO = (size_t)DM * HW * 2, SZ_WOUT = (size_t)DM * DM * 2;
constexpr size_t SZ_QKV = (size_t)M * 3072 * 2, SZ_HY = (size_t)M * 6144 * 2, SZ_GT = (size_t)M * 8192 * 2, SZ_XN = (size_t)M * DM * 2;
constexpr size_t WS_PB = CTL_ZERO_BYTES;
constexpr size_t WS_WUP = WS_PB + SZ_PB, WS_WDN = WS_WUP + SZ_WUP, WS_WPG = WS_WDN + SZ_WDN, WS_WPL = WS_WPG + SZ_WPG;
constexpr size_t WS_EARLY = WS_WPL + SZ_WPL;
constexpr size_t WS_WIN = WS_EARLY, WS_WAO = WS_WIN + SZ_WIN, WS_WHO = WS_WAO + SZ_WAO, WS_WOUT = WS_WHO + SZ_WHO;
constexpr size_t WS_QKV = WS_WOUT + SZ_WOUT, WS_HY = WS_QKV + SZ_QKV, WS_GT = WS_HY + SZ_HY, WS_END = WS_GT + SZ_GT;
constexpr size_t WS_HYO = WS_QKV;
constexpr size_t WS_TM = WS_HY;
constexpr size_t WS_XN2 = WS_END - SZ_XN;
constexpr size_t SZ_GU = (size_t)MP * FF * 2;
constexpr size_t WS_GU = WS_EARLY, WS_ACT = WS_GU + SZ_GU;
constexpr size_t WS_PP = WS_EARLY;
static_assert(WS_ACT + SZ_GU <= WS_XN2, "FFN buffers overlap XN2");
static_assert(WS_HYO + (size_t)M * HW * 2 <= WS_HY && WS_TM + SZ_XN <= WS_GT, "overlay map");
static_assert(WS_END <= 1450000000ull, "workspace");
constexpr size_t DO_XN = 0;
constexpr size_t DO_UT = 0;
constexpr size_t DO_KT = SZ_XN;
constexpr size_t DO_ATT = SZ_XN + (size_t)HW * (2 * LP + 2 * LS) * 4;
static_assert(DO_ATT + (size_t)M * AW * 2 <= (size_t)M * DM * 4, "d_out scratch map");
constexpr int CW_BAR = 4096;

constexpr int RING_BYTES = 131072;
constexpr int LDSCTL_OFF = RING_BYTES, MISC_OFF = LDSCTL_OFF + 320;
constexpr int LDS_BYTES = 147456;

#define GAS __attribute__((address_space(1)))
#define LAS __attribute__((address_space(3)))
typedef unsigned short bf16;
typedef unsigned v4u __attribute__((ext_vector_type(4)));
typedef float f32x4 __attribute__((ext_vector_type(4)));
typedef float f32x16 __attribute__((ext_vector_type(16)));
typedef short bf16x8 __attribute__((ext_vector_type(8)));
typedef short s16x4 __attribute__((ext_vector_type(4)));
typedef GAS unsigned gu32;
#define LDS_WAIT() asm volatile("s_waitcnt lgkmcnt(0)" ::: "memory")
using pg8::pk2f; using pg8::bflo; using pg8::bfhi;
#define XB_TMO      128
#define XB_XCNT(j)  (256  + 64 * (j))
#define XB_XSUB(j)  (1280 + 64 * (j))
#define XB_XGEN(j)  (2304 + 64 * (j))
#define XB_TOP      3328
#define XB_TOPGEN   3392
#define XCD_BAR_WORDS 3456
#define XB_SPIN_CAP (1u << 18)

__device__ __forceinline__ unsigned xb_ld(unsigned* p)              { return __hip_atomic_load(p, __ATOMIC_RELAXED, __HIP_MEMORY_SCOPE_AGENT); }
__device__ __forceinline__ unsigned xb_add(unsigned* p, unsigned v) { return __hip_atomic_fetch_add(p, v, __ATOMIC_RELAXED, __HIP_MEMORY_SCOPE_AGENT); }
__device__ __forceinline__ unsigned xb_xcc_id() { return (unsigned)__builtin_amdgcn_s_getreg((3 << 11) | 20) & 0xFu; }
#define XB_SPIN(cond, bar) do { unsigned _sp = 0; while (cond) { __builtin_amdgcn_s_sleep(1); \
    if ((++_sp & 255u) == 0u) { if (xb_ld(&(bar)[XB_TMO])) break; if (_sp > XB_SPIN_CAP) { atomicAdd(&(bar)[XB_TMO], 1u); break; } } } } while (0)

struct XcdBarrier {
    unsigned* bar; unsigned x;
    volatile LAS unsigned* st;
};

__device__ __forceinline__ XcdBarrier xcd_barrier_post(unsigned* bar, volatile LAS unsigned* st) {
    XcdBarrier b; b.bar = bar; b.x = xb_xcc_id(); b.st = st;
    if (threadIdx.x == 0) (void)xb_add(&bar[XB_XCNT(b.x)], 1u);
    return b;
}
__device__ __forceinline__ void xcd_barrier_complete(unsigned* bar, unsigned x, unsigned& nloc, unsigned& nx) {
    const unsigned G = gridDim.x * gridDim.y * gridDim.z;
    unsigned sum, cnt, mine, sp = 0u;
    for (;;) {
        sum = 0u; cnt = 0u; mine = 0u;
#pragma unroll
        for (unsigned j = 0; j < 16; ++j) { const unsigned c = xb_ld(&bar[XB_XCNT(j)]); sum += c; cnt += (c > 0u) ? 1u : 0u; mine = (j == x) ? c : mine; }
        if (sum == G) break;
        __builtin_amdgcn_s_sleep(1);
        if ((++sp & 255u) == 0u) { if (xb_ld(&bar[XB_TMO])) break; if (sp > XB_SPIN_CAP) { atomicAdd(&bar[XB_TMO], 1u); break; } }
    }
    nloc = mine > 0u ? mine : 1u; nx = cnt > 0u ? cnt : 1u;
}

__device__ __forceinline__ void xcd_barrier(const XcdBarrier& b) {
    asm volatile("s_waitcnt vmcnt(0)" ::: "memory");
    __syncthreads();
    if (threadIdx.x == 0) {
        unsigned* bar = b.bar;
        __builtin_amdgcn_s_waitcnt(0);
        unsigned nloc = b.st[0], nx = b.st[1];
        if (nloc == 0u) { xcd_barrier_complete(bar, b.x, nloc, nx); b.st[0] = nloc; b.st[1] = nx; }
        const unsigned old = xb_add(&bar[XB_XSUB(b.x)], 1u);
        const unsigned gen = old / nloc;
        if (old + 1u == (gen + 1u) * nloc) {
            __builtin_amdgcn_fence(__ATOMIC_RELEASE, "agent");
            asm volatile("s_waitcnt vmcnt(0)" ::: "memory");
            const unsigned og = xb_add(&bar[XB_TOP], 1u);
            const unsigned tg = og / nx;
            if (og + 1u == (tg + 1u) * nx) xb_add(&bar[XB_TOPGEN], 1u);
            else XB_SPIN(xb_ld(&bar[XB_TOPGEN]) == tg, bar);
            __builtin_amdgcn_fence(__ATOMIC_ACQUIRE, "agent");
            xb_add(&bar[XB_XGEN(b.x)], 1u);
            asm volatile("s_waitcnt vmcnt(0)" ::: "memory");
        } else {
            XB_SPIN(xb_ld(&bar[XB_XGEN(b.x)]) == gen, bar);
            __builtin_amdgcn_fence(__ATOMIC_ACQUIRE, "agent");
            asm volatile("s_waitcnt vmcnt(0)" ::: "memory");
        }
    }
    __syncthreads();
}

struct Args { const float* in[31]; float* out; unsigned char* ws; int ph_lo, ph_hi; };
typedef unsigned u32x2_t __attribute__((ext_vector_type(2)));
struct Frame {
    LAS unsigned char* lds;
    int tid, lane, wave, vcu, G;
};
__device__ __forceinline__ void refresh(Frame& F) { unsigned z_ = 0u; asm volatile("" : "+v"(z_)); const int l_ = (int)__builtin_amdgcn_mbcnt_hi(~0u, __builtin_amdgcn_mbcnt_lo(~0u, z_)); F.lane = l_; F.tid = F.wave * 64 + l_; }
__device__ __forceinline__ float shx(float v, int mask, int lane) { return __int_as_float(__builtin_amdgcn_ds_bpermute((lane ^ mask) << 2, __float_as_int(v))); }

struct TrItem { const float* W; bf16* WT; const float* gk; int K, N, k0, n0; float sc = 1.0f; };
__device__ __forceinline__ void tr_load(const TrItem& t, int lane, float (&wv)[32]) {
    const float* src = t.W + (size_t)(t.k0 + (lane >> 5)) * t.N + t.n0 + (lane & 31);
#pragma unroll
    for (int i = 0; i < 32; ++i) wv[i] = src[(size_t)(2 * i) * t.N];
}
__device__ __forceinline__ void tr_store(const TrItem& t, int lane, const float (&wv)[32], LAS float* scr) {
#pragma unroll
    for (int i = 0; i < 32; ++i) { const int kk = 2 * i + (lane >> 5); scr[kk * 33 + (lane & 31)] = (t.gk ? wv[i] * t.gk[t.k0 + kk] : wv[i]) * t.sc; }
    LDS_WAIT(); asm volatile("" ::: "memory");
    const int c = lane & 7;
#pragma unroll
    for (int j = 0; j < 4; ++j) { const int n = (lane >> 3) + 8 * j; const LAS float* s = scr + (8 * c) * 33 + n;
        v4u o; o.x = pk2f(s[0 * 33], s[1 * 33]); o.y = pk2f(s[2 * 33], s[3 * 33]); o.z = pk2f(s[4 * 33], s[5 * 33]); o.w = pk2f(s[6 * 33], s[7 * 33]);
        *(GAS v4u*)(t.WT + (size_t)(t.n0 + n) * t.K + t.k0 + 8 * c) = o; }
    LDS_WAIT(); asm volatile("" ::: "memory");
}
__device__ __forceinline__ TrItem tr_item(const float* W, int K, int N, bf16* WT, const float* gk, int r) { const int nblk = N / 32, kb = r / nblk, nb = r - kb * nblk; return TrItem{W, WT, gk, K, N, 64 * kb, 32 * nb}; }
template <bool BF> __device__ __forceinline__ void rms_row(const float* xrow, const float* g, void* orow, int lane) {
    const GAS f32x4* xr = (const GAS f32x4*)xrow + lane; const GAS f32x4* gr = (const GAS f32x4*)g + lane;
    f32x4 v[16]; float s = 0.f;
#pragma unroll
    for (int j = 0; j < 16; ++j) { v[j] = xr[64 * j]; s += (v[j].x * v[j].x + v[j].y * v[j].y) + (v[j].z * v[j].z + v[j].w * v[j].w); }
#pragma unroll
    for (int o = 1; o < 64; o <<= 1) s += shx(s, o, lane);
    const float r = 1.0f / sqrtf(s * (1.0f / 4096.0f) + EPS);
#pragma unroll
    for (int j = 0; j < 16; ++j) { const f32x4 gg = gr[64 * j]; const f32x4 y = v[j] * r * gg;
        if (BF) { ((GAS unsigned long long*)orow)[lane + 64 * j] = (unsigned long long)pk2f(y.x, y.y) | ((unsigned long long)pk2f(y.z, y.w) << 32); }
        else ((GAS f32x4*)orow)[lane + 64 * j] = y; }
}
__device__ __forceinline__ void final_row(const bf16* xrow, float rstd, const float* g, float* orow, int lane) {
    const GAS u32x2_t* xr = (const GAS u32x2_t*)xrow + lane; const GAS f32x4* gr = (const GAS f32x4*)g + lane; GAS f32x4* o = (GAS f32x4*)orow + lane;
    u32x2_t v[16];
#pragma unroll
    for (int j = 0; j < 16; ++j) v[j] = xr[64 * j];
#pragma unroll
    for (int j = 0; j < 16; ++j) { const f32x4 gg = gr[64 * j]; f32x4 y; y.x = bflo(v[j].x) * rstd * gg.x; y.y = bfhi(v[j].x) * rstd * gg.y; y.z = bflo(v[j].y) * rstd * gg.z; y.w = bfhi(v[j].y) * rstd * gg.w; o[64 * j] = y; }
}
__device__ __forceinline__ void rms_phase_bf16(const Frame& F, const float* src0, const float* src1, const float* g, bf16* dst) {
    const int gw = F.vcu * NWAVES + F.wave, NGW = F.G * NWAVES, lane = F.lane;
    if (gw >= M) return;
    f32x4 gv[16], cur[16], nxt[16];
#pragma unroll
    for (int j = 0; j < 16; ++j) gv[j] = ((const GAS f32x4*)g)[lane + 64 * j];
    { const GAS f32x4* xr = (const GAS f32x4*)(gw < MP ? src0 + (size_t)gw * DM : src1 + (size_t)(gw - MP) * DM) + lane;
#pragma unroll
      for (int j = 0; j < 16; ++j) cur[j] = xr[64 * j]; }
#pragma unroll 1
    for (int m = gw; m < M; m += NGW) {
        const int mn = m + NGW;
        if (mn < M) { const GAS f32x4* xr = (const GAS f32x4*)(mn < MP ? src0 + (size_t)mn * DM : src1 + (size_t)(mn - MP) * DM) + lane;
#pragma unroll
            for (int j = 0; j < 16; ++j) nxt[j] = xr[64 * j]; }
        float s = 0.f;
#pragma unroll
        for (int j = 0; j < 16; ++j) s += (cur[j].x * cur[j].x + cur[j].y * cur[j].y) + (cur[j].z * cur[j].z + cur[j].w * cur[j].w);
#pragma unroll
        for (int o = 1; o < 64; o <<= 1) s += shx(s, o, lane);
        const float r = 1.0f / sqrtf(s * (1.0f / 4096.0f) + EPS);
        GAS unsigned long long* orow = (GAS unsigned long long*)(dst + (size_t)m * DM);
#pragma unroll
        for (int j = 0; j < 16; ++j) { const f32x4 y = cur[j] * r * gv[j]; orow[lane + 64 * j] = (unsigned long long)pk2f(y.x, y.y) | ((unsigned long long)pk2f(y.z, y.w) << 32); }
        if (mn < M) {
#pragma unroll
            for (int j = 0; j < 16; ++j) cur[j] = nxt[j]; }
    }
}
__device__ __forceinline__ void final_phase(const Frame& F, const bf16* XB, const float* ss, const float* g, float* out, float dadd = 0.f) {
    const int gw = F.vcu * NWAVES + F.wave, NGW = F.G * NWAVES, lane = F.lane;
    if (gw >= M) return;
    f32x4 gv[16]; u32x2_t cur[16], nxt[16];
#pragma unroll
    for (int j = 0; j < 16; ++j) gv[j] = ((const GAS f32x4*)g)[lane + 64 * j];
    { const GAS u32x2_t* xr = (const GAS u32x2_t*)(XB + (size_t)gw * DM) + lane;
#pragma unroll
      for (int j = 0; j < 16; ++j) cur[j] = xr[64 * j]; }
    float sc = ss[gw];
#pragma unroll 1
    for (int m = gw; m < M; m += NGW) {
        const int mn = m + NGW; float sn = 0.f;
        if (mn < M) { const GAS u32x2_t* xr = (const GAS u32x2_t*)(XB + (size_t)mn * DM) + lane; sn = ss[mn];
#pragma unroll
            for (int j = 0; j < 16; ++j) nxt[j] = xr[64 * j]; }
        const float rstd = 1.0f / sqrtf(sc * (1.0f / 4096.0f) + EPS);
        GAS f32x4* o = (GAS f32x4*)(out + (size_t)m * DM) + lane;
#pragma unroll
        for (int j = 0; j < 16; ++j) { const f32x4 gg = gv[j]; f32x4 y; y.x = bflo(cur[j].x) * rstd * gg.x; y.y = bfhi(cur[j].x) * rstd * gg.y; y.z = bflo(cur[j].y) * rstd * gg.z; y.w = bfhi(cur[j].y) * rstd * gg.w; if (dadd != 0.f && m < MP) y = y + dadd; o[64 * j] = y; }
        if (mn < M) { sc = sn;
#pragma unroll
            for (int j = 0; j < 16; ++j) cur[j] = nxt[j]; }
    }
}

#define MFMAF32(a, b, c) __builtin_amdgcn_mfma_f32_32x32x2f32((a), (b), (c), 0, 0, 0)
__device__ __forceinline__ void h0_phase(const Frame& F, const Args& A, float* KT) {
    const float* w1 = A.in[10]; const float* b1 = A.in[11]; const float* f1 = A.in[12]; const float* w2 = A.in[13]; const float* b2 = A.in[14]; const float* f2 = A.in[15];
    const float* w3 = A.in[16]; const float* decay = A.in[17]; const float* skip = A.in[18];
    LAS float* Z = (LAS float*)F.lds; LAS float* H1 = Z + 64 * 35; LAS float* H2 = H1 + 64 * 65; LAS float* T = H2 + 64 * 65;
#pragma unroll 1
    for (int unit = F.vcu; unit < 1536; unit += F.G) {
        int tid = F.tid; asm volatile("" : "+v"(tid));
        const int lane = tid & 63, r = lane & 31, kh = lane >> 5, wv = F.wave;
        const int dct = unit & 15, lt = unit >> 4, dc0 = dct * 256, dir = dc0 >> 11, c0 = dc0 & 2047;
        const int lsel = lt >= 64, L = lsel ? LS : LP, l0 = (lsel ? lt - 64 : lt) * 64;
        float* KTb = KT + (lsel ? (size_t)HW * 2 * LP : 0);
        const float invLm1 = 1.0f / (float)(L - 1);
        float bw[32];
#pragma unroll
        for (int s = 0; s < 32; ++s) bw[s] = w3[(size_t)(2 * s + kh) * 4096 + dc0 + wv * 32 + r];
        const float dec = decay[dc0 + wv * 32 + r];
        for (int idx = tid; idx < 64 * 35; idx += NTHR) { const int li = idx / 35, f = idx - li * 35; const float lf = (float)(l0 + li);
            float v;
            if (f == 0) v = lf * invLm1;
            else if (f >= 33) v = 0.f;
            else { const int i = (f - 1) & 15; const float band = 1e-4f + (float)i * ((15.0f - 1e-4f) / 15.0f); const float a = 2.0f * lf * band / (float)L;
                v = f <= 16 ? cospif(a) : -sinpif(a); }
            Z[idx] = v; }
        __syncthreads();
        if (wv < 4) { const int lt2 = wv >> 1, j = (wv & 1) * 32 + r; f32x16 acc;
#pragma unroll
            for (int e = 0; e < 16; ++e) acc[e] = 0.f;
#pragma unroll
            for (int s = 0; s < 17; ++s) { const int k = 2 * s + kh; const float a = Z[(lt2 * 32 + r) * 35 + k], b = k < 33 ? w1[k * 64 + j] : 0.f; acc = MFMAF32(a, b, acc); }
            const float bj = b1[j], fj = f1[j];
#pragma unroll
            for (int e = 0; e < 16; ++e) H1[(lt2 * 32 + (e & 3) + 8 * (e >> 2) + 4 * kh) * 65 + j] = __sinf(fj * (acc[e] + bj)); }
        __syncthreads();
        if (wv < 4) { const int lt2 = wv >> 1, j = (wv & 1) * 32 + r; f32x16 acc;
#pragma unroll
            for (int e = 0; e < 16; ++e) acc[e] = 0.f;
#pragma unroll
            for (int s = 0; s < 32; ++s) { const int k = 2 * s + kh; acc = MFMAF32(H1[(lt2 * 32 + r) * 65 + k], w2[k * 64 + j], acc); }
            const float bj = b2[j], fj = f2[j];
#pragma unroll
            for (int e = 0; e < 16; ++e) H2[(lt2 * 32 + (e & 3) + 8 * (e >> 2) + 4 * kh) * 65 + j] = __sinf(fj * (acc[e] + bj)); }
        __syncthreads();
        { const int dcl = wv * 32 + r;
#pragma unroll
          for (int lt2 = 0; lt2 < 2; ++lt2) { f32x16 acc;
#pragma unroll
              for (int e = 0; e < 16; ++e) acc[e] = 0.f;
#pragma unroll
              for (int s = 0; s < 32; ++s) acc = MFMAF32(H2[(lt2 * 32 + r) * 65 + 2 * s + kh], bw[s], acc);
#pragma unroll
              for (int e = 0; e < 16; ++e) { const int li = lt2 * 32 + (e & 3) + 8 * (e >> 2) + 4 * kh; const float t = (float)(l0 + li) * invLm1; T[dcl * 65 + li] = acc[e] * __expf(-t * dec); } } }
        __syncthreads();
#pragma unroll 2
        for (int it = 0; it < 32; ++it) { const int row = (tid >> 6) + 8 * it, i = tid & 63, c = c0 + row, l = l0 + i; float v = T[row * 65 + i]; int n;
            if (dir == 0) { n = l; if (l == 0) v += skip[c]; }
            else { if (l == 0) { n = L; v = 0.f; } else n = 2 * L - l; }
            KTb[(size_t)c * (2 * L) + n] = v; }
        __syncthreads();
    }
}

struct HyUnit { int ct, seq, t0, L, rowbase; size_t uoff; };
__device__ __forceinline__ HyUnit hy_unit(int unit) { HyUnit u; u.ct = unit & 15; const int tt = unit >> 4;
    if (tt < 256) { u.seq = tt >> 6; u.t0 = (tt & 63) * 64; u.L = LP; u.rowbase = u.seq * LP; u.uoff = 0; }
    else { const int t2 = tt - 256; u.seq = t2 >> 5; u.t0 = (t2 & 31) * 64; u.L = LS; u.rowbase = MP + u.seq * LS; u.uoff = (size_t)HW * 4 * LP; }
    return u; }
template <int NC> __device__ __forceinline__ void hy_load(const bf16* HY, const HyUnit& u, int comp0, int cp, int tq, unsigned (&xr)[NC][10]) {
    const int c = u.ct * 128 + 2 * cp;
#pragma unroll
    for (int i = 0; i < 10; ++i) { const int t = u.t0 + tq * 8 - 1 + i;
#pragma unroll
        for (int cm = 0; cm < NC; ++cm) { unsigned v = 0u; if (t >= 0 && t < u.L) v = *(const unsigned*)(HY + (size_t)(u.rowbase + t) * 6144 + (comp0 + cm) * 2048 + c); xr[cm][i] = v; } }
}
__device__ __forceinline__ void h1_phase(const Frame& F, const Args& A, const bf16* HY, bf16* UT) {
    const float* sw = A.in[8]; const float* sb = A.in[9];
    LAS float* T = (LAS float*)F.lds;
    if (F.vcu >= 6144) return;
    unsigned xr[2][10], xn[2][10];
    { const int tid0 = F.tid; hy_load<2>(HY, hy_unit(F.vcu), 0, tid0 & 63, tid0 >> 6, xr); }
#pragma unroll 1
    for (int unit = F.vcu; unit < 6144; unit += F.G) {
        int tid = F.tid; asm volatile("" : "+v"(tid)); const int cp = tid & 63, tq = tid >> 6;
        const HyUnit u = hy_unit(unit); const bool more = unit + F.G < 6144;
        if (more) hy_load<2>(HY, hy_unit(unit + F.G), 0, cp, tq, xn);
        const int ct = u.ct, seq = u.seq, t0 = u.t0, L = u.L; bf16* ut = UT + u.uoff;
        const int c = ct * 128 + 2 * cp;
        float w[2][2][3], b[2][2];
#pragma unroll
        for (int cm = 0; cm < 2; ++cm)
#pragma unroll
            for (int ch = 0; ch < 2; ++ch) { b[cm][ch] = sb[cm * 2048 + c + ch];
#pragma unroll
                for (int k = 0; k < 3; ++k) w[cm][ch][k] = sw[k * 6144 + cm * 2048 + c + ch]; }
        float x[2][2][10];
#pragma unroll
        for (int i = 0; i < 10; ++i)
#pragma unroll
            for (int cm = 0; cm < 2; ++cm) { x[cm][0][i] = bflo(xr[cm][i]); x[cm][1][i] = bfhi(xr[cm][i]); }
#pragma unroll
        for (int i = 0; i < 8; ++i)
#pragma unroll
            for (int ch = 0; ch < 2; ++ch) {
                const float a = w[0][ch][0] * x[0][ch][i] + w[0][ch][1] * x[0][ch][i + 1] + w[0][ch][2] * x[0][ch][i + 2] + b[0][ch];
                const float d = w[1][ch][0] * x[1][ch][i] + w[1][ch][1] * x[1][ch][i + 1] + w[1][ch][2] * x[1][ch][i + 2] + b[1][ch];
                T[(ch * 64 + cp) * 65 + tq * 8 + i] = a * d; }
        __syncthreads();
#pragma unroll 4
        for (int it = 0; it < 8; ++it) { const int rho = (tid >> 5) + 16 * it, i2 = tid & 31, cc = ct * 128 + 2 * (rho & 63) + (rho >> 6);
            *(unsigned*)(ut + ((size_t)cc * 4 + seq) * L + t0 + 2 * i2) = pk2f(T[rho * 65 + 2 * i2], T[rho * 65 + 2 * i2 + 1]); }
        __syncthreads();
        if (more) {
#pragma unroll
            for (int i = 0; i < 10; ++i) { xr[0][i] = xn[0][i]; xr[1][i] = xn[1][i]; } }
    }
}
__device__ __forceinline__ void h3_phase(const Frame& F, const Args& A, const bf16* HY, const bf16* UT, bf16* HYO) {
    const float* sw = A.in[8]; const float* sb = A.in[9];
    LAS float* T = (LAS float*)F.lds;
    if (F.vcu >= 6144) return;
    unsigned xr[1][10], xn[1][10], yr[8], yn[8];
    auto yload = [&](const HyUnit& u, int tid, unsigned (&y)[8]) {
#pragma unroll
        for (int it = 0; it < 8; ++it) { const int rho = (tid >> 5) + 16 * it, i2 = tid & 31, cc = u.ct * 128 + 2 * (rho & 63) + (rho >> 6);
            y[it] = *(const unsigned*)(UT + u.uoff + ((size_t)cc * 4 + u.seq) * u.L + u.t0 + 2 * i2); } };
    { const int tid0 = F.tid; const HyUnit u0 = hy_unit(F.vcu); yload(u0, tid0, yr); hy_load<1>(HY, u0, 2, tid0 & 63, tid0 >> 6, xr); }
#pragma unroll 1
    for (int unit = F.vcu; unit < 6144; unit += F.G) {
        int tid = F.tid; asm volatile("" : "+v"(tid)); const int cp = tid & 63, tq = tid >> 6;
        const HyUnit u = hy_unit(unit); const bool more = unit + F.G < 6144;
        if (more) { const HyUnit un = hy_unit(unit + F.G); yload(un, tid, yn); hy_load<1>(HY, un, 2, cp, tq, xn); }
        const int ct = u.ct, t0 = u.t0, rowbase = u.rowbase;
#pragma unroll
        for (int it = 0; it < 8; ++it) { const int rho = (tid >> 5) + 16 * it, i2 = tid & 31; T[rho * 65 + 2 * i2] = bflo(yr[it]); T[rho * 65 + 2 * i2 + 1] = bfhi(yr[it]); }
        const int c = ct * 128 + 2 * cp;
        float w[2][3], b[2];
#pragma unroll
        for (int ch = 0; ch < 2; ++ch) { b[ch] = sb[4096 + c + ch];
#pragma unroll
            for (int k = 0; k < 3; ++k) w[ch][k] = sw[k * 6144 + 4096 + c + ch]; }
        float x[2][10];
#pragma unroll
        for (int i = 0; i < 10; ++i) { x[0][i] = bflo(xr[0][i]); x[1][i] = bfhi(xr[0][i]); }
        __syncthreads();
#pragma unroll
        for (int i = 0; i < 8; ++i) {
            const float g0 = w[0][0] * x[0][i] + w[0][1] * x[0][i + 1] + w[0][2] * x[0][i + 2] + b[0];
            const float g1 = w[1][0] * x[1][i] + w[1][1] * x[1][i + 1] + w[1][2] * x[1][i + 2] + b[1];
            const float y0 = T[cp * 65 + tq * 8 + i], y1 = T[(64 + cp) * 65 + tq * 8 + i];
            *(unsigned*)(HYO + (size_t)(rowbase + t0 + tq * 8 + i) * 2048 + c) = pk2f(y0 * g0, y1 * g1); }
        __syncthreads();
        if (more) {
#pragma unroll
            for (int i = 0; i < 10; ++i) xr[0][i] = xn[0][i];
#pragma unroll
            for (int it = 0; it < 8; ++it) yr[it] = yn[it]; }
    }
}


#define HD_INLINE __device__ __forceinline__
#define XP(T) LAS T*
#ifndef FFT_CORE_H
#define FFT_CORE_H
#ifdef __HIP_DEVICE_COMPILE__
typedef float cf __attribute__((ext_vector_type(2)));
#elif defined(__clang__)
typedef float cf __attribute__((ext_vector_type(2)));
#else
struct cf { float x, y; };
#endif
#ifdef __HIPCC__
#define PK_ADD(r, a, b, OS, OH, NL, NH) asm("v_pk_add_f32 %0, %1, %2 op_sel:" OS " op_sel_hi:" OH " neg_lo:" NL " neg_hi:" NH : "=v"(r) : "v"(a), "v"(b))
#define PK_MUL(r, a, b, OS, OH, NL, NH) asm("v_pk_mul_f32 %0, %1, %2 op_sel:" OS " op_sel_hi:" OH " neg_lo:" NL " neg_hi:" NH : "=v"(r) : "v"(a), "v"(b))
#define PK_FMA(r, a, b, c, OS, OH, NL, NH) asm("v_pk_fma_f32 %0, %1, %2, %3 op_sel:" OS " op_sel_hi:" OH " neg_lo:" NL " neg_hi:" NH : "=v"(r) : "v"(a), "v"(b), "v"(c))
HD_INLINE cf cadd(cf a, cf b) { return a + b; }
HD_INLINE cf csub(cf a, cf b) { return a - b; }
HD_INLINE cf cscale(cf a, float s) { return a * s; }
#else
static inline float pk_src(cf v, const char* sel, const char* neg, int i) { const float f = (sel[1 + 2 * i] == '1') ? v.y : v.x; return (neg[1 + 2 * i] == '1') ? -f : f; }
#define PK_ADD(r, a, b, OS, OH, NL, NH) do { cf r_; r_.x = pk_src(a, OS, NL, 0) + pk_src(b, OS, NL, 1); r_.y = pk_src(a, OH, NH, 0) + pk_src(b, OH, NH, 1); r = r_; } while (0)
#define PK_MUL(r, a, b, OS, OH, NL, NH) do { cf r_; r_.x = pk_src(a, OS, NL, 0) * pk_src(b, OS, NL, 1); r_.y = pk_src(a, OH, NH, 0) * pk_src(b, OH, NH, 1); r = r_; } while (0)
#define PK_FMA(r, a, b, c, OS, OH, NL, NH) do { cf r_; r_.x = pk_src(a, OS, NL, 0) * pk_src(b, OS, NL, 1) + pk_src(c, OS, NL, 2); r_.y = pk_src(a, OH, NH, 0) * pk_src(b, OH, NH, 1) + pk_src(c, OH, NH, 2); r = r_; } while (0)
HD_INLINE cf cadd(cf a, cf b) { return cf{a.x + b.x, a.y + b.y}; }
HD_INLINE cf csub(cf a, cf b) { return cf{a.x - b.x, a.y - b.y}; }
HD_INLINE cf cscale(cf a, float s) { return cf{a.x * s, a.y * s}; }
#endif
HD_INLINE cf csub_mi(cf a, cf b) { cf r; PK_ADD(r, a, b, "[1,1]", "[0,0]", "[0,1]", "[1,0]"); return r; }
HD_INLINE cf cadd_pi(cf a, cf b) { cf r; PK_ADD(r, a, b, "[0,1]", "[1,0]", "[0,1]", "[0,0]"); return r; }
HD_INLINE cf csub_pi(cf a, cf b) { cf r; PK_ADD(r, a, b, "[0,1]", "[1,0]", "[0,0]", "[0,1]"); return r; }
HD_INLINE cf cmul(cf a, cf b) { cf t, r; PK_MUL(t, a, b, "[1,0]", "[1,1]", "[0,0]", "[0,0]");
    PK_FMA(r, a, b, t, "[0,0,1]", "[0,1,0]", "[0,0,1]", "[0,0,0]"); return r; }
HD_INLINE cf cmulc(cf a, cf b) { cf t, r; PK_MUL(t, a, b, "[1,0]", "[1,1]", "[0,0]", "[0,0]");
    PK_FMA(r, a, b, t, "[0,0,1]", "[0,1,0]", "[0,0,0]", "[1,0,0]"); return r; }
HD_INLINE cf csqr(cf a) { return cmul(a, a); }
HD_INLINE int fpad(int i) { return i + (i >> 4); }
HD_INLINE int wpad(int k) { return k + (k >> 4) + (k >> 8); }
HD_INLINE cf mul_w32(cf x, int idx, bool conj) {
    const float C[16] = {1.0f, 0.98078528040f, 0.92387953251f, 0.83146961230f, 0.70710678119f, 0.55557023302f, 0.38268343237f, 0.19509032202f, 0.0f, -0.19509032202f, -0.38268343237f, -0.55557023302f, -0.70710678119f, -0.83146961230f, -0.92387953251f, -0.98078528040f};
    const float S[16] = {0.0f, 0.19509032202f, 0.38268343237f, 0.55557023302f, 0.70710678119f, 0.83146961230f, 0.92387953251f, 0.98078528040f, 1.0f, 0.98078528040f, 0.92387953251f, 0.83146961230f, 0.70710678119f, 0.55557023302f, 0.38268343237f, 0.19509032202f};
    if (idx == 0) return x;
    if (idx == 8) return conj ? cf{-x.y, x.x} : cf{x.y, -x.x};
    const float c = C[idx], s = conj ? -S[idx] : S[idx];
#ifdef __HIPCC__
    const cf t = x.yx * cf{s, -s}; return __builtin_elementwise_fma(x, cf{c, c}, t);
#else
    return cf{x.x * c + x.y * s, x.y * c - x.x * s};
#endif
}
HD_INLINE int brev(int j, int lr) { int r = 0; for (int b = 0; b < lr; ++b) r |= ((j >> b) & 1) << (lr - 1 - b); return r; }
template <int R> HD_INLINE void wpowers(cf w, cf (&p)[R]) {
    p[0] = cf{1.0f, 0.0f}; if (R > 1) p[1] = w;
#pragma unroll
    for (int k = 2; k < R; ++k) p[k] = (k & 1) ? cmul(p[k - 1], w) : csqr(p[k >> 1]);
}
template <int LR> HD_INLINE void dif_regs(cf (&v)[1 << LR], XP(const cf) W, int N, int q, int o) {
    constexpr int R = 1 << LR;
#pragma unroll
    for (int st = 0; st < LR; ++st) {
        const int half = R >> (st + 1);
#pragma unroll
        for (int j = 0; j < R; ++j) {
            if ((j & half) == 0) {
                const cf a = v[j], b = v[j + half];
                const int idx = (j & (half - 1)) * (16 / half);
                v[j] = cadd(a, b);
                v[j + half] = (idx == 8) ? csub_mi(a, b) : mul_w32(csub(a, b), idx, false);
            }
        }
    }
    if (q > 1) {
        if (R == 32) {
            cf p[16]; wpowers<16>(W[wpad(o * (N / (R * q)))], p); const cf p16 = csqr(p[8]);
#pragma unroll
            for (int j = 1; j < R; ++j) { const int k = brev(j, LR); v[j] = cmul(v[j], k < 16 ? p[k & 15] : cmul(p[k & 15], p16)); }
        } else {
        cf p[R]; wpowers<R>(W[wpad(o * (N / (R * q)))], p);
#pragma unroll
        for (int j = 1; j < R; ++j) v[j] = cmul(v[j], p[brev(j, LR)]);
        }
    }
}
template <int LR> HD_INLINE void dit_regs(cf (&v)[1 << LR], XP(const cf) W, int N, int s0, int o) {
    constexpr int R = 1 << LR;
    if (s0 > 1) {
        if (R == 32) {
            cf p[16]; wpowers<16>(W[wpad(o * (N / (R * s0)))], p); const cf p16 = csqr(p[8]);
#pragma unroll
            for (int j = 1; j < R; ++j) { const int k = brev(j, LR); v[j] = cmulc(v[j], k < 16 ? p[k & 15] : cmul(p[k & 15], p16)); }
        } else {
        cf p[R]; wpowers<R>(W[wpad(o * (N / (R * s0)))], p);
#pragma unroll
        for (int j = 1; j < R; ++j) v[j] = cmulc(v[j], p[brev(j, LR)]);
        }
    }
#pragma unroll
    for (int st = 0; st < LR; ++st) {
        const int half = 1 << st;
#pragma unroll
        for (int j = 0; j < R; ++j) {
            if ((j & half) == 0) {
                const int idx = (j & (half - 1)) * (16 / half);
                const cf a = v[j];
                if (idx == 8) { const cf x = v[j + half]; v[j] = cadd_pi(a, x); v[j + half] = csub_pi(a, x); }
                else { const cf b = mul_w32(v[j + half], idx, true); v[j] = cadd(a, b); v[j + half] = csub(a, b); }
            }
        }
    }
}
template <int LR> HD_INLINE void dif_pass(XP(cf) X, XP(const cf) W, int N, int S, int tid, int nthr) {
    constexpr int R = 1 << LR;
    const int q = S >> (LR - 1);
#pragma unroll 1
    for (int bf = tid; bf < N / R; bf += nthr) {
        const int blk = bf / q, o = bf - blk * q, base = blk * 2 * S + o;
        cf v[R];
#pragma unroll
        for (int j = 0; j < R; ++j) v[j] = X[fpad(base + j * q)];
        dif_regs<LR>(v, W, N, q, o);
#pragma unroll
        for (int j = 0; j < R; ++j) X[fpad(base + j * q)] = v[j];
    }
}
template <int LR> HD_INLINE void dit_pass(XP(cf) X, XP(const cf) W, int N, int s0, int tid, int nthr) {
    constexpr int R = 1 << LR;
#pragma unroll 1
    for (int bf = tid; bf < N / R; bf += nthr) {
        const int blk = bf / s0, o = bf - blk * s0, base = blk * R * s0 + o;
        cf v[R];
#pragma unroll
        for (int j = 0; j < R; ++j) v[j] = X[fpad(base + j * s0)];
        dit_regs<LR>(v, W, N, s0, o);
#pragma unroll
        for (int j = 0; j < R; ++j) X[fpad(base + j * s0)] = v[j];
    }
}
#endif
#undef HD_INLINE
#undef XP
constexpr int FFT_W_OFF = (8192 + 512 + 16) * 8;
template <int RA> struct FftIn { float ktv[RA]; unsigned up0[RA / 2], up1[RA / 2]; };
template <int RA> __device__ __forceinline__ void fft_load_kt(FftIn<RA>& in, const float* kt, int tid) {
#pragma unroll
    for (int j = 0; j < RA; ++j) in.ktv[j] = kt[tid + 256 * j]; }
template <int RA> __device__ __forceinline__ void fft_load_u(unsigned (&up)[RA / 2], const bf16* u0, int L, int tid) {
#pragma unroll
    for (int j = 0; j < RA / 2; ++j) up[j] = (unsigned)u0[tid + 256 * j] | ((unsigned)u0[(size_t)L + tid + 256 * j] << 16); }
template <int LOG2N> __device__ __forceinline__ void fft_conv_channel(const Frame& F, FftIn<(LOG2N == 13) ? 32 : 16>& in, const float* kt_next, bf16* u, const bf16* u_next, int L) {
    constexpr int N = 1 << LOG2N, LRA = (LOG2N == 13) ? 5 : 4, RA = 1 << LRA, NIN_A = RA / 2, NT1 = N / RA;
    static_assert(NT1 == 256, "stride");
    LAS cf* X = (LAS cf*)F.lds; const LAS cf* W = (const LAS cf*)(F.lds + FFT_W_OFF);
    int tid = F.tid; asm volatile("" : "+v"(tid));
    const bool t1 = tid < NT1;
    const bool hn = kt_next != nullptr;
    if (t1) {
        cf v[RA];
#pragma unroll
        for (int j = 0; j < RA; ++j) v[j] = cf{in.ktv[j], 0.f};
        dif_regs<LRA>(v, W, N, NT1, tid);
#pragma unroll
        for (int j = 0; j < RA; ++j) X[fpad(tid + NT1 * j)] = v[j];
    }
    __syncthreads();
    dif_pass<4>(X, W, N, 128, tid, NTHR);
    __syncthreads();
    cf kf[16];
    if (tid < N / 16) {
#pragma unroll
        for (int j = 0; j < 16; ++j) kf[j] = X[fpad(tid * 16 + j)];
        dif_regs<4>(kf, W, N, 1, 0);
#pragma unroll
        for (int j = 0; j < 16; ++j) kf[j] = cscale(kf[j], 1.0f / N);
    } else {
#pragma unroll
        for (int j = 0; j < 16; ++j) kf[j] = cf{0.f, 0.f};
    }
    __syncthreads();
#pragma unroll
    for (int pr = 0; pr < 2; ++pr) {
        bf16* u0 = u + (size_t)(2 * pr) * L; bf16* u1 = u0 + L;
        if (t1) { cf v[RA];
#pragma unroll
          for (int j = 0; j < RA; ++j) { const unsigned w = (j < NIN_A) ? (pr ? in.up1[j < NIN_A ? j : 0] : in.up0[j < NIN_A ? j : 0]) : 0u; v[j] = (j < NIN_A) ? cf{__uint_as_float(w << 16), __uint_as_float(w & 0xffff0000u)} : cf{0.f, 0.f}; }
          if (hn) { if (pr == 0) fft_load_u<RA>(in.up0, u_next, L, tid); else fft_load_u<RA>(in.up1, u_next + (size_t)2 * L, L, tid); }
          dif_regs<LRA>(v, W, N, NT1, tid);
#pragma unroll
          for (int j = 0; j < RA; ++j) X[fpad(tid + NT1 * j)] = v[j]; }
        __syncthreads();
        dif_pass<4>(X, W, N, 128, tid, NTHR);
        __syncthreads();
        if (tid < N / 16) { cf v[16];
#pragma unroll
            for (int j = 0; j < 16; ++j) v[j] = X[fpad(tid * 16 + j)];
            dif_regs<4>(v, W, N, 1, 0);
#pragma unroll
            for (int j = 0; j < 16; ++j) v[j] = cmul(v[j], kf[j]);
            dit_regs<4>(v, W, N, 1, 0);
#pragma unroll
            for (int j = 0; j < 16; ++j) X[fpad(tid * 16 + j)] = v[j]; }
        if (pr == 1 && hn && t1) fft_load_kt<RA>(in, kt_next, tid);
        __syncthreads();
        dit_pass<4>(X, W, N, 16, tid, NTHR);
        __syncthreads();
        if (t1) { cf v[RA];
#pragma unroll
          for (int j = 0; j < RA; ++j) v[j] = X[fpad(tid + NT1 * j)];
          dit_regs<LRA>(v, W, N, NT1, tid);
#pragma unroll
          for (int j = 0; j < NIN_A; ++j) { u0[tid + NT1 * j] = (bf16)(pk2f(v[j].x, 0.f) & 0xffffu); u1[tid + NT1 * j] = (bf16)(pk2f(v[j].y, 0.f) & 0xffffu); } }
        __syncthreads();
    }
}
template <int LOG2N> __device__ __forceinline__ void fft_channels(const Frame& F, const float* KTb, bf16* UTb, int L) {
    constexpr int RA = (LOG2N == 13) ? 32 : 16; constexpr size_t KS = (size_t)1 << LOG2N;
    int c = F.vcu; if (c >= HW) return;
    FftIn<RA> in;
    { int tid = F.tid; asm volatile("" : "+v"(tid));
      if (tid < 256) { fft_load_kt<RA>(in, KTb + (size_t)c * KS, tid); fft_load_u<RA>(in.up0, UTb + (size_t)c * 4 * L, L, tid); fft_load_u<RA>(in.up1, UTb + (size_t)c * 4 * L + (size_t)2 * L, L, tid); } }
#pragma unroll 1
    for (; c < HW; c += F.G) { const int cn = c + F.G; const bool hn = cn < HW;
        fft_conv_channel<LOG2N>(F, in, hn ? KTb + (size_t)cn * KS : nullptr, UTb + (size_t)c * 4 * L, hn ? UTb + (size_t)cn * 4 * L : nullptr, L); }
}
__device__ __forceinline__ void h2_phase(const Frame& F, const float* KT, bf16* UT) {
    LAS cf* W = (LAS cf*)(F.lds + FFT_W_OFF);
    for (int k = F.tid; k < 4096; k += NTHR) { const float a = (float)k * (1.0f / 4096.0f); W[wpad(k)] = cf{cospif(a), -sinpif(a)}; }
    __syncthreads();
    fft_channels<13>(F, KT, UT, LP);
    __syncthreads();
    for (int k = F.tid; k < 2048; k += NTHR) { const float a = (float)k * (1.0f / 2048.0f); W[wpad(k)] = cf{cospif(a), -sinpif(a)}; }
    __syncthreads();
    fft_channels<12>(F, KT + (size_t)HW * 8192, UT + (size_t)HW * 4 * LP, LS);
    __syncthreads();
}

constexpr int ATT_KROW = 272, ATT_VROW = 648, ATT_BIAS_OFF = 320 * ATT_KROW, ATT_OROW = 272;
#define MFMA32(a, b, c) __builtin_amdgcn_mfma_f32_32x32x16_bf16((a), (b), (c), 0, 0, 0)
__device__ __forceinline__ void attn_phase(const Frame& F, const Args& A, const bf16* QKV, bf16* ATT) {
    const int g4 = F.wave >> 1, sub = F.wave & 1;
    LAS unsigned char* lds = F.lds;
    LAS float* BIAS = (LAS float*)(lds + ATT_BIAS_OFF);
    { const float* rel_bias = A.in[4];
      for (int idx = F.tid; idx < 16 * 257; idx += NTHR) { const int hh = idx / 257, ri = idx - hh * 257, rel = ri - 128, n = rel < 0 ? -rel : rel; int b;
          if (n < 8) b = n; else { int e = 0; while ((64 << (e + 1)) <= n * n) ++e; b = 8 + e; if (b > 15) b = 15; }
          if (rel > 0) b += 16;
          BIAS[hh * 260 + ri] = rel_bias[b * 16 + hh] * 1.44269504089f; } }
    __syncthreads();
    v4u kpre[10]; bf16x8 qf[8];
    auto unit_geom = [&](int unit, int& kvh, int& q0, int& L, int& rowbase) __attribute__((always_inline)) { kvh = unit & 3; const int tile = unit >> 2;
        if (tile < 256) { rowbase = (tile >> 6) * LP; q0 = (tile & 63) * 64; L = LP; } else { const int t2 = tile - 256; rowbase = MP + (t2 >> 5) * LS; q0 = (t2 & 31) * 64; L = LS; } };
    auto issue_k = [&](int unit, int lane) __attribute__((always_inline)) { int kvh, q0, L, rowbase; unit_geom(unit, kvh, q0, L, rowbase); const int rl = lane >> 4, ch = lane & 15;
#pragma unroll
        for (int i = 0; i < 10; ++i) { const int row = (F.wave * 10 + i) * 4 + rl, kp = q0 - 128 + row; kpre[i] = (v4u){0u, 0u, 0u, 0u};
            if (kp >= 0 && kp < L) kpre[i] = *(const v4u*)(QKV + (size_t)(rowbase + kp) * 3072 + 2048 + kvh * 128 + ch * 8); } };
    auto issue_q = [&](int unit, int lane) __attribute__((always_inline)) { int kvh, q0, L, rowbase; unit_geom(unit, kvh, q0, L, rowbase); const int r = lane & 31, h = lane >> 5, hq = kvh * 4 + g4;
        const bf16* qp = QKV + (size_t)(rowbase + q0 + sub * 32 + r) * 3072 + hq * 128 + 8 * h;
#pragma unroll
        for (int s = 0; s < 8; ++s) qf[s] = *(const bf16x8*)(qp + 16 * s); };
    if (F.vcu < 1536) { int lane0 = F.lane; asm volatile("" : "+v"(lane0)); issue_k(F.vcu, lane0); issue_q(F.vcu, lane0); }
#pragma unroll 1
    for (int unit = F.vcu; unit < 1536; unit += F.G) {
        int lane = F.lane; asm volatile("" : "+v"(lane));
        const int r = lane & 31, h = lane >> 5;
        int kvh, q0, L, rowbase; unit_geom(unit, kvh, q0, L, rowbase);
        const int hq = kvh * 4 + g4;
        { const int rl = lane >> 4, ch = lane & 15;
#pragma unroll
          for (int i = 0; i < 10; ++i) { const int row = (F.wave * 10 + i) * 4 + rl; *(LAS v4u*)(lds + row * ATT_KROW + ch * 16) = kpre[i]; } }
        __syncthreads();
        f32x16 sacc[9];
        { const LAS unsigned char* kb = lds + (sub * 32 + r) * ATT_KROW + h * 16;
#pragma unroll
          for (int kt = 0; kt < 9; ++kt) {
#pragma unroll
              for (int e = 0; e < 16; ++e) sacc[kt][e] = 0.f;
#pragma unroll
              for (int s = 0; s < 8; ++s) { const bf16x8 a = *(const LAS bf16x8*)(kb + kt * 32 * ATT_KROW + s * 32); sacc[kt] = MFMA32(a, qf[s], sacc[kt]); }
              __builtin_amdgcn_sched_barrier(0);
          } }
        v4u vv[10];
#pragma unroll
        for (int i = 0; i < 10; ++i) { const int combo = F.wave * 10 + i, kg = combo % 5, ch = combo / 5, kp = q0 - 128 + kg * 64 + lane; vv[i] = (v4u){0u, 0u, 0u, 0u};
            if (kp >= 0 && kp < L) vv[i] = *(const v4u*)(QKV + (size_t)(rowbase + kp) * 3072 + 2560 + kvh * 128 + ch * 8); }
        const float sink = A.in[7][hq] * 1.44269504089f;
        float mx = sink;
        const bool interior = (q0 >= 128) && (q0 + 192 <= L);
        { const int qpos = q0 + sub * 32 + r, relb = 4 * h - 128 - r; const LAS float* bh = BIAS + hq * 260 + 128 + relb;
#pragma unroll
          for (int kt = 0; kt < 9; ++kt) {
              if (interior && kt >= 1 && kt <= 7) {
#pragma unroll
                  for (int e = 0; e < 16; ++e) { const float sv = sacc[kt][e] + bh[kt * 32 + (e & 3) + 8 * (e >> 2)]; sacc[kt][e] = sv; mx = fmaxf(mx, sv); }
              } else {
#pragma unroll
              for (int e = 0; e < 16; ++e) { const int ro = kt * 32 + (e & 3) + 8 * (e >> 2); const int rel = relb + ro; const int kp = qpos + rel;
                  bool ok = kp >= 0 && kp < L; float bv;
                  if (kt == 0) { ok = ok && rel >= -128; bv = bh[ok ? ro : -relb]; }
                  else if (kt == 8) { ok = ok && rel <= 128; bv = bh[ok ? ro : -relb]; }
                  else bv = bh[ro];
                  const float sv = ok ? sacc[kt][e] + bv : -1e30f; sacc[kt][e] = sv; mx = fmaxf(mx, sv); }
              }
              __builtin_amdgcn_sched_barrier(0);
          } }
        mx = fmaxf(mx, shx(mx, 32, lane));
        float sum = 0.f; float __attribute__((ext_vector_type(2))) sum2 = {0.f, 0.f};
        bf16x8 pf[9][2];
#pragma unroll
        for (int kt = 0; kt < 9; ++kt) {
#pragma unroll
            for (int e = 0; e < 16; e += 2) { typedef float f2_ __attribute__((ext_vector_type(2)));
                const f2_ d = (f2_){sacc[kt][e], sacc[kt][e + 1]} - mx; f2_ p; p.x = __builtin_amdgcn_exp2f(d.x); p.y = __builtin_amdgcn_exp2f(d.y);
                sacc[kt][e] = p.x; sacc[kt][e + 1] = p.y; sum2 += p; }
#pragma unroll
            for (int s2 = 0; s2 < 2; ++s2) { v4u w;
                w.x = pk2f(sacc[kt][8 * s2 + 0], sacc[kt][8 * s2 + 1]); w.y = pk2f(sacc[kt][8 * s2 + 2], sacc[kt][8 * s2 + 3]);
                w.z = pk2f(sacc[kt][8 * s2 + 4], sacc[kt][8 * s2 + 5]); w.w = pk2f(sacc[kt][8 * s2 + 6], sacc[kt][8 * s2 + 7]);
                pf[kt][s2] = __builtin_bit_cast(bf16x8, w); }
            __builtin_amdgcn_sched_barrier(0);
        }
        sum = sum2.x + sum2.y; sum += shx(sum, 32, lane);
        const float inv = 1.0f / (sum + __builtin_amdgcn_exp2f(sink - mx));
        __syncthreads();
#pragma unroll
        for (int i = 0; i < 10; ++i) { const int combo = F.wave * 10 + i, kg = combo % 5, ch = combo / 5; LAS bf16* vp = (LAS bf16*)(lds + (ch * 8) * ATT_VROW + (kg * 64 + lane) * 2);
            vp[0 * 324] = (bf16)(vv[i].x & 0xffffu); vp[1 * 324] = (bf16)(vv[i].x >> 16); vp[2 * 324] = (bf16)(vv[i].y & 0xffffu); vp[3 * 324] = (bf16)(vv[i].y >> 16);
            vp[4 * 324] = (bf16)(vv[i].z & 0xffffu); vp[5 * 324] = (bf16)(vv[i].z >> 16); vp[6 * 324] = (bf16)(vv[i].w & 0xffffu); vp[7 * 324] = (bf16)(vv[i].w >> 16); }
        __syncthreads();
        f32x16 oacc[4];
#pragma unroll
        for (int dt = 0; dt < 4; ++dt)
#pragma unroll
            for (int e = 0; e < 16; ++e) oacc[dt][e] = 0.f;
        { const LAS unsigned char* vb0 = lds + r * ATT_VROW + (sub * 32 + 4 * h) * 2;
#pragma unroll
          for (int kt = 0; kt < 9; ++kt)
#pragma unroll
              for (int s2 = 0; s2 < 2; ++s2) {
#pragma unroll
                  for (int dt = 0; dt < 4; ++dt) { const LAS unsigned char* vb = vb0 + dt * 32 * ATT_VROW + (kt * 32 + 16 * s2) * 2;
                      const s16x4 lo = *(const LAS s16x4*)vb, hi = *(const LAS s16x4*)(vb + 16);
                      const bf16x8 bfr = {lo[0], lo[1], lo[2], lo[3], hi[0], hi[1], hi[2], hi[3]};
                      oacc[dt] = MFMA32(pf[kt][s2], bfr, oacc[dt]); }
                  if (kt == 4 && s2 == 1) issue_k(unit + F.G < 1536 ? unit + F.G : unit, lane);
                  if (kt == 8 && s2 == 1) issue_q(unit + F.G < 1536 ? unit + F.G : unit, lane);
                  __builtin_amdgcn_sched_barrier(0); } }
        __syncthreads();
        { LAS unsigned char* ob = lds + F.wave * (32 * ATT_OROW);
          LAS bf16* ow = (LAS bf16*)(ob + (4 * h) * ATT_OROW + r * 2);
          float invq[16];
#pragma unroll
          for (int e = 0; e < 16; ++e) invq[e] = __int_as_float(__builtin_amdgcn_ds_bpermute(((e & 3) + 8 * (e >> 2) + 4 * h) << 2, __float_as_int(inv)));
#pragma unroll
          for (int dt = 0; dt < 4; ++dt)
#pragma unroll
              for (int e = 0; e < 16; ++e) ow[((e & 3) + 8 * (e >> 2)) * (ATT_OROW / 2) + dt * 32] = (bf16)(pk2f(oacc[dt][e] * invq[e], 0.f) & 0xffffu);
          LDS_WAIT(); asm volatile("" ::: "memory");
          bf16* op = ATT + (size_t)(rowbase + q0 + sub * 32 + (lane >> 4)) * 2048 + hq * 128 + (lane & 15) * 8;
          const LAS unsigned char* orp = ob + (lane >> 4) * ATT_OROW + (lane & 15) * 16;
#pragma unroll
          for (int i = 0; i < 8; ++i) *(v4u*)(op + (size_t)i * 4 * 2048) = *(const LAS v4u*)(orp + i * 4 * ATT_OROW); }
        __syncthreads();
    }
}

__device__ __forceinline__ void attn_naive(const Frame& F, const Args& A, const bf16* QKV, bf16* ATT) {
    const float* rel_bias = A.in[4]; const int lane = F.lane;
    const int gw = F.vcu * NWAVES + F.wave, NGW = F.G * NWAVES;
#pragma unroll 1
    for (int item = gw; item < M * 16; item += NGW) {
        const int row = item >> 4, hq = item & 15, kvh = hq >> 2;
        int L, rowbase, t;
        if (row < MP) { L = LP; rowbase = row & ~(LP - 1); t = row & (LP - 1); } else { L = LS; const int r2 = row - MP; rowbase = MP + (r2 & ~(LS - 1)); t = r2 & (LS - 1); }
        const bf16* qp = QKV + (size_t)row * 3072 + hq * 128;
        const float q0 = __uint_as_float((unsigned)qp[lane] << 16), q1 = __uint_as_float((unsigned)qp[64 + lane] << 16);
        float m = A.in[7][hq] * 1.44269504089f, l = 1.0f, o0 = 0.f, o1 = 0.f;
        const int jlo = t - 128 < 0 ? 0 : t - 128, jhi = t + 128 > L - 1 ? L - 1 : t + 128;
#pragma unroll 1
        for (int j = jlo; j <= jhi; ++j) {
            const bf16* kp = QKV + (size_t)(rowbase + j) * 3072 + 2048 + kvh * 128; const bf16* vp = kp + 512;
            float s = q0 * __uint_as_float((unsigned)kp[lane] << 16) + q1 * __uint_as_float((unsigned)kp[64 + lane] << 16);
#pragma unroll
            for (int o = 1; o < 64; o <<= 1) s += shx(s, o, lane);
            const int rel = j - t, n = rel < 0 ? -rel : rel; int b;
            if (n < 8) b = n; else { int e = 0; while ((64 << (e + 1)) <= n * n) ++e; b = 8 + e; if (b > 15) b = 15; }
            if (rel > 0) b += 16;
            s += rel_bias[b * 16 + hq] * 1.44269504089f;
            const float mn = fmaxf(m, s), sc = exp2f(m - mn), p = exp2f(s - mn);
            l = l * sc + p; o0 = o0 * sc + p * __uint_as_float((unsigned)vp[lane] << 16); o1 = o1 * sc + p * __uint_as_float((unsigned)vp[64 + lane] << 16); m = mn;
        }
        bf16* op = ATT + (size_t)row * 2048 + hq * 128;
        op[lane] = (bf16)(pk2f(o0 / l, 0.f) & 0xffffu); op[64 + lane] = (bf16)(pk2f(o1 / l, 0.f) & 0xffffu);
    }
}

#ifndef DIAG_CLOCK
#define DIAG_CLOCK 0
#endif
__device__ __forceinline__ void p0_prologue(Frame F, const Args& A, unsigned char* ws, unsigned char* dob) {
    LAS float* scr = (LAS float*)(F.lds + F.wave * 16384);
    const int gw = F.vcu * NWAVES + F.wave, NGW = F.G * NWAVES;
    constexpr int I_IN = (DM / 64) * (NIN / 32), I_AO = (AW / 64) * (DM / 32), I_HO = (HW / 64) * (DM / 32), I_OUT = (DM / 64) * (DM / 32), I_UP = (DM / 64) * (2 * FF / 32), I_DN = (FF / 64) * (DM / 32), I_PG = (DM / 64) * (DM / 32), I_PL = (PLE / 64) * (DM / 32);
    constexpr int NITEMS = I_IN + I_AO + I_HO + I_OUT + I_UP;
    auto decode = [&](int it) -> TrItem { int r = it;
        if (r < I_IN) { TrItem t = tr_item(A.in[6], DM, NIN, (bf16*)(ws + WS_WIN), nullptr, r); if (t.n0 >= 36 * 256) t.sc = -1.44269504089f; else if (t.n0 < 2048) t.sc = 0.08838834764831845f * 1.4426950408889634f; return t; } r -= I_IN;
        if (r < I_AO) return tr_item(A.in[19], AW, DM, (bf16*)(ws + WS_WAO), nullptr, r); r -= I_AO;
        if (r < I_HO) return tr_item(A.in[20], HW, DM, (bf16*)(ws + WS_WHO), nullptr, r); r -= I_HO;
        if (r < I_OUT) return tr_item(A.in[21], DM, DM, (bf16*)(ws + WS_WOUT), nullptr, r); r -= I_OUT;
        return tr_item(A.in[23], DM, 2 * FF, (bf16*)(ws + WS_WUP), A.in[22], r); };
    const bool h0first_ = (((int)blockIdx.x >> 3) & 1) != 0;
    if (h0first_) { refresh(F); h0_phase(F, A, (float*)(dob + DO_KT)); __syncthreads(); refresh(F); }
    if (gw < NITEMS) {
        float wa[32], wb[32]; TrItem ci = decode(gw); tr_load(ci, F.lane, wa);
#pragma unroll 1
        for (int it = gw; it < NITEMS; it += NGW) {
            const bool more = it + NGW < NITEMS; TrItem ni = ci;
            if (more) { ni = decode(it + NGW); tr_load(ni, F.lane, wb); }
            tr_store(ci, F.lane, wa, scr);
            if (more) {
#pragma unroll
                for (int i = 0; i < 32; ++i) wa[i] = wb[i];
                ci = ni; }
        }
    }
    if (DIAG_CLOCK >= 15 && blockIdx.x == 0) { __syncthreads(); if (threadIdx.x == 0) ((unsigned long long*)(ws + WS_CTL + 16384))[50] = wall_clock64(); }
    refresh(F);
    rms_phase_bf16(F, A.in[0], A.in[1], A.in[5], (bf16*)(dob + DO_XN));
    refresh(F);
    { bf16* PB = (bf16*)(ws + WS_PB); const size_t gt = (size_t)F.vcu * NTHR + F.tid, GT_ = (size_t)F.G * NTHR;
      constexpr size_t NQ = (size_t)M * PLE / 4;
      f32x4 v[12];
#pragma unroll
      for (int q = 0; q < 12; ++q) { const size_t i = gt + (size_t)q * GT_, e = i * 4; v[q] = (f32x4){0.f, 0.f, 0.f, 0.f}; if (i < NQ) v[q] = *(const f32x4*)(e < (size_t)MP * PLE ? A.in[2] + e : A.in[3] + (e - (size_t)MP * PLE)); }
#pragma unroll
      for (int q = 0; q < 12; ++q) { const size_t i = gt + (size_t)q * GT_, e = i * 4; if (i < NQ) *(unsigned long long*)(PB + e) = (unsigned long long)pk2f(v[q].x, v[q].y) | ((unsigned long long)pk2f(v[q].z, v[q].w) << 32); }
      for (size_t i = gt + 12 * GT_; i < NQ; i += GT_) { const size_t e = i * 4; const float* src = e < (size_t)MP * PLE ? A.in[2] + e : A.in[3] + (e - (size_t)MP * PLE);
          const f32x4 w = *(const f32x4*)src; *(unsigned long long*)(PB + e) = (unsigned long long)pk2f(w.x, w.y) | ((unsigned long long)pk2f(w.z, w.w) << 32); } }
    if (!h0first_) { __syncthreads(); refresh(F); h0_phase(F, A, (float*)(dob + DO_KT)); }
    if (DIAG_CLOCK >= 15 && blockIdx.x == 0) { __syncthreads(); if (threadIdx.x == 0) ((unsigned long long*)(ws + WS_CTL + 16384))[52] = wall_clock64(); }
}

__device__ __forceinline__ void tail_transpose_wdown(Frame F, const Args& A, unsigned char* ws, int blk0, int nblk) {
    const int b = (int)blockIdx.x - blk0; if (b < 0 || b >= nblk) return;
    refresh(F);
    LAS float* scr = (LAS float*)(F.lds + F.wave * 16384);
    constexpr int I_DN0 = (FF / 64) * (DM / 32), I_PG = (DM / 64) * (DM / 32), I_PL = (PLE / 64) * (DM / 32), I_DN = I_DN0 + I_PG + I_PL;
    auto tdec = [&](int r) -> TrItem { if (r < I_DN0) return tr_item(A.in[26], FF, DM, (bf16*)(ws + WS_WDN), nullptr, r); r -= I_DN0;
        if (r < I_PG) return tr_item(A.in[28], DM, DM, (bf16*)(ws + WS_WPG), A.in[27], r); r -= I_PG; return tr_item(A.in[29], PLE, DM, (bf16*)(ws + WS_WPL), nullptr, r); };
    const int w0 = b * NWAVES + F.wave, NW = nblk * NWAVES;
    if (w0 < I_DN) {
        float wa[32], wb[32]; TrItem ci = tdec(w0); tr_load(ci, F.lane, wa);
#pragma unroll 1
        for (int it = w0; it < I_DN; it += NW) {
            const bool more = it + NW < I_DN; TrItem ni = ci;
            if (more) { ni = tdec(it + NW); tr_load(ni, F.lane, wb); }
            tr_store(ci, F.lane, wa, scr);
            if (more) {
#pragma unroll
                for (int i = 0; i < 32; ++i) wa[i] = wb[i];
                ci = ni; }
        }
    }
}
constexpr int N_PHASES = 16;

#ifndef DBL_MASK
#define DBL_MASK 0
#endif
#ifndef DIAG_NAIVE_ATTN
#define DIAG_NAIVE_ATTN 0
#endif
__global__ void __launch_bounds__(NTHR, 2) fwd_kernel(Args args) {
    extern __shared__ __attribute__((aligned(16))) unsigned char lds[];
    Frame F;
    F.lds = (LAS unsigned char*)lds;
    volatile LAS unsigned* MISC = (volatile LAS unsigned*)(F.lds + MISC_OFF);
    F.wave = __builtin_amdgcn_readfirstlane((int)threadIdx.x >> 6); refresh(F);
    F.G = gridDim.x; { const int bx = blockIdx.x; F.vcu = (F.G % 8 == 0) ? (bx % 8) * (F.G / 8) + bx / 8 : bx; }
    unsigned char* ws = args.ws; unsigned char* dob = (unsigned char*)args.out;
    for (int u = F.tid; u < (LDS_BYTES - LDSCTL_OFF) / 4; u += NTHR) ((LAS unsigned*)(F.lds + LDSCTL_OFF))[u] = 0u;
    __syncthreads();
    XcdBarrier bar = xcd_barrier_post((unsigned*)(ws + WS_CTL) + CW_BAR, MISC + 8);
    const int lo = args.ph_lo, hi = args.ph_hi;
#ifdef ONLY_PHASE
#define IN(k) ((k) == ONLY_PHASE && lo <= (k))
#else
#define IN(k) (lo <= (k) && (k) < hi)
#endif
#define SEAM(k) do { if (IN(k) && IN((k) + 1)) xcd_barrier(bar); if (DIAG_CLOCK >= 3 && blockIdx.x == 0 && threadIdx.x == 0) ((unsigned long long*)(ws + WS_CTL + 16384))[(k) + 1] = wall_clock64(); } while (0)
#define REF() refresh(F)
    bf16* const QKV = (bf16*)(ws + WS_QKV); bf16* const HY = (bf16*)(ws + WS_HY); bf16* const GT = (bf16*)(ws + WS_GT);
    bf16* const ATT = (bf16*)(dob + DO_ATT); bf16* const HYO = (bf16*)(ws + WS_HYO); bf16* const TM = (bf16*)(ws + WS_TM);
    bf16* const XN2 = (bf16*)(ws + WS_XN2); bf16* const GU = (bf16*)(ws + WS_GU); bf16* const ACT = (bf16*)(ws + WS_ACT); bf16* const PP = (bf16*)(ws + WS_PP);
#ifndef USE_DYN
#define USE_DYN 0
#endif
#define DQ(i) (USE_DYN ? (unsigned*)(ws + WS_CTL + 786432) + (i) * 512 : (unsigned*)nullptr), (MISC + 16)
    float* const SS1 = (float*)(ws + WS_CTL + 262144); float* const SS2 = (float*)(ws + WS_CTL + 393216); float* const SS3 = (float*)(ws + WS_CTL + 524288); bf16* const X3 = (bf16*)(ws + WS_ACT);
    bf16* const GUS = (bf16*)dob;
    bf16* const UT = (bf16*)(dob + DO_UT); float* const KT = (float*)(dob + DO_KT); float* const OUT = args.out;

    if (DIAG_CLOCK >= 3 && blockIdx.x == 0 && threadIdx.x == 0) ((unsigned long long*)(ws + WS_CTL + 16384))[0] = wall_clock64();
    if (IN(0)) for (int rep_ = 0; rep_ < 1 + ((DBL_MASK >> 0) & 1); ++rep_) { if (rep_) __syncthreads(); REF(); p0_prologue(F, args, ws, dob); } SEAM(0);
    unsigned long long dc0_ = 0, dw0_ = 0; if (DIAG_CLOCK) { dc0_ = clock64(); dw0_ = wall_clock64(); }
    if (IN(1)) for (int rep_ = 0; rep_ < 1 + ((DBL_MASK >> 1) & 1); ++rep_) { if (rep_) __syncthreads(); REF(); pg8::Gemm g{(const bf16*)(dob + DO_XN), (const bf16*)(ws + WS_WIN), M, NIN, DM}; pg8::StaticOrder S; S.init(M, NIN, F.G, (int)blockIdx.x);
        pg8::EpiIn E{QKV, HY, GT}; pg8::gemm_phase<pg8::EpiIn, pg8::StaticOrder, true, true>(F.lds, g, S, E, F.tid, DIAG_CLOCK == 2 ? (float*)(ws + WS_CTL) + 3001 : nullptr, DQ(0)); }
    if (IN(1)) { const int nu = (M / 256) * (NIN / 256), rem = nu % F.G; if (rem) tail_transpose_wdown(F, args, ws, rem, F.G - rem); else tail_transpose_wdown(F, args, ws, 0, F.G); }
    if (DIAG_CLOCK == 8 && blockIdx.x == 0 && threadIdx.x == 0) ((unsigned long long*)(ws + WS_CTL + 16384))[40] = wall_clock64();
    if (DIAG_CLOCK == 7 && threadIdx.x == 0) ((unsigned long long*)(ws + WS_CTL + 32768))[blockIdx.x] = wall_clock64();
    if (DIAG_CLOCK && blockIdx.x == 0 && threadIdx.x == 0) { const unsigned long long dc1_ = clock64(), dw1_ = wall_clock64(); ((float*)(ws + WS_CTL))[3000] = (float)(dc1_ - dc0_) / (float)(dw1_ - dw0_) * 0.1f; }
    SEAM(1);
    if (IN(2)) for (int rep_ = 0; rep_ < 1 + ((DBL_MASK >> 2) & 1); ++rep_) { if (rep_) __syncthreads();
        if (((int)blockIdx.x >> 3) & 1) { REF(); h1_phase(F, args, HY, UT); __syncthreads(); REF(); attn_phase(F, args, QKV, ATT); }
        else { REF(); attn_phase(F, args, QKV, ATT); __syncthreads(); REF(); h1_phase(F, args, HY, UT); } } SEAM(2);
    if (IN(3)) { REF(); h2_phase(F, KT, UT); } SEAM(3);
    if (IN(4)) for (int rep_ = 0; rep_ < 1 + ((DBL_MASK >> 4) & 1); ++rep_) { if (rep_) __syncthreads(); REF(); h3_phase(F, args, HY, UT, HYO); } SEAM(4);
    if (IN(5)) for (int rep_ = 0; rep_ < 1 + ((DBL_MASK >> 5) & 1); ++rep_) { if (rep_) __syncthreads(); REF();
        { pg8::Gemm g{ATT, (const bf16*)(ws + WS_WAO), M, DM, AW}; pg8::StaticOrder S; S.init(M, DM, F.G, (int)blockIdx.x);
          pg8::EpiGate<0> E{GT, TM}; pg8::gemm_phase<pg8::EpiGate<0>, pg8::StaticOrder, true, true>(F.lds, g, S, E, F.tid); }
        { pg8::Gemm g{HYO, (const bf16*)(ws + WS_WHO), M, DM, HW}; pg8::StaticOrder S; S.init(M, DM, F.G, (int)blockIdx.x);
          pg8::EpiGate<1> E{GT, TM}; pg8::gemm_phase<pg8::EpiGate<1>, pg8::StaticOrder, true, true>(F.lds, g, S, E, F.tid); }
    } SEAM(5);
    if (IN(6)) for (int rep_ = 0; rep_ < 1 + ((DBL_MASK >> 6) & 1); ++rep_) { if (rep_) __syncthreads(); REF(); pg8::Gemm g{TM, (const bf16*)(ws + WS_WOUT), M, DM, DM}; pg8::StaticOrder S; S.init(M, DM, F.G, (int)blockIdx.x);
        pg8::EpiRes E{args.in[0], args.in[1], MP, XN2, SS1}; pg8::gemm_phase<pg8::EpiRes, pg8::StaticOrder, true, true>(F.lds, g, S, E, F.tid, nullptr, DQ(1)); } SEAM(6);
    if (IN(8)) for (int rep_ = 0; rep_ < 1 + ((DBL_MASK >> 8) & 1); ++rep_) { if (rep_) __syncthreads(); REF(); pg8::Gemm g{XN2, (const bf16*)(ws + WS_WUP), MP, FF, DM}; pg8::StaticOrder S; S.init(MP, FF, F.G, (int)blockIdx.x);
        pg8::EpiStore E{GU, FF, SS1}; pg8::gemm_phase<pg8::EpiStore, pg8::StaticOrder, true, true>(F.lds, g, S, E, F.tid, nullptr, DQ(2));
        { REF(); pg8::Gemm g2{XN2 + (size_t)MP * DM, (const bf16*)(ws + WS_WUP), MS, FF, DM}; pg8::RangeOrder R; R.init(MS, FF, F.G, (int)blockIdx.x); R.L0 = 0; R.L1 = F.G == 256 ? 64 : 0; R.c0 = 192; R.nb = 64;
          pg8::EpiStore E2{GUS, FF, SS1 + MP}; pg8::gemm_phase<pg8::EpiStore, pg8::RangeOrder, true, true>(F.lds, g2, R, E2, F.tid); } } SEAM(8);
    if (IN(9)) for (int rep_ = 0; rep_ < 1 + ((DBL_MASK >> 9) & 1); ++rep_) { if (rep_) __syncthreads(); REF(); pg8::Gemm g{XN2, (const bf16*)(ws + WS_WUP) + (size_t)FF * DM, MP, FF, DM}; pg8::StaticOrder S; S.init(MP, FF, F.G, (int)blockIdx.x);
        pg8::EpiGlu E{GU, ACT, args.in[24], args.in[25], LP, SS1}; pg8::gemm_phase<pg8::EpiGlu, pg8::StaticOrder, true, true>(F.lds, g, S, E, F.tid, nullptr, DQ(3));
        { REF(); pg8::Gemm g2{XN2 + (size_t)MP * DM, (const bf16*)(ws + WS_WUP), MS, FF, DM}; pg8::RangeOrder R; R.init(MS, FF, F.G, (int)blockIdx.x); R.L0 = 64; R.L1 = F.G == 256 ? 128 : 64; R.c0 = 192; R.nb = 64;
          pg8::EpiStore E2{GUS, FF, SS1 + MP}; pg8::gemm_phase<pg8::EpiStore, pg8::RangeOrder, true, true>(F.lds, g2, R, E2, F.tid); } } SEAM(9);
    if (IN(10)) { REF();
        { pg8::Gemm g{ACT, (const bf16*)(ws + WS_WDN), MP, DM, FF}; pg8::StaticOrder S; S.init(MP, DM, F.G, (int)blockIdx.x);
          pg8::EpiResB E{XN2, SS2}; pg8::gemm_phase<pg8::EpiResB, pg8::StaticOrder, true, true>(F.lds, g, S, E, F.tid, nullptr, DQ(4)); }
        if (DIAG_CLOCK == 11 && blockIdx.x == 0 && threadIdx.x == 0) ((unsigned long long*)(ws + WS_CTL + 16384))[41] = wall_clock64();
        { REF(); pg8::Gemm g{XN2 + (size_t)MP * DM, (const bf16*)(ws + WS_WUP), MS, FF, DM}; pg8::RangeOrder S; S.init(MS, FF, F.G, (int)blockIdx.x); S.L0 = F.G == 256 ? 128 : 0; S.L1 = (MS / 256) * (FF / 256); S.c0 = 0; S.nb = F.G;
          pg8::EpiStore E{GUS, FF, SS1 + MP}; pg8::gemm_phase<pg8::EpiStore, pg8::RangeOrder, true, true>(F.lds, g, S, E, F.tid); }
    } SEAM(10);
    if (IN(11)) for (int rep_ = 0; rep_ < 1 + ((DBL_MASK >> 11) & 1); ++rep_) { if (rep_) __syncthreads(); REF(); pg8::Gemm g{XN2 + (size_t)MP * DM, (const bf16*)(ws + WS_WUP) + (size_t)FF * DM, MS, FF, DM}; pg8::StaticOrder S; S.init(MS, FF, F.G, (int)blockIdx.x);
        pg8::EpiGlu E{GUS, ACT, args.in[24], args.in[25], LS, SS1 + MP}; pg8::gemm_phase<pg8::EpiGlu, pg8::StaticOrder, true, true>(F.lds, g, S, E, F.tid, nullptr, DQ(6));
        { REF(); pg8::Gemm g2{(const bf16*)(ws + WS_PB), (const bf16*)(ws + WS_WPL), M, DM, PLE}; pg8::RangeOrder R; R.init(M, DM, F.G, (int)blockIdx.x); R.L0 = 0; R.L1 = F.G == 256 ? 960 : 0; R.c0 = 96; R.nb = 160;
          pg8::EpiPP E2{PP}; pg8::gemm_phase<pg8::EpiPP, pg8::RangeOrder, true, true>(F.lds, g2, R, E2, F.tid); } } SEAM(11);
    if (IN(12)) { REF(); pg8::Gemm g{ACT, (const bf16*)(ws + WS_WDN), MS, DM, FF}; pg8::StaticOrder S; S.init(MS, DM, F.G, (int)blockIdx.x);
        pg8::EpiResB E{XN2 + (size_t)MP * DM, SS2 + MP}; pg8::gemm_phase<pg8::EpiResB, pg8::StaticOrder, true, true>(F.lds, g, S, E, F.tid, nullptr, DQ(7)); } SEAM(12);
    if (IN(14)) { REF();
        { pg8::Gemm g{(const bf16*)(ws + WS_PB), (const bf16*)(ws + WS_WPL), M, DM, PLE}; pg8::RangeOrder S; S.init(M, DM, F.G, (int)blockIdx.x); S.L0 = F.G == 256 ? 960 : 0; S.L1 = (M / 256) * (DM / 256); S.c0 = F.G == 256 ? 192 : 0; S.nb = F.G;
          pg8::EpiPP E{PP}; pg8::gemm_phase<pg8::EpiPP, pg8::RangeOrder, true, true>(F.lds, g, S, E, F.tid); }
        { pg8::Gemm g{XN2, (const bf16*)(ws + WS_WPG), M, DM, DM}; pg8::StaticOrder S; S.init(M, DM, F.G, (int)blockIdx.x);
          pg8::EpiPle E{PP, XN2, X3, SS2, SS3}; pg8::gemm_phase<pg8::EpiPle, pg8::StaticOrder, true, true>(F.lds, g, S, E, F.tid); }
    } SEAM(14);
    float dadd_ = 0.f;
    if (DIAG_CLOCK >= 3) { const unsigned long long* st_ = (const unsigned long long*)(ws + WS_CTL + 16384);
        auto T = [&](int a, int b) { return (float)(st_[b] - st_[a]) * 1e-5f; };
        float rv_ = 0.f;
        if (DIAG_CLOCK == 3) rv_ = 1e-4f * T(0, 1);
        if (DIAG_CLOCK == 4) rv_ = 3e-5f * T(1, 2);
        if (DIAG_CLOCK == 5) rv_ = 1e-4f * T(2, 5);
        if (DIAG_CLOCK == 6) rv_ = 3e-5f * T(5, 7);
        if (DIAG_CLOCK == 7) rv_ = 2e-5f * T(7, 13);
        if (DIAG_CLOCK == 9) rv_ = 1e-4f * T(13, 15);
        dadd_ = sqrtf(rv_); }
    if (IN(15)) { REF(); final_phase(F, X3, SS3, args.in[30], OUT, dadd_); }
#undef IN
#undef SEAM
#undef REF
#undef DQ
}

#ifndef MK_PER_PHASE
#define MK_PER_PHASE 0
#endif
extern "C" void kernel_launch(void* const* d_in, const int* in_sizes, int n_in, void* d_out, int out_size, void* d_ws, size_t ws_size, hipStream_t stream) {
    static int grid = 0;
    if (grid == 0) {
        if (n_in != 31 || out_size != M * DM || ws_size < WS_END) { fprintf(stderr, "kernel_launch: unexpected shapes (n_in %d out %d ws %zu)\n", n_in, out_size, ws_size); grid = -1; return; }
        int dev = 0, cus = 0, per_cu = 0;
        if (hipGetDevice(&dev) != hipSuccess || hipDeviceGetAttribute(&cus, hipDeviceAttributeMultiprocessorCount, dev) != hipSuccess) { grid = -1; return; }
        if (hipFuncSetAttribute((const void*)fwd_kernel, hipFuncAttributeMaxDynamicSharedMemorySize, LDS_BYTES) != hipSuccess) { fprintf(stderr, "kernel_launch: hipFuncSetAttribute failed\n"); grid = -1; return; }
        if (hipOccupancyMaxActiveBlocksPerMultiprocessor(&per_cu, (const void*)fwd_kernel, NTHR, LDS_BYTES) != hipSuccess || per_cu < 1) fprintf(stderr, "kernel_launch: occupancy query reports %d\n", per_cu);
        (void)hipGetLastError();
        grid = cus;
    }
    if (grid < 0) return;
    if (hipMemsetAsync((char*)d_ws + WS_CTL, 0, CTL_ZERO_BYTES, stream) != hipSuccess) return;
    Args a{};
    for (int i = 0; i < 31; ++i) a.in[i] = (const float*)d_in[i];
    a.out = (float*)d_out; a.ws = (unsigned char*)d_ws;
#if MK_PER_PHASE
    for (int p = 0; p < N_PHASES; ++p) { a.ph_lo = p; a.ph_hi = p + 1; hipLaunchKernelGGL(fwd_kernel, dim3(grid), dim3(NTHR), LDS_BYTES, stream, a); }
#else
    a.ph_lo = 0; a.ph_hi = N_PHASES;
    hipLaunchKernelGGL(fwd_kernel, dim3(grid), dim3(NTHR), LDS_BYTES, stream, a);
#endif
}
```

```cpp
#include <hip/hip_runtime.h>
#include <cstdio>
#include <cstdint>
namespace pg8 {
#define PG8_LAS __attribute__((address_space(3)))
typedef unsigned short bf16_t;
typedef short bf16x8 __attribute__((ext_vector_type(8)));
typedef float f32x4 __attribute__((ext_vector_type(4)));
typedef unsigned u32x4 __attribute__((ext_vector_type(4)));
constexpr int BM = 256, BK = 64, HALF = 128, HTB = HALF * BK * 2  , STAGE_BYTES = 8 * HTB, NXCD = 8, WGM = 4;

__host__ __device__ __forceinline__ int lds_byte(int r, int c) { const int st = (r >> 4) * 2 + (c >> 5), rr = r & 15, cc = c & 31, ob = rr * 64 + cc * 2; return st * 1024 + (ob ^ (((ob >> 9) & 1) << 5)); }
__host__ __device__ __forceinline__ void stage_rc(int b, int& R, int& C) { const int st = b / 1024, sb = b % 1024, swz = sb ^ (((sb >> 9) & 1) << 5); R = (st >> 1) * 16 + swz / 64; C = (st & 1) * 32 + (swz % 64) / 2; }
__host__ __device__ __forceinline__ int perm32(int rho) { const int n = rho >> 4, i = rho & 15; return 8 * (i >> 2) + 4 * n + (i & 3); }

struct Unit { int pm, pn; };
struct Gemm { const bf16_t* A; const bf16_t* Bt; int M, N, K; };

struct StaticOrder {
    int nM, nN, nwg, G, c;
    __host__ __device__ void init(int M, int N, int G_, int c_) { nM = M / BM; nN = N / BM; nwg = nM * nN; G = G_; c = c_; }
    __host__ __device__ bool next(int i, Unit& u) const {
        const long L = (long)i * G + c; if (L >= nwg) return false;
        unit_of(L, u); return true;
    }
    __host__ __device__ void unit_of(long L, Unit& u) const {
        int wgid = (int)L; { const int q = nwg / NXCD, r = nwg % NXCD, xcd = wgid % NXCD, off = wgid / NXCD; wgid = (xcd < r ? xcd * (q + 1) : r * (q + 1) + (xcd - r) * q) + off; }
        const int nig = WGM * nN, gid = wgid / nig, fm = gid * WGM, gsz = (nM - fm) < WGM ? (nM - fm) : WGM;
        u.pm = fm + ((wgid % nig) % gsz); u.pn = (wgid % nig) / gsz;
    }
    __device__ __forceinline__ void a_ready(const Unit&) const {}
    __device__ __forceinline__ void done(const Unit&) const {}
};
struct RangeOrder : StaticOrder {
    int L0, L1, c0, nb;
    __host__ __device__ bool next(int i, Unit& u) const { const int k = (c - c0 + G) % G; if (k >= nb) return false; const long L = (long)L0 + k + (long)i * nb; if (L >= L1) return false; unit_of(L, u); return true; }
};
__device__ __forceinline__ unsigned cvt_pk_bf16(float lo, float hi) { unsigned r; asm volatile("v_cvt_pk_bf16_f32 %0, %1, %2" : "=v"(r) : "v"(lo), "v"(hi)); return r; }
typedef float f32x2 __attribute__((ext_vector_type(2)));
__device__ __forceinline__ f32x2 gelu_pk(f32x2 v) {
    typedef unsigned u2_ __attribute__((ext_vector_type(2)));
    const f32x2 na = __builtin_bit_cast(f32x2, __builtin_bit_cast(u2_, v) | 0x80000000u);
    f32x2 p = na * 5.6212998061e-06f + (-5.1055209042e-05f); p = p * na + 3.9686136006e-05f; p = p * na + (-3.4227392171e-03f); p = p * na + 2.2076997906e-02f; p = p * na + (-5.2075162530e-02f); p = p * na + 1.0442737341f;
    p = p * p; p = p * p; p = p * p; p = p * p;
    f32x2 h; h.x = __builtin_amdgcn_rcpf(p.x); h.y = __builtin_amdgcn_rcpf(p.y);
    f32x2 rl; rl.x = fmaxf(v.x, 0.f); rl.y = fmaxf(v.y, 0.f);
    return __builtin_elementwise_fma(na, h, rl);
}
typedef unsigned u32x2 __attribute__((ext_vector_type(2)));
__device__ __forceinline__ unsigned pk2f(float lo, float hi) { typedef float f2_ __attribute__((ext_vector_type(2))); typedef __bf16 b2_ __attribute__((ext_vector_type(2))); return __builtin_bit_cast(unsigned, __builtin_convertvector((f2_){lo, hi}, b2_)); }
__device__ __forceinline__ float bflo(unsigned u) { return __uint_as_float(u << 16); }
__device__ __forceinline__ float bfhi(unsigned u) { return __uint_as_float(u & 0xffff0000u); }
__device__ __forceinline__ float sg2(float y) { return __builtin_amdgcn_rcpf(1.0f + __builtin_amdgcn_exp2f(y)); }
__device__ __forceinline__ float sigm(float x) { return __builtin_amdgcn_rcpf(1.0f + __builtin_amdgcn_exp2f(-1.44269504089f * x)); }
__device__ __forceinline__ u32x4 pack8(const f32x4 v0, const f32x4 v1) { u32x4 w; w.x = pk2f(v0[0], v0[1]); w.y = pk2f(v0[2], v0[3]); w.z = pk2f(v1[0], v1[1]); w.w = pk2f(v1[2], v1[3]); return w; }

struct EpiIn {
    static constexpr bool PERM = true, AFTER_DRAIN = false;
    bf16_t *QKV, *HY, *GT;
    __device__ __forceinline__ void operator()(const f32x4 (&acc)[2][2][4][2], const Unit& u, int wr, int wc, int fr, int fq) const {
        const int row0 = u.pm * BM + wr * 64 + fr; bf16_t* base; int ldc, colt; bool sg = false;
        if (u.pn < 12) { base = QKV; ldc = 3072; colt = u.pn * 256; }
        else if (u.pn < 36) { base = HY; ldc = 6144; colt = (u.pn - 12) * 256; }
        else { base = GT; ldc = 8192; colt = (u.pn - 36) * 256; sg = true; }
        const int col0 = colt + wc * 32 + 8 * fq;
#pragma unroll
        for (int ai = 0; ai < 2; ++ai)
#pragma unroll
            for (int m = 0; m < 4; ++m) { bf16_t* rowp = base + (size_t)(row0 + ai * HALF + m * 16) * ldc + col0;
#pragma unroll
                for (int bj = 0; bj < 2; ++bj) { f32x4 v0 = acc[ai][bj][m][0], v1 = acc[ai][bj][m][1];
                    if (sg) {
#pragma unroll
                        for (int j = 0; j < 4; ++j) { v0[j] = __builtin_amdgcn_rcpf(1.0f + __builtin_amdgcn_exp2f(v0[j])); v1[j] = __builtin_amdgcn_rcpf(1.0f + __builtin_amdgcn_exp2f(v1[j])); } }

                    if (sg) __builtin_nontemporal_store(pack8(v0, v1), (u32x4*)(rowp + bj * HALF));
                    else *(u32x4*)(rowp + bj * HALF) = pack8(v0, v1); } }
    }
};
__device__ __forceinline__ float row_rstd(const float* ss, int r) { return __builtin_amdgcn_rsqf(ss[r] * (1.0f / 4096.0f) + 1e-6f); }
struct EpiStore {
    static constexpr bool PERM = true, AFTER_DRAIN = false;
    bf16_t* O; int ldc; const float* ss;
    __device__ __forceinline__ void operator()(const f32x4 (&acc)[2][2][4][2], const Unit& u, int wr, int wc, int fr, int fq) const {
        const int row0 = u.pm * BM + wr * 64 + fr, col0 = u.pn * BM + wc * 32 + 8 * fq;
#pragma unroll
        for (int ai = 0; ai < 2; ++ai)
#pragma unroll
            for (int m = 0; m < 4; ++m) { const int r = row0 + ai * HALF + m * 16; const float rr = row_rstd(ss, r); bf16_t* rowp = O + (size_t)r * ldc + col0;
#pragma unroll
                for (int bj = 0; bj < 2; ++bj) *(u32x4*)(rowp + bj * HALF) = pack8(acc[ai][bj][m][0] * rr, acc[ai][bj][m][1] * rr); }
    }
};
template <int MODE> struct EpiGate {
    static constexpr bool PERM = true, AFTER_DRAIN = false;
    const bf16_t* GT; bf16_t* TM;
    __device__ __forceinline__ void operator()(const f32x4 (&acc)[2][2][4][2], const Unit& u, int wr, int wc, int fr, int fq) const {
        const int row0 = u.pm * BM + wr * 64 + fr, col0 = u.pn * BM + wc * 32 + 8 * fq;
        u32x4 gq[2][4][2], tq[4][2];
        auto ldrow = [&](int ai, int m) __attribute__((always_inline)) { const size_t r = (size_t)(row0 + ai * HALF + m * 16); const bf16_t* gp = GT + r * 8192 + MODE * 4096 + col0; const bf16_t* tp = TM + r * 4096 + col0;
#pragma unroll
            for (int bj = 0; bj < 2; ++bj) { gq[ai][m][bj] = *(const u32x4*)(gp + bj * HALF); if (MODE == 1) tq[m][bj] = *(const u32x4*)(tp + bj * HALF); } };
#pragma unroll
        for (int ai = 0; ai < (MODE == 0 ? 2 : 1); ++ai)
#pragma unroll
            for (int m = 0; m < 4; ++m) ldrow(ai, m);
#pragma unroll
        for (int ai = 0; ai < 2; ++ai) {
#pragma unroll
            for (int m = 0; m < 4; ++m) { const size_t r = (size_t)(row0 + ai * HALF + m * 16); bf16_t* tp = TM + r * 4096 + col0;
                u32x4 gv[2], tv[2];
#pragma unroll
                for (int bj = 0; bj < 2; ++bj) { gv[bj] = gq[ai][m][bj]; if (MODE == 1) tv[bj] = tq[m][bj]; }
                if (MODE == 1 && ai == 0) ldrow(1, m);
#pragma unroll
                for (int bj = 0; bj < 2; ++bj) { const u32x4 g = gv[bj]; f32x4 v0 = acc[ai][bj][m][0], v1 = acc[ai][bj][m][1];
                    v0[0] *= bflo(g.x); v0[1] *= bfhi(g.x); v0[2] *= bflo(g.y); v0[3] *= bfhi(g.y); v1[0] *= bflo(g.z); v1[1] *= bfhi(g.z); v1[2] *= bflo(g.w); v1[3] *= bfhi(g.w);
                    if (MODE == 1) { const u32x4 t = tv[bj];
                        v0[0] += bflo(t.x); v0[1] += bfhi(t.x); v0[2] += bflo(t.y); v0[3] += bfhi(t.y); v1[0] += bflo(t.z); v1[1] += bfhi(t.z); v1[2] += bflo(t.w); v1[3] += bfhi(t.w); }
                    *(u32x4*)(tp + bj * HALF) = pack8(v0, v1); }
                if (MODE == 1) asm volatile("" ::: "memory"); }
            asm volatile("" ::: "memory"); }
    }
};
struct EpiRes {
    static constexpr bool PERM = false, AFTER_DRAIN = false;
    const float* b0; const float* b1; int split; bf16_t* XB; float* ss;
    __device__ __forceinline__ void operator()(const f32x4 (&acc)[2][2][4][2], const Unit& u, int wr, int wc, int fr, int fq) const {
        const int row0 = u.pm * BM + wr * 64 + fr, col0 = u.pn * BM + wc * 32 + 4 * fq, lane = fq * 16 + fr;
#pragma unroll
        for (int ai = 0; ai < 2; ++ai) {
        f32x4 bv[2][4][2][2];
#pragma unroll
            for (int m = 0; m < 4; ++m) { const int r = row0 + ai * HALF + m * 16; const float* bp = (r < split ? b0 + (size_t)r * 4096 : b1 + (size_t)(r - split) * 4096) + col0;
#pragma unroll
                for (int bj = 0; bj < 2; ++bj)
#pragma unroll
                    for (int n = 0; n < 2; ++n) bv[ai][m][bj][n] = *(const f32x4*)(bp + bj * HALF + n * 16); }
#pragma unroll
            for (int m = 0; m < 4; ++m) { const int r = row0 + ai * HALF + m * 16; bf16_t* xp = XB + (size_t)r * 4096 + col0;
                float s = 0.f;
#pragma unroll
                for (int bj = 0; bj < 2; ++bj)
#pragma unroll
                    for (int n = 0; n < 2; ++n) { const f32x4 v = bv[ai][m][bj][n] + acc[ai][bj][m][n];
                        s += (v[0] * v[0] + v[1] * v[1]) + (v[2] * v[2] + v[3] * v[3]);
                        u32x2 w; w.x = pk2f(v[0], v[1]); w.y = pk2f(v[2], v[3]); *(u32x2*)(xp + bj * HALF + n * 16) = w; }
                s += __int_as_float(__builtin_amdgcn_ds_bpermute((lane ^ 16) << 2, __float_as_int(s)));
                s += __int_as_float(__builtin_amdgcn_ds_bpermute((lane ^ 32) << 2, __float_as_int(s)));
                if (fq == 0) (void)__hip_atomic_fetch_add(ss + r, s, __ATOMIC_RELAXED, __HIP_MEMORY_SCOPE_AGENT);
                }
            asm volatile("" ::: "memory"); }
    }
};
struct EpiResB {
    static constexpr bool PERM = false, AFTER_DRAIN = false;
    bf16_t* XB; float* ss;
    __device__ __forceinline__ void operator()(const f32x4 (&acc)[2][2][4][2], const Unit& u, int wr, int wc, int fr, int fq) const {
        const int row0 = u.pm * BM + wr * 64 + fr, col0 = u.pn * BM + wc * 32 + 4 * fq, lane = fq * 16 + fr;
        u32x2 bv[2][4][2][2];
#pragma unroll
        for (int ai = 0; ai < 2; ++ai)
#pragma unroll
            for (int m = 0; m < 4; ++m) { const bf16_t* bp = XB + (size_t)(row0 + ai * HALF + m * 16) * 4096 + col0;
#pragma unroll
                for (int bj = 0; bj < 2; ++bj)
#pragma unroll
                    for (int n = 0; n < 2; ++n) bv[ai][m][bj][n] = *(const u32x2*)(bp + bj * HALF + n * 16); }
#pragma unroll
        for (int ai = 0; ai < 2; ++ai)
#pragma unroll
            for (int m = 0; m < 4; ++m) { const int r = row0 + ai * HALF + m * 16; bf16_t* xp = XB + (size_t)r * 4096 + col0;
                float s = 0.f;
#pragma unroll
                for (int bj = 0; bj < 2; ++bj)
#pragma unroll
                    for (int n = 0; n < 2; ++n) { const u32x2 b = bv[ai][m][bj][n]; f32x4 v = acc[ai][bj][m][n];
                        v[0] += bflo(b.x); v[1] += bfhi(b.x); v[2] += bflo(b.y); v[3] += bfhi(b.y);
                        s += (v[0] * v[0] + v[1] * v[1]) + (v[2] * v[2] + v[3] * v[3]);
                        u32x2 w; w.x = pk2f(v[0], v[1]); w.y = pk2f(v[2], v[3]); *(u32x2*)(xp + bj * HALF + n * 16) = w; }
                s += __int_as_float(__builtin_amdgcn_ds_bpermute((lane ^ 16) << 2, __float_as_int(s)));
                s += __int_as_float(__builtin_amdgcn_ds_bpermute((lane ^ 32) << 2, __float_as_int(s)));
                if (fq == 0) (void)__hip_atomic_fetch_add(ss + r, s, __ATOMIC_RELAXED, __HIP_MEMORY_SCOPE_AGENT); }
    }
};
struct EpiGlu {
    static constexpr bool PERM = true, AFTER_DRAIN = false;
    const bf16_t* GU; bf16_t* ACT; const float* cw; const float* cb; int L; const float* ss;
    __device__ __forceinline__ void operator()(const f32x4 (&acc)[2][2][4][2], const Unit& u, int wr, int wc, int fr, int fq) const {
        const int row0 = u.pm * BM + wr * 64 + fr;
        float rr[2][4];
#pragma unroll
        for (int ai = 0; ai < 2; ++ai)
#pragma unroll
            for (int m = 0; m < 4; ++m) rr[ai][m] = row_rstd(ss, row0 + ai * HALF + m * 16);
        const u32x4 z4 = {0u, 0u, 0u, 0u};
        auto gaddr = [&](int b) __attribute__((always_inline)) -> const bf16_t* { const int bj = b >> 1, ai = b & 1; return GU + (size_t)(row0 + ai * HALF) * 11008 + (u.pn * BM + bj * HALF + wc * 32 + 8 * fq); };
        auto ld_hu = [&](int b) __attribute__((always_inline)) -> u32x4 { const int rA = row0 + (b & 1) * HALF; u32x4 h = z4; if (fr == 0 && (rA & (L - 1)) > 0) h = *(const u32x4*)(gaddr(b) - 11008); return h; };
        auto ld_hd = [&](int b) __attribute__((always_inline)) -> u32x4 { const int rA = row0 + (b & 1) * HALF; u32x4 h = z4; if (fr == 15 && ((rA + 48) & (L - 1)) < L - 1) h = *(const u32x4*)(gaddr(b) + (size_t)49 * 11008); return h; };
        u32x4 gq[4], hu, hd;
#pragma unroll
        for (int m = 0; m < 4; ++m) gq[m] = *(const u32x4*)(gaddr(0) + (size_t)(m * 16) * 11008);
        hu = ld_hu(0); hd = ld_hd(0);
        f32x4 w0[2], w1[2], w2[2], bb[2];
#pragma unroll
        for (int b = 0; b < 4; ++b) { const int bj = b >> 1, ai = b & 1, c0 = u.pn * BM + bj * HALF + wc * 32 + 8 * fq, rA = row0 + ai * HALF;
            if (ai == 0) {
#pragma unroll
                for (int n = 0; n < 2; ++n) { w0[n] = *(const f32x4*)(cw + c0 + 4 * n); w1[n] = *(const f32x4*)(cw + 11008 + c0 + 4 * n); w2[n] = *(const f32x4*)(cw + 22016 + c0 + 4 * n); bb[n] = *(const f32x4*)(cb + c0 + 4 * n); } }
#pragma unroll
            for (int m = 0; m < 4; ++m) { const int r = rA + m * 16;
                const u32x4 gc = gq[m]; u32x4 gm, gn;
#pragma unroll
                for (int q = 0; q < 4; ++q) {
                    const int au = m > 0 ? __builtin_amdgcn_update_dpp(0, (int)gq[m > 0 ? m - 1 : 0][q], 0x121, 0xf, 0xf, false) : (int)hu[q];
                    const int ad = m < 3 ? __builtin_amdgcn_update_dpp(0, (int)gq[m < 3 ? m + 1 : 3][q], 0x12f, 0xf, 0xf, false) : (int)hd[q];
                    gm[q] = (unsigned)__builtin_amdgcn_update_dpp(au, (int)gc[q], 0x111, 0xf, 0xf, false);
                    gn[q] = (unsigned)__builtin_amdgcn_update_dpp(ad, (int)gc[q], 0x101, 0xf, 0xf, false); }
                if (b < 3) {
                    if (m == 0) hu = ld_hu(b + 1);
                    if (m == 2) { gq[0] = *(const u32x4*)gaddr(b + 1); gq[1] = *(const u32x4*)(gaddr(b + 1) + (size_t)16 * 11008); }
                    if (m == 3) { gq[2] = *(const u32x4*)(gaddr(b + 1) + (size_t)32 * 11008); gq[3] = *(const u32x4*)(gaddr(b + 1) + (size_t)48 * 11008); hd = ld_hd(b + 1); } }
                f32x4 xm[2], xc[2], xn[2];
                xm[0] = (f32x4){bflo(gm.x), bfhi(gm.x), bflo(gm.y), bfhi(gm.y)}; xm[1] = (f32x4){bflo(gm.z), bfhi(gm.z), bflo(gm.w), bfhi(gm.w)};
                xc[0] = (f32x4){bflo(gc.x), bfhi(gc.x), bflo(gc.y), bfhi(gc.y)}; xc[1] = (f32x4){bflo(gc.z), bfhi(gc.z), bflo(gc.w), bfhi(gc.w)};
                xn[0] = (f32x4){bflo(gn.x), bfhi(gn.x), bflo(gn.y), bfhi(gn.y)}; xn[1] = (f32x4){bflo(gn.z), bfhi(gn.z), bflo(gn.w), bfhi(gn.w)};
                f32x4 o[2];
#pragma unroll
                for (int n = 0; n < 2; ++n) { const f32x4 pre = w0[n] * xm[n] + w1[n] * xc[n] + w2[n] * xn[n] + bb[n];
                    const f32x2 ga = gelu_pk((f32x2){pre[0], pre[1]}), gb = gelu_pk((f32x2){pre[2], pre[3]});
                    o[n] = (f32x4){ga.x, ga.y, gb.x, gb.y} * (acc[ai][bj][m][n] * rr[ai][m]); }
                *(u32x4*)(ACT + (size_t)r * 11008 + c0) = pack8(o[0], o[1]);
                asm volatile("" ::: "memory"); } }
    }
};
struct EpiPP {
    static constexpr bool PERM = false, AFTER_DRAIN = false;
    bf16_t* PP;
    __device__ __forceinline__ void operator()(const f32x4 (&acc)[2][2][4][2], const Unit& u, int wr, int wc, int fr, int fq) const {
        const int row0 = u.pm * BM + wr * 64 + fr, col0 = u.pn * BM + wc * 32 + 4 * fq;
#pragma unroll
        for (int ai = 0; ai < 2; ++ai)
#pragma unroll
            for (int m = 0; m < 4; ++m) { bf16_t* pp = PP + (size_t)(row0 + ai * HALF + m * 16) * 4096 + col0;
#pragma unroll
                for (int bj = 0; bj < 2; ++bj)
#pragma unroll
                    for (int n = 0; n < 2; ++n) { const f32x4 v = acc[ai][bj][m][n]; u32x2 w; w.x = pk2f(v[0], v[1]); w.y = pk2f(v[2], v[3]); *(u32x2*)(pp + bj * HALF + n * 16) = w; } }
    }
};
struct EpiPle {
    static constexpr bool PERM = false, AFTER_DRAIN = false;
    const bf16_t* PP; const bf16_t* XB; bf16_t* X3; const float* ss; float* ss3;
    __device__ __forceinline__ void operator()(const f32x4 (&acc)[2][2][4][2], const Unit& u, int wr, int wc, int fr, int fq) const {
        const int row0 = u.pm * BM + wr * 64 + fr, col0 = u.pn * BM + wc * 32 + 4 * fq, lane = fq * 16 + fr;
#pragma unroll
        for (int ai = 0; ai < 2; ++ai) {
            u32x2 pq[4][2][2], xq[4][2][2]; float rq[4];
#pragma unroll
            for (int m = 0; m < 4; ++m) { const size_t ro = (size_t)(row0 + ai * HALF + m * 16) * 4096 + col0; rq[m] = row_rstd(ss, row0 + ai * HALF + m * 16) * -1.44269504089f;
#pragma unroll
                for (int bj = 0; bj < 2; ++bj)
#pragma unroll
                    for (int n = 0; n < 2; ++n) { pq[m][bj][n] = *(const u32x2*)(PP + ro + bj * HALF + n * 16); xq[m][bj][n] = *(const u32x2*)(XB + ro + bj * HALF + n * 16); } }
#pragma unroll
            for (int m = 0; m < 4; ++m) { const int r = row0 + ai * HALF + m * 16; const size_t ro = (size_t)r * 4096 + col0; float s = 0.f;
#pragma unroll
                for (int bj = 0; bj < 2; ++bj)
#pragma unroll
                    for (int n = 0; n < 2; ++n) { const f32x4 v = acc[ai][bj][m][n] * rq[m]; const u32x2 p = pq[m][bj][n], xb = xq[m][bj][n]; f32x4 x;
                        x[0] = bflo(xb.x) + sg2(v[0]) * bflo(p.x); x[1] = bfhi(xb.x) + sg2(v[1]) * bfhi(p.x); x[2] = bflo(xb.y) + sg2(v[2]) * bflo(p.y); x[3] = bfhi(xb.y) + sg2(v[3]) * bfhi(p.y);
                        s += (x[0] * x[0] + x[1] * x[1]) + (x[2] * x[2] + x[3] * x[3]);
                        u32x2 w; w.x = pk2f(x[0], x[1]); w.y = pk2f(x[2], x[3]); *(u32x2*)(X3 + ro + bj * HALF + n * 16) = w; }
                s += __int_as_float(__builtin_amdgcn_ds_bpermute((lane ^ 16) << 2, __float_as_int(s)));
                s += __int_as_float(__builtin_amdgcn_ds_bpermute((lane ^ 32) << 2, __float_as_int(s)));
                if (fq == 0) (void)__hip_atomic_fetch_add(ss3 + r, s, __ATOMIC_RELAXED, __HIP_MEMORY_SCOPE_AGENT); }
            asm volatile("" ::: "memory"); }
    }
};
template <class Epi, class Sched, bool ALIGN_EPI = false, bool SP2 = false>
__device__ __forceinline__ void gemm_phase(PG8_LAS unsigned char* lds, const Gemm g, const Sched& S, const Epi& E, int tid_in, float* probe = nullptr, unsigned* dynq = nullptr, volatile PG8_LAS unsigned* dslot = nullptr) {
    int tid_ = tid_in; asm volatile("" : "+v"(tid_));
    const int tid = tid_, wid = __builtin_amdgcn_readfirstlane(tid >> 6), lane = tid & 63, wr = wid >> 2, wc = wid & 3, fr = lane & 15, fq = lane >> 4;
    const int K = g.K, nt = K / BK;
    unsigned voffA[2], voffB[2];
#pragma unroll
    for (int i = 0; i < 2; ++i) { int R, C; stage_rc(tid * 16 + i * 8192, R, C); const int Rb = Epi::PERM ? ((R & ~31) + perm32(R & 31)) : R;
        voffA[i] = (unsigned)(R * K + C) * 2u; voffB[i] = (unsigned)(Rb * K + C) * 2u; }
    const size_t kstep = (size_t)(BK * 2);
    const size_t hstep = (size_t)HALF * K * 2;
    const size_t tstep = 2 * hstep;
    const unsigned ldsw = (unsigned)wid * 1024u;
    const int aoff = lds_byte(wr * 64 + fr, fq * 8), boff = lds_byte(wc * 32 + fr, fq * 8);
#define PG8_SA(b, h) (((b) * 2 + (h)) * HTB)
#define PG8_SB(b, h) ((4 + (b) * 2 + (h)) * HTB)
#define PG8_STAGE(bufoff, gbase, voff) do { _Pragma("unroll") for (int _i = 0; _i < 2; ++_i) \
        __builtin_amdgcn_global_load_lds((const unsigned*)((const char*)(gbase) + (voff)[_i]), (PG8_LAS unsigned*)(lds + (bufoff) + ldsw + _i * 8192), 16, 0, 0); } while (0)
#define PG8_LDA(dst, b, h) do { _Pragma("unroll") for (int m = 0; m < 4; ++m) _Pragma("unroll") for (int k = 0; k < 2; ++k) dst[m][k] = *(const PG8_LAS bf16x8*)(lds + PG8_SA(b, h) + aoff + m * 2048 + k * 1024); } while (0)
#define PG8_LDB(dst, b, h) do { _Pragma("unroll") for (int n = 0; n < 2; ++n) _Pragma("unroll") for (int k = 0; k < 2; ++k) dst[n][k] = *(const PG8_LAS bf16x8*)(lds + PG8_SB(b, h) + boff + n * 2048 + k * 1024); } while (0)
#define PG8_MMA(ai, bj, At, Bt) do { __builtin_amdgcn_s_setprio(1); _Pragma("unroll") for (int m = 0; m < 4; ++m) _Pragma("unroll") for (int n = 0; n < 2; ++n) _Pragma("unroll") for (int k = 0; k < 2; ++k) \
        acc[ai][bj][m][n] = __builtin_amdgcn_mfma_f32_16x16x32_bf16(Bt[n][k], At[m][k], acc[ai][bj][m][n], 0, 0, 0); __builtin_amdgcn_s_setprio(0); } while (0)
#define PG8_WAIT_V(n) asm volatile("s_waitcnt vmcnt(" #n ")" ::: "memory")
#define PG8_WAIT_L(n) asm volatile("s_waitcnt lgkmcnt(" #n ")" ::: "memory")
#define PG8_BAR __builtin_amdgcn_s_barrier()
#define PG8_SCHED __builtin_amdgcn_sched_barrier(0)
    Unit cur, nxt; int ui = 0;
    if (!S.next(0, cur)) return;
    f32x4 acc[2][2][4][2];
#pragma unroll
    for (int a = 0; a < 2; ++a)
#pragma unroll
        for (int b = 0; b < 2; ++b)
#pragma unroll
            for (int m = 0; m < 4; ++m)
#pragma unroll
                for (int n = 0; n < 2; ++n) acc[a][b][m][n] = (f32x4){0.f, 0.f, 0.f, 0.f};
    bf16x8 At[4][2], B0[2][2], B1[2][2];
    const char* cA = (const char*)g.A + (size_t)cur.pm * tstep; const char* cB = (const char*)g.Bt + (size_t)cur.pn * tstep;
    S.a_ready(cur);
    if constexpr (SP2) {
        PG8_STAGE(PG8_SB(0, 0), cB, voffB); PG8_STAGE(PG8_SB(0, 1), cB + hstep, voffB); PG8_STAGE(PG8_SA(0, 0), cA, voffA); PG8_STAGE(PG8_SA(0, 1), cA + hstep, voffA);
        if (wr == 1) PG8_BAR;
        PG8_WAIT_V(2); PG8_BAR;
        PG8_STAGE(PG8_SB(1, 0), cB + kstep, voffB); PG8_STAGE(PG8_SA(1, 0), cA + kstep, voffA); PG8_STAGE(PG8_SB(1, 1), cB + hstep + kstep, voffB);
        PG8_WAIT_V(6); PG8_BAR;
    } else {
        PG8_STAGE(PG8_SB(0, 0), cB, voffB); PG8_STAGE(PG8_SA(0, 0), cA, voffA); PG8_STAGE(PG8_SB(0, 1), cB + hstep, voffB); PG8_STAGE(PG8_SA(0, 1), cA + hstep, voffA);
        if (wr == 1) PG8_BAR;
        PG8_WAIT_V(4); PG8_BAR;
        PG8_STAGE(PG8_SB(1, 0), cB + kstep, voffB); PG8_STAGE(PG8_SA(1, 0), cA + kstep, voffA); PG8_STAGE(PG8_SB(1, 1), cB + hstep + kstep, voffB);
        PG8_WAIT_V(6); PG8_BAR;
    }
    unsigned dyn_ret = 0; int dq = S.c & 7;
    unsigned long long pr_prev = 0, pr_sumk = 0, pr_sume = 0; if (probe) pr_prev = wall_clock64();
    for (;;) {
        bool has_next = false;
        if (dynq) {
            if (wid == 0) {
                if (ui >= 1) {
                    unsigned v = (unsigned)__builtin_amdgcn_readfirstlane((int)dyn_ret) + (unsigned)(2 * S.G / 8);
                    for (int tries = 0; v >= (unsigned)((S.nwg - dq + 7) >> 3) && tries < 7; ++tries) {
                        dq = (dq + 1) & 7; unsigned r_ = 0;
                        if (lane == 0) r_ = __hip_atomic_fetch_add(dynq + 64 * dq, 1u, __ATOMIC_RELAXED, __HIP_MEMORY_SCOPE_AGENT);
                        v = (unsigned)__builtin_amdgcn_readfirstlane((int)r_) + (unsigned)(2 * S.G / 8); }
                    const unsigned code = (v < (unsigned)((S.nwg - dq + 7) >> 3)) ? (8u * v + (unsigned)dq) : 0xffffffffu;
                    if (lane == 0) dslot[(ui + 1) & 1] = code;
                }
                dyn_ret = 0u;
                if (lane == 0) dyn_ret = __hip_atomic_fetch_add(dynq + 64 * dq, 1u, __ATOMIC_RELAXED, __HIP_MEMORY_SCOPE_AGENT);
            }
        } else has_next = S.next(ui + 1, nxt);
        const char* nA_ = has_next ? (const char*)g.A + (size_t)nxt.pm * tstep : cA; const char* nB_ = has_next ? (const char*)g.Bt + (size_t)nxt.pn * tstep : cB;
        const char* nA = nA_; const char* nB = nB_;
        for (int t = 0; t < nt; t += 2) {
            const bool last = (t == nt - 2);
            if (dynq && last) {
                long L1;
                if (ui == 0) { L1 = (long)S.G + S.c; has_next = L1 < S.nwg; }
                else { const unsigned code = (unsigned)__builtin_amdgcn_readfirstlane((int)dslot[(ui + 1) & 1]); has_next = code != 0xffffffffu; L1 = (long)code; }
                if (has_next) { S.unit_of(L1, nxt); nA = (const char*)g.A + (size_t)nxt.pm * tstep; nB = (const char*)g.Bt + (size_t)nxt.pn * tstep; } else { nA = cA; nB = cB; }
            }
            const char* a1 = cA + (size_t)(t + 1) * kstep;
            const char* a2 = last ? nA : cA + (size_t)(t + 2) * kstep; const char* b2 = last ? nB : cB + (size_t)(t + 2) * kstep;
            const char* a3 = a2 + kstep; const char* b3 = b2 + kstep;
            if (last && has_next) S.a_ready(nxt);
            if constexpr (SP2) {
            PG8_LDB(B0, 0, 0); PG8_LDB(B1, 0, 1); PG8_SCHED; PG8_LDA(At, 0, 0); PG8_STAGE(PG8_SA(1, 1), a1 + hstep, voffA);
            PG8_WAIT_V(8); PG8_WAIT_L(0); PG8_BAR; PG8_MMA(0, 0, At, B0); PG8_MMA(0, 1, At, B1); PG8_BAR; PG8_SCHED;
            PG8_LDA(At, 0, 1); PG8_STAGE(PG8_SB(0, 0), b2, voffB); PG8_STAGE(PG8_SB(0, 1), b2 + hstep, voffB); PG8_STAGE(PG8_SA(0, 0), a2, voffA);
            PG8_WAIT_V(8); PG8_WAIT_L(0); PG8_BAR; PG8_MMA(1, 0, At, B0); PG8_MMA(1, 1, At, B1); PG8_BAR; PG8_SCHED;
            PG8_LDB(B0, 1, 0); PG8_LDB(B1, 1, 1); PG8_SCHED; PG8_LDA(At, 1, 0); PG8_STAGE(PG8_SA(0, 1), a2 + hstep, voffA);
            PG8_WAIT_V(8); PG8_WAIT_L(0); PG8_BAR; PG8_MMA(0, 0, At, B0); PG8_MMA(0, 1, At, B1); PG8_BAR; PG8_SCHED;
            PG8_LDA(At, 1, 1); PG8_STAGE(PG8_SB(1, 0), b3, voffB); PG8_STAGE(PG8_SB(1, 1), b3 + hstep, voffB); PG8_STAGE(PG8_SA(1, 0), a3, voffA);
            PG8_WAIT_V(8); PG8_WAIT_L(0); PG8_BAR; PG8_MMA(1, 0, At, B0); PG8_MMA(1, 1, At, B1); PG8_BAR; PG8_SCHED;
            } else {
            PG8_LDB(B0, 0, 0); PG8_SCHED; PG8_LDA(At, 0, 0); PG8_STAGE(PG8_SA(1, 1), a1 + hstep, voffA);
            PG8_WAIT_L(8); PG8_BAR; PG8_WAIT_L(0); PG8_MMA(0, 0, At, B0); PG8_BAR; PG8_SCHED;
            PG8_LDB(B1, 0, 1); PG8_STAGE(PG8_SB(0, 0), b2, voffB);
            PG8_BAR; PG8_WAIT_L(0); PG8_MMA(0, 1, At, B1); PG8_BAR;
            PG8_LDA(At, 0, 1); PG8_STAGE(PG8_SA(0, 0), a2, voffA);
            PG8_BAR; PG8_WAIT_L(0); PG8_MMA(1, 0, At, B0); PG8_BAR; PG8_SCHED;
            PG8_STAGE(PG8_SB(0, 1), b2 + hstep, voffB);
            PG8_WAIT_V(6); PG8_BAR; PG8_MMA(1, 1, At, B1); PG8_BAR;
            PG8_LDB(B0, 1, 0); PG8_SCHED; PG8_LDA(At, 1, 0); PG8_STAGE(PG8_SA(0, 1), a2 + hstep, voffA);
            PG8_WAIT_L(8); PG8_BAR; PG8_WAIT_L(0); PG8_MMA(0, 0, At, B0); PG8_BAR; PG8_SCHED;
            PG8_LDB(B1, 1, 1); PG8_STAGE(PG8_SB(1, 0), b3, voffB);
            PG8_BAR; PG8_WAIT_L(0); PG8_MMA(0, 1, At, B1); PG8_BAR;
            PG8_LDA(At, 1, 1); PG8_STAGE(PG8_SA(1, 0), a3, voffA);
            PG8_BAR; PG8_WAIT_L(0); PG8_MMA(1, 0, At, B0); PG8_BAR; PG8_SCHED;
            PG8_STAGE(PG8_SB(1, 1), b3 + hstep, voffB);
            PG8_WAIT_V(6); PG8_BAR; PG8_MMA(1, 1, At, B1); PG8_BAR;
            }
        }
        unsigned long long pr_tk = 0; if (probe) { pr_tk = wall_clock64(); pr_sumk += pr_tk - pr_prev; }
        if constexpr (ALIGN_EPI) { if (wr == 0) PG8_BAR; }
        if constexpr (!Epi::AFTER_DRAIN) { int le_ = lane; asm volatile("" : "+v"(le_));
            E(acc, cur, wr, wc, le_ & 15, le_ >> 4); S.done(cur); }
        if (probe) { const unsigned long long pr_te = wall_clock64(); pr_sume += pr_te - pr_tk; pr_prev = pr_te; }
        if (!has_next) break;
#pragma unroll
        for (int a = 0; a < 2; ++a)
#pragma unroll
            for (int b = 0; b < 2; ++b)
#pragma unroll
                for (int m = 0; m < 4; ++m)
#pragma unroll
                    for (int n = 0; n < 2; ++n) acc[a][b][m][n] = (f32x4){0.f, 0.f, 0.f, 0.f};
        cur = nxt; cA = nA; cB = nB; ++ui;
        if constexpr (ALIGN_EPI) { if (wr == 1) PG8_BAR; }
    }
    if (probe && blockIdx.x == 0 && tid == 0) { probe[0] = (float)pr_sumk * 0.01f / (float)(ui + 1); probe[1] = (float)pr_sume * 0.01f / (float)(ui + 1); }
    PG8_WAIT_V(0);
    if constexpr (!ALIGN_EPI) { if (wr == 0) PG8_BAR; }
    PG8_BAR;
    if constexpr (Epi::AFTER_DRAIN) { E.fused(acc, cur, wr, wc, fr, fq, lds, wid, lane); S.done(cur); }
#undef PG8_SA
#undef PG8_SB
#undef PG8_STAGE
#undef PG8_LDA
#undef PG8_LDB
#undef PG8_MMA
#undef PG8_WAIT_V
#undef PG8_WAIT_L
#undef PG8_BAR
#undef PG8_SCHED
}
}

constexpr int NWAVES = 8, NTHR = 512;
constexpr int DM = 4096, MP = 16384, MS = 8192, M = MP + MS;
constexpr int LP = 4096, LS = 2048;
constexpr int NIN = 17408, AW = 2048, HW = 2048, FF = 11008, PLE = 256;
constexpr float EPS = 1e-6f;

constexpr size_t WS_CTL = 0, CTL_ZERO_BYTES = 1u << 20;
constexpr size_t SZ_PB = (size_t)M * PLE * 2;
constexpr size_t SZ_WUP = (size_t)2 * FF * DM * 2, SZ_WDN = (size_t)DM * FF * 2, SZ_WPG = (size_t)DM * DM * 2, SZ_WPL = (size_t)DM * PLE * 2;
constexpr size_t SZ_WIN = (size_t)NIN * DM * 2, SZ_WAO = (size_t)DM * AW * 2, SZ_WHO = (size_t)DM * HW * 2, SZ_WOUT = (size_t)DM * DM * 2;
constexpr size_t SZ_QKV = (size_t)M * 3072 * 2, SZ_HY = (size_t)M * 6144 * 2, SZ_GT = (size_t)M * 8192 * 2, SZ_XN = (size_t)M * DM * 2;
constexpr size_t WS_PB = CTL_ZERO_BYTES;
constexpr size_t WS_WUP = WS_PB + SZ_PB, WS_WDN = WS_WUP + SZ_WUP, WS_WPG = WS_WDN + SZ_WDN, WS_WPL = WS_WPG + SZ_WPG;
constexpr size_t WS_EARLY = WS_WPL + SZ_WPL;
constexpr size_t WS_WIN = WS_EARLY, WS_WAO = WS_WIN + SZ_WIN, WS_WHO = WS_WAO + SZ_WAO, WS_WOUT = WS_WHO + SZ_WHO;
constexpr size_t WS_QKV = WS_WOUT + SZ_WOUT, WS_HY = WS_QKV + SZ_QKV, WS_GT = WS_HY + SZ_HY, WS_END = WS_GT + SZ_GT;
constexpr size_t WS_HYO = WS_QKV;
constexpr size_t WS_TM = WS_HY;
constexpr size_t WS_XN2 = WS_END - SZ_XN;
constexpr size_t SZ_GU = (size_t)MP * FF * 2;
constexpr size_t WS_GU = WS_EARLY, WS_ACT = WS_GU + SZ_GU;
constexpr size_t WS_PP = WS_EARLY;
static_assert(WS_ACT + SZ_GU <= WS_XN2, "FFN buffers overlap XN2");
static_assert(WS_HYO + (size_t)M * HW * 2 <= WS_HY && WS_TM + SZ_XN <= WS_GT, "overlay map");
static_assert(WS_END <= 1450000000ull, "workspace");
constexpr size_t DO_XN = 0;
constexpr size_t DO_UT = 0;
constexpr size_t DO_KT = SZ_XN;
constexpr size_t DO_ATT = SZ_XN + (size_t)HW * (2 * LP + 2 * LS) * 4;
static_assert(DO_ATT + (size_t)M * AW * 2 <= (size_t)M * DM * 4, "d_out scratch map");
constexpr int CW_BAR = 4096;

constexpr int RING_BYTES = 131072;
constexpr int LDSCTL_OFF = RING_BYTES, MISC_OFF = LDSCTL_OFF + 320;
constexpr int LDS_BYTES = 147456;

#define GAS __attribute__((address_space(1)))
#define LAS __attribute__((address_space(3)))
typedef unsigned short bf16;
typedef unsigned v4u __attribute__((ext_vector_type(4)));
typedef float f32x4 __attribute__((ext_vector_type(4)));
typedef float f32x16 __attribute__((ext_vector_type(16)));
typedef short bf16x8 __attribute__((ext_vector_type(8)));
typedef short s16x4 __attribute__((ext_vector_type(4)));
typedef GAS unsigned gu32;
#define LDS_WAIT() asm volatile("s_waitcnt lgkmcnt(0)" ::: "memory")
using pg8::pk2f; using pg8::bflo; using pg8::bfhi;
#define XB_TMO      128
#define XB_XCNT(j)  (256  + 64 * (j))
#define XB_XSUB(j)  (1280 + 64 * (j))
#define XB_XGEN(j)  (2304 + 64 * (j))
#define XB_TOP      3328
#define XB_TOPGEN   3392
#define XCD_BAR_WORDS 3456
#define XB_SPIN_CAP (1u << 18)

__device__ __forceinline__ unsigned xb_ld(unsigned* p)              { return __hip_atomic_load(p, __ATOMIC_RELAXED, __HIP_MEMORY_SCOPE_AGENT); }
__device__ __forceinline__ unsigned xb_add(unsigned* p, unsigned v) { return __hip_atomic_fetch_add(p, v, __ATOMIC_RELAXED, __HIP_MEMORY_SCOPE_AGENT); }
__device__ __forceinline__ unsigned xb_xcc_id() { return (unsigned)__builtin_amdgcn_s_getreg((3 << 11) | 20) & 0xFu; }
#define XB_SPIN(cond, bar) do { unsigned _sp = 0; while (cond) { __builtin_amdgcn_s_sleep(1); \
    if ((++_sp & 255u) == 0u) { if (xb_ld(&(bar)[XB_TMO])) break; if (_sp > XB_SPIN_CAP) { atomicAdd(&(bar)[XB_TMO], 1u); break; } } } } while (0)

struct XcdBarrier {
    unsigned* bar; unsigned x;
    volatile LAS unsigned* st;
};

__device__ __forceinline__ XcdBarrier xcd_barrier_post(unsigned* bar, volatile LAS unsigned* st) {
    XcdBarrier b; b.bar = bar; b.x = xb_xcc_id(); b.st = st;
    if (threadIdx.x == 0) (void)xb_add(&bar[XB_XCNT(b.x)], 1u);
    return b;
}
__device__ __forceinline__ void xcd_barrier_complete(unsigned* bar, unsigned x, unsigned& nloc, unsigned& nx) {
    const unsigned G = gridDim.x * gridDim.y * gridDim.z;
    unsigned sum, cnt, mine, sp = 0u;
    for (;;) {
        sum = 0u; cnt = 0u; mine = 0u;
#pragma unroll
        for (unsigned j = 0; j < 16; ++j) { const unsigned c = xb_ld(&bar[XB_XCNT(j)]); sum += c; cnt += (c > 0u) ? 1u : 0u; mine = (j == x) ? c : mine; }
        if (sum == G) break;
        __builtin_amdgcn_s_sleep(1);
        if ((++sp & 255u) == 0u) { if (xb_ld(&bar[XB_TMO])) break; if (sp > XB_SPIN_CAP) { atomicAdd(&bar[XB_TMO], 1u); break; } }
    }
    nloc = mine > 0u ? mine : 1u; nx = cnt > 0u ? cnt : 1u;
}

__device__ __forceinline__ void xcd_barrier(const XcdBarrier& b) {
    asm volatile("s_waitcnt vmcnt(0)" ::: "memory");
    __syncthreads();
    if (threadIdx.x == 0) {
        unsigned* bar = b.bar;
        __builtin_amdgcn_s_waitcnt(0);
        unsigned nloc = b.st[0], nx = b.st[1];
        if (nloc == 0u) { xcd_barrier_complete(bar, b.x, nloc, nx); b.st[0] = nloc; b.st[1] = nx; }
        const unsigned old = xb_add(&bar[XB_XSUB(b.x)], 1u);
        const unsigned gen = old / nloc;
        if (old + 1u == (gen + 1u) * nloc) {
            __builtin_amdgcn_fence(__ATOMIC_RELEASE, "agent");
            asm volatile("s_waitcnt vmcnt(0)" ::: "memory");
            const unsigned og = xb_add(&bar[XB_TOP], 1u);
            const unsigned tg = og / nx;
            if (og + 1u == (tg + 1u) * nx) xb_add(&bar[XB_TOPGEN], 1u);
            else XB_SPIN(xb_ld(&bar[XB_TOPGEN]) == tg, bar);
            __builtin_amdgcn_fence(__ATOMIC_ACQUIRE, "agent");
            xb_add(&bar[XB_XGEN(b.x)], 1u);
            asm volatile("s_waitcnt vmcnt(0)" ::: "memory");
        } else {
            XB_SPIN(xb_ld(&bar[XB_XGEN(b.x)]) == gen, bar);
            __builtin_amdgcn_fence(__ATOMIC_ACQUIRE, "agent");
            asm volatile("s_waitcnt vmcnt(0)" ::: "memory");
        }
    }
    __syncthreads();
}

struct Args { const float* in[31]; float* out; unsigned char* ws; int ph_lo, ph_hi; };
typedef unsigned u32x2_t __attribute__((ext_vector_type(2)));
struct Frame {
    LAS unsigned char* lds;
    int tid, lane, wave, vcu, G;
};
__device__ __forceinline__ void refresh(Frame& F) { unsigned z_ = 0u; asm volatile("" : "+v"(z_)); const int l_ = (int)__builtin_amdgcn_mbcnt_hi(~0u, __builtin_amdgcn_mbcnt_lo(~0u, z_)); F.lane = l_; F.tid = F.wave * 64 + l_; }
__device__ __forceinline__ float shx(float v, int mask, int lane) { return __int_as_float(__builtin_amdgcn_ds_bpermute((lane ^ mask) << 2, __float_as_int(v))); }

struct TrItem { const float* W; bf16* WT; const float* gk; int K, N, k0, n0; float sc = 1.0f; };
__device__ __forceinline__ void tr_load(const TrItem& t, int lane, float (&wv)[32]) {
    const float* src = t.W + (size_t)(t.k0 + (lane >> 5)) * t.N + t.n0 + (lane & 31);
#pragma unroll
    for (int i = 0; i < 32; ++i) wv[i] = src[(size_t)(2 * i) * t.N];
}
__device__ __forceinline__ void tr_store(const TrItem& t, int lane, const float (&wv)[32], LAS float* scr) {
#pragma unroll
    for (int i = 0; i < 32; ++i) { const int kk = 2 * i + (lane >> 5); scr[kk * 33 + (lane & 31)] = (t.gk ? wv[i] * t.gk[t.k0 + kk] : wv[i]) * t.sc; }
    LDS_WAIT(); asm volatile("" ::: "memory");
    const int c = lane & 7;
#pragma unroll
    for (int j = 0; j < 4; ++j) { const int n = (lane >> 3) + 8 * j; const LAS float* s = scr + (8 * c) * 33 + n;
        v4u o; o.x = pk2f(s[0 * 33], s[1 * 33]); o.y = pk2f(s[2 * 33], s[3 * 33]); o.z = pk2f(s[4 * 33], s[5 * 33]); o.w = pk2f(s[6 * 33], s[7 * 33]);
        *(GAS v4u*)(t.WT + (size_t)(t.n0 + n) * t.K + t.k0 + 8 * c) = o; }
    LDS_WAIT(); asm volatile("" ::: "memory");
}
__device__ __forceinline__ TrItem tr_item(const float* W, int K, int N, bf16* WT, const float* gk, int r) { const int nblk = N / 32, kb = r / nblk, nb = r - kb * nblk; return TrItem{W, WT, gk, K, N, 64 * kb, 32 * nb}; }
template <bool BF> __device__ __forceinline__ void rms_row(const float* xrow, const float* g, void* orow, int lane) {
    const GAS f32x4* xr = (const GAS f32x4*)xrow + lane; const GAS f32x4* gr = (const GAS f32x4*)g + lane;
    f32x4 v[16]; float s = 0.f;
#pragma unroll
    for (int j = 0; j < 16; ++j) { v[j] = xr[64 * j]; s += (v[j].x * v[j].x + v[j].y * v[j].y) + (v[j].z * v[j].z + v[j].w * v[j].w); }
#pragma unroll
    for (int o = 1; o < 64; o <<= 1) s += shx(s, o, lane);
    const float r = 1.0f / sqrtf(s * (1.0f / 4096.0f) + EPS);
#pragma unroll
    for (int j = 0; j < 16; ++j) { const f32x4 gg = gr[64 * j]; const f32x4 y = v[j] * r * gg;
        if (BF) { ((GAS unsigned long long*)orow)[lane + 64 * j] = (unsigned long long)pk2f(y.x, y.y) | ((unsigned long long)pk2f(y.z, y.w) << 32); }
        else ((GAS f32x4*)orow)[lane + 64 * j] = y; }
}
__device__ __forceinline__ void final_row(const bf16* xrow, float rstd, const float* g, float* orow, int lane) {
    const GAS u32x2_t* xr = (const GAS u32x2_t*)xrow + lane; const GAS f32x4* gr = (const GAS f32x4*)g + lane; GAS f32x4* o = (GAS f32x4*)orow + lane;
    u32x2_t v[16];
#pragma unroll
    for (int j = 0; j < 16; ++j) v[j] = xr[64 * j];
#pragma unroll
    for (int j = 0; j < 16; ++j) { const f32x4 gg = gr[64 * j]; f32x4 y; y.x = bflo(v[j].x) * rstd * gg.x; y.y = bfhi(v[j].x) * rstd * gg.y; y.z = bflo(v[j].y) * rstd * gg.z; y.w = bfhi(v[j].y) * rstd * gg.w; o[64 * j] = y; }
}
__device__ __forceinline__ void rms_phase_bf16(const Frame& F, const float* src0, const float* src1, const float* g, bf16* dst) {
    const int gw = F.vcu * NWAVES + F.wave, NGW = F.G * NWAVES, lane = F.lane;
    if (gw >= M) return;
    f32x4 gv[16], cur[16], nxt[16];
#pragma unroll
    for (int j = 0; j < 16; ++j) gv[j] = ((const GAS f32x4*)g)[lane + 64 * j];
    { const GAS f32x4* xr = (const GAS f32x4*)(gw < MP ? src0 + (size_t)gw * DM : src1 + (size_t)(gw - MP) * DM) + lane;
#pragma unroll
      for (int j = 0; j < 16; ++j) cur[j] = xr[64 * j]; }
#pragma unroll 1
    for (int m = gw; m < M; m += NGW) {
        const int mn = m + NGW;
        if (mn < M) { const GAS f32x4* xr = (const GAS f32x4*)(mn < MP ? src0 + (size_t)mn * DM : src1 + (size_t)(mn - MP) * DM) + lane;
#pragma unroll
            for (int j = 0; j < 16; ++j) nxt[j] = xr[64 * j]; }
        float s = 0.f;
#pragma unroll
        for (int j = 0; j < 16; ++j) s += (cur[j].x * cur[j].x + cur[j].y * cur[j].y) + (cur[j].z * cur[j].z + cur[j].w * cur[j].w);
#pragma unroll
        for (int o = 1; o < 64; o <<= 1) s += shx(s, o, lane);
        const float r = 1.0f / sqrtf(s * (1.0f / 4096.0f) + EPS);
        GAS unsigned long long* orow = (GAS unsigned long long*)(dst + (size_t)m * DM);
#pragma unroll
        for (int j = 0; j < 16; ++j) { const f32x4 y = cur[j] * r * gv[j]; orow[lane + 64 * j] = (unsigned long long)pk2f(y.x, y.y) | ((unsigned long long)pk2f(y.z, y.w) << 32); }
        if (mn < M) {
#pragma unroll
            for (int j = 0; j < 16; ++j) cur[j] = nxt[j]; }
    }
}
__device__ __forceinline__ void final_phase(const Frame& F, const bf16* XB, const float* ss, const float* g, float* out, float dadd = 0.f) {
    const int gw = F.vcu * NWAVES + F.wave, NGW = F.G * NWAVES, lane = F.lane;
    if (gw >= M) return;
    f32x4 gv[16]; u32x2_t cur[16], nxt[16];
#pragma unroll
    for (int j = 0; j < 16; ++j) gv[j] = ((const GAS f32x4*)g)[lane + 64 * j];
    { const GAS u32x2_t* xr = (const GAS u32x2_t*)(XB + (size_t)gw * DM) + lane;
#pragma unroll
      for (int j = 0; j < 16; ++j) cur[j] = xr[64 * j]; }
    float sc = ss[gw];
#pragma unroll 1
    for (int m = gw; m < M; m += NGW) {
        const int mn = m + NGW; float sn = 0.f;
        if (mn < M) { const GAS u32x2_t* xr = (const GAS u32x2_t*)(XB + (size_t)mn * DM) + lane; sn = ss[mn];
#pragma unroll
            for (int j = 0; j < 16; ++j) nxt[j] = xr[64 * j]; }
        const float rstd = 1.0f / sqrtf(sc * (1.0f / 4096.0f) + EPS);
        GAS f32x4* o = (GAS f32x4*)(out + (size_t)m * DM) + lane;
#pragma unroll
        for (int j = 0; j < 16; ++j) { const f32x4 gg = gv[j]; f32x4 y; y.x = bflo(cur[j].x) * rstd * gg.x; y.y = bfhi(cur[j].x) * rstd * gg.y; y.z = bflo(cur[j].y) * rstd * gg.z; y.w = bfhi(cur[j].y) * rstd * gg.w; if (dadd != 0.f && m < MP) y = y + dadd; o[64 * j] = y; }
        if (mn < M) { sc = sn;
#pragma unroll
            for (int j = 0; j < 16; ++j) cur[j] = nxt[j]; }
    }
}

#define MFMAF32(a, b, c) __builtin_amdgcn_mfma_f32_32x32x2f32((a), (b), (c), 0, 0, 0)
__device__ __forceinline__ void h0_phase(const Frame& F, const Args& A, float* KT) {
    const float* w1 = A.in[10]; const float* b1 = A.in[11]; const float* f1 = A.in[12]; const float* w2 = A.in[13]; const float* b2 = A.in[14]; const float* f2 = A.in[15];
    const float* w3 = A.in[16]; const float* decay = A.in[17]; const float* skip = A.in[18];
    LAS float* Z = (LAS float*)F.lds; LAS float* H1 = Z + 64 * 35; LAS float* H2 = H1 + 64 * 65; LAS float* T = H2 + 64 * 65;
#pragma unroll 1
    for (int unit = F.vcu; unit < 1536; unit += F.G) {
        int tid = F.tid; asm volatile("" : "+v"(tid));
        const int lane = tid & 63, r = lane & 31, kh = lane >> 5, wv = F.wave;
        const int dct = unit & 15, lt = unit >> 4, dc0 = dct * 256, dir = dc0 >> 11, c0 = dc0 & 2047;
        const int lsel = lt >= 64, L = lsel ? LS : LP, l0 = (lsel ? lt - 64 : lt) * 64;
        float* KTb = KT + (lsel ? (size_t)HW * 2 * LP : 0);
        const float invLm1 = 1.0f / (float)(L - 1);
        float bw[32];
#pragma unroll
        for (int s = 0; s < 32; ++s) bw[s] = w3[(size_t)(2 * s + kh) * 4096 + dc0 + wv * 32 + r];
        const float dec = decay[dc0 + wv * 32 + r];
        for (int idx = tid; idx < 64 * 35; idx += NTHR) { const int li = idx / 35, f = idx - li * 35; const float lf = (float)(l0 + li);
            float v;
            if (f == 0) v = lf * invLm1;
            else if (f >= 33) v = 0.f;
            else { const int i = (f - 1) & 15; const float band = 1e-4f + (float)i * ((15.0f - 1e-4f) / 15.0f); const float a = 2.0f * lf * band / (float)L;
                v = f <= 16 ? cospif(a) : -sinpif(a); }
            Z[idx] = v; }
        __syncthreads();
        if (wv < 4) { const int lt2 = wv >> 1, j = (wv & 1) * 32 + r; f32x16 acc;
#pragma unroll
            for (int e = 0; e < 16; ++e) acc[e] = 0.f;
#pragma unroll
            for (int s = 0; s < 17; ++s) { const int k = 2 * s + kh; const float a = Z[(lt2 * 32 + r) * 35 + k], b = k < 33 ? w1[k * 64 + j] : 0.f; acc = MFMAF32(a, b, acc); }
            const float bj = b1[j], fj = f1[j];
#pragma unroll
            for (int e = 0; e < 16; ++e) H1[(lt2 * 32 + (e & 3) + 8 * (e >> 2) + 4 * kh) * 65 + j] = __sinf(fj * (acc[e] + bj)); }
        __syncthreads();
        if (wv < 4) { const int lt2 = wv >> 1, j = (wv & 1) * 32 + r; f32x16 acc;
#pragma unroll
            for (int e = 0; e < 16; ++e) acc[e] = 0.f;
#pragma unroll
            for (int s = 0; s < 32; ++s) { const int k = 2 * s + kh; acc = MFMAF32(H1[(lt2 * 32 + r) * 65 + k], w2[k * 64 + j], acc); }
            const float bj = b2[j], fj = f2[j];
#pragma unroll
            for (int e = 0; e < 16; ++e) H2[(lt2 * 32 + (e & 3) + 8 * (e >> 2) + 4 * kh) * 65 + j] = __sinf(fj * (acc[e] + bj)); }
        __syncthreads();
        { const int dcl = wv * 32 + r;
#pragma unroll
          for (int lt2 = 0; lt2 < 2; ++lt2) { f32x16 acc;
#pragma unroll
              for (int e = 0; e < 16; ++e) acc[e] = 0.f;
#pragma unroll
              for (int s = 0; s < 32; ++s) acc = MFMAF32(H2[(lt2 * 32 + r) * 65 + 2 * s + kh], bw[s], acc);
#pragma unroll
              for (int e = 0; e < 16; ++e) { const int li = lt2 * 32 + (e & 3) + 8 * (e >> 2) + 4 * kh; const float t = (float)(l0 + li) * invLm1; T[dcl * 65 + li] = acc[e] * __expf(-t * dec); } } }
        __syncthreads();
#pragma unroll 2
        for (int it = 0; it < 32; ++it) { const int row = (tid >> 6) + 8 * it, i = tid & 63, c = c0 + row, l = l0 + i; float v = T[row * 65 + i]; int n;
            if (dir == 0) { n = l; if (l == 0) v += skip[c]; }
            else { if (l == 0) { n = L; v = 0.f; } else n = 2 * L - l; }
            KTb[(size_t)c * (2 * L) + n] = v; }
        __syncthreads();
    }
}

struct HyUnit { int ct, seq, t0, L, rowbase; size_t uoff; };
__device__ __forceinline__ HyUnit hy_unit(int unit) { HyUnit u; u.ct = unit & 15; const int tt = unit >> 4;
    if (tt < 256) { u.seq = tt >> 6; u.t0 = (tt & 63) * 64; u.L = LP; u.rowbase = u.seq * LP; u.uoff = 0; }
    else { const int t2 = tt - 256; u.seq = t2 >> 5; u.t0 = (t2 & 31) * 64; u.L = LS; u.rowbase = MP + u.seq * LS; u.uoff = (size_t)HW * 4 * LP; }
    return u; }
template <int NC> __device__ __forceinline__ void hy_load(const bf16* HY, const HyUnit& u, int comp0, int cp, int tq, unsigned (&xr)[NC][10]) {
    const int c = u.ct * 128 + 2 * cp;
#pragma unroll
    for (int i = 0; i < 10; ++i) { const int t = u.t0 + tq * 8 - 1 + i;
#pragma unroll
        for (int cm = 0; cm < NC; ++cm) { unsigned v = 0u; if (t >= 0 && t < u.L) v = *(const unsigned*)(HY + (size_t)(u.rowbase + t) * 6144 + (comp0 + cm) * 2048 + c); xr[cm][i] = v; } }
}
__device__ __forceinline__ void h1_phase(const Frame& F, const Args& A, const bf16* HY, bf16* UT) {
    const float* sw = A.in[8]; const float* sb = A.in[9];
    LAS float* T = (LAS float*)F.lds;
    if (F.vcu >= 6144) return;
    unsigned xr[2][10], xn[2][10];
    { const int tid0 = F.tid; hy_load<2>(HY, hy_unit(F.vcu), 0, tid0 & 63, tid0 >> 6, xr); }
#pragma unroll 1
    for (int unit = F.vcu; unit < 6144; unit += F.G) {
        int tid = F.tid; asm volatile("" : "+v"(tid)); const int cp = tid & 63, tq = tid >> 6;
        const HyUnit u = hy_unit(unit); const bool more = unit + F.G < 6144;
        if (more) hy_load<2>(HY, hy_unit(unit + F.G), 0, cp, tq, xn);
        const int ct = u.ct, seq = u.seq, t0 = u.t0, L = u.L; bf16* ut = UT + u.uoff;
        const int c = ct * 128 + 2 * cp;
        float w[2][2][3], b[2][2];
#pragma unroll
        for (int cm = 0; cm < 2; ++cm)
#pragma unroll
            for (int ch = 0; ch < 2; ++ch) { b[cm][ch] = sb[cm * 2048 + c + ch];
#pragma unroll
                for (int k = 0; k < 3; ++k) w[cm][ch][k] = sw[k * 6144 + cm * 2048 + c + ch]; }
        float x[2][2][10];
#pragma unroll
        for (int i = 0; i < 10; ++i)
#pragma unroll
            for (int cm = 0; cm < 2; ++cm) { x[cm][0][i] = bflo(xr[cm][i]); x[cm][1][i] = bfhi(xr[cm][i]); }
#pragma unroll
        for (int i = 0; i < 8; ++i)
#pragma unroll
            for (int ch = 0; ch < 2; ++ch) {
                const float a = w[0][ch][0] * x[0][ch][i] + w[0][ch][1] * x[0][ch][i + 1] + w[0][ch][2] * x[0][ch][i + 2] + b[0][ch];
                const float d = w[1][ch][0] * x[1][ch][i] + w[1][ch][1] * x[1][ch][i + 1] + w[1][ch][2] * x[1][ch][i + 2] + b[1][ch];
                T[(ch * 64 + cp) * 65 + tq * 8 + i] = a * d; }
        __syncthreads();
#pragma unroll 4
        for (int it = 0; it < 8; ++it) { const int rho = (tid >> 5) + 16 * it, i2 = tid & 31, cc = ct * 128 + 2 * (rho & 63) + (rho >> 6);
            *(unsigned*)(ut + ((size_t)cc * 4 + seq) * L + t0 + 2 * i2) = pk2f(T[rho * 65 + 2 * i2], T[rho * 65 + 2 * i2 + 1]); }
        __syncthreads();
        if (more) {
#pragma unroll
            for (int i = 0; i < 10; ++i) { xr[0][i] = xn[0][i]; xr[1][i] = xn[1][i]; } }
    }
}
__device__ __forceinline__ void h3_phase(const Frame& F, const Args& A, const bf16* HY, const bf16* UT, bf16* HYO) {
    const float* sw = A.in[8]; const float* sb = A.in[9];
    LAS float* T = (LAS float*)F.lds;
    if (F.vcu >= 6144) return;
    unsigned xr[1][10], xn[1][10], yr[8], yn[8];
    auto yload = [&](const HyUnit& u, int tid, unsigned (&y)[8]) {
#pragma unroll
        for (int it = 0; it < 8; ++it) { const int rho = (tid >> 5) + 16 * it, i2 = tid & 31, cc = u.ct * 128 + 2 * (rho & 63) + (rho >> 6);
            y[it] = *(const unsigned*)(UT + u.uoff + ((size_t)cc * 4 + u.seq) * u.L + u.t0 + 2 * i2); } };
    { const int tid0 = F.tid; const HyUnit u0 = hy_unit(F.vcu); yload(u0, tid0, yr); hy_load<1>(HY, u0, 2, tid0 & 63, tid0 >> 6, xr); }
#pragma unroll 1
    for (int unit = F.vcu; unit < 6144; unit += F.G) {
        int tid = F.tid; asm volatile("" : "+v"(tid)); const int cp = tid & 63, tq = tid >> 6;
        const HyUnit u = hy_unit(unit); const bool more = unit + F.G < 6144;
        if (more) { const HyUnit un = hy_unit(unit + F.G); yload(un, tid, yn); hy_load<1>(HY, un, 2, cp, tq, xn); }
        const int ct = u.ct, t0 = u.t0, rowbase = u.rowbase;
#pragma unroll
        for (int it = 0; it < 8; ++it) { const int rho = (tid >> 5) + 16 * it, i2 = tid & 31; T[rho * 65 + 2 * i2] = bflo(yr[it]); T[rho * 65 + 2 * i2 + 1] = bfhi(yr[it]); }
        const int c = ct * 128 + 2 * cp;
        float w[2][3], b[2];
#pragma unroll
        for (int ch = 0; ch < 2; ++ch) { b[ch] = sb[4096 + c + ch];
#pragma unroll
            for (int k = 0; k < 3; ++k) w[ch][k] = sw[k * 6144 + 4096 + c + ch]; }
        float x[2][10];
#pragma unroll
        for (int i = 0; i < 10; ++i) { x[0][i] = bflo(xr[0][i]); x[1][i] = bfhi(xr[0][i]); }
        __syncthreads();
#pragma unroll
        for (int i = 0; i < 8; ++i) {
            const float g0 = w[0][0] * x[0][i] + w[0][1] * x[0][i + 1] + w[0][2] * x[0][i + 2] + b[0];
            const float g1 = w[1][0] * x[1][i] + w[1][1] * x[1][i + 1] + w[1][2] * x[1][i + 2] + b[1];
            const float y0 = T[cp * 65 + tq * 8 + i], y1 = T[(64 + cp) * 65 + tq * 8 + i];
            *(unsigned*)(HYO + (size_t)(rowbase + t0 + tq * 8 + i) * 2048 + c) = pk2f(y0 * g0, y1 * g1); }
        __syncthreads();
        if (more) {
#pragma unroll
            for (int i = 0; i < 10; ++i) xr[0][i] = xn[0][i];
#pragma unroll
            for (int it = 0; it < 8; ++it) yr[it] = yn[it]; }
    }
}


#define HD_INLINE __device__ __forceinline__
#define XP(T) LAS T*
#ifndef FFT_CORE_H
#define FFT_CORE_H
#ifdef __HIP_DEVICE_COMPILE__
typedef float cf __attribute__((ext_vector_type(2)));
#elif defined(__clang__)
typedef float cf __attribute__((ext_vector_type(2)));
#else
struct cf { float x, y; };
#endif
#ifdef __HIPCC__
#define PK_ADD(r, a, b, OS, OH, NL, NH) asm("v_pk_add_f32 %0, %1, %2 op_sel:" OS " op_sel_hi:" OH " neg_lo:" NL " neg_hi:" NH : "=v"(r) : "v"(a), "v"(b))
#define PK_MUL(r, a, b, OS, OH, NL, NH) asm("v_pk_mul_f32 %0, %1, %2 op_sel:" OS " op_sel_hi:" OH " neg_lo:" NL " neg_hi:" NH : "=v"(r) : "v"(a), "v"(b))
#define PK_FMA(r, a, b, c, OS, OH, NL, NH) asm("v_pk_fma_f32 %0, %1, %2, %3 op_sel:" OS " op_sel_hi:" OH " neg_lo:" NL " neg_hi:" NH : "=v"(r) : "v"(a), "v"(b), "v"(c))
HD_INLINE cf cadd(cf a, cf b) { return a + b; }
HD_INLINE cf csub(cf a, cf b) { return a - b; }
HD_INLINE cf cscale(cf a, float s) { return a * s; }
#else
static inline float pk_src(cf v, const char* sel, const char* neg, int i) { const float f = (sel[1 + 2 * i] == '1') ? v.y : v.x; return (neg[1 + 2 * i] == '1') ? -f : f; }
#define PK_ADD(r, a, b, OS, OH, NL, NH) do { cf r_; r_.x = pk_src(a, OS, NL, 0) + pk_src(b, OS, NL, 1); r_.y = pk_src(a, OH, NH, 0) + pk_src(b, OH, NH, 1); r = r_; } while (0)
#define PK_MUL(r, a, b, OS, OH, NL, NH) do { cf r_; r_.x = pk_src(a, OS, NL, 0) * pk_src(b, OS, NL, 1); r_.y = pk_src(a, OH, NH, 0) * pk_src(b, OH, NH, 1); r = r_; } while (0)
#define PK_FMA(r, a, b, c, OS, OH, NL, NH) do { cf r_; r_.x = pk_src(a, OS, NL, 0) * pk_src(b, OS, NL, 1) + pk_src(c, OS, NL, 2); r_.y = pk_src(a, OH, NH, 0) * pk_src(b, OH, NH, 1) + pk_src(c, OH, NH, 2); r = r_; } while (0)
HD_INLINE cf cadd(cf a, cf b) { return cf{a.x + b.x, a.y + b.y}; }
HD_INLINE cf csub(cf a, cf b) { return cf{a.x - b.x, a.y - b.y}; }
HD_INLINE cf cscale(cf a, float s) { return cf{a.x * s, a.y * s}; }
#endif
HD_INLINE cf csub_mi(cf a, cf b) { cf r; PK_ADD(r, a, b, "[1,1]", "[0,0]", "[0,1]", "[1,0]"); return r; }
HD_INLINE cf cadd_pi(cf a, cf b) { cf r; PK_ADD(r, a, b, "[0,1]", "[1,0]", "[0,1]", "[0,0]"); return r; }
HD_INLINE cf csub_pi(cf a, cf b) { cf r; PK_ADD(r, a, b, "[0,1]", "[1,0]", "[0,0]", "[0,1]"); return r; }
HD_INLINE cf cmul(cf a, cf b) { cf t, r; PK_MUL(t, a, b, "[1,0]", "[1,1]", "[0,0]", "[0,0]");
    PK_FMA(r, a, b, t, "[0,0,1]", "[0,1,0]", "[0,0,1]", "[0,0,0]"); return r; }
HD_INLINE cf cmulc(cf a, cf b) { cf t, r; PK_MUL(t, a, b, "[1,0]", "[1,1]", "[0,0]", "[0,0]");
    PK_FMA(r, a, b, t, "[0,0,1]", "[0,1,0]", "[0,0,0]", "[1,0,0]"); return r; }
HD_INLINE cf csqr(cf a) { return cmul(a, a); }
HD_INLINE int fpad(int i) { return i + (i >> 4); }
HD_INLINE int wpad(int k) { return k + (k >> 4) + (k >> 8); }
HD_INLINE cf mul_w32(cf x, int idx, bool conj) {
    const float C[16] = {1.0f, 0.98078528040f, 0.92387953251f, 0.83146961230f, 0.70710678119f, 0.55557023302f, 0.38268343237f, 0.19509032202f, 0.0f, -0.19509032202f, -0.38268343237f, -0.55557023302f, -0.70710678119f, -0.83146961230f, -0.92387953251f, -0.98078528040f};
    const float S[16] = {0.0f, 0.19509032202f, 0.38268343237f, 0.55557023302f, 0.70710678119f, 0.83146961230f, 0.92387953251f, 0.98078528040f, 1.0f, 0.98078528040f, 0.92387953251f, 0.83146961230f, 0.70710678119f, 0.55557023302f, 0.38268343237f, 0.19509032202f};
    if (idx == 0) return x;
    if (idx == 8) return conj ? cf{-x.y, x.x} : cf{x.y, -x.x};
    const float c = C[idx], s = conj ? -S[idx] : S[idx];
#ifdef __HIPCC__
    const cf t = x.yx * cf{s, -s}; return __builtin_elementwise_fma(x, cf{c, c}, t);
#else
    return cf{x.x * c + x.y * s, x.y * c - x.x * s};
#endif
}
HD_INLINE int brev(int j, int lr) { int r = 0; for (int b = 0; b < lr; ++b) r |= ((j >> b) & 1) << (lr - 1 - b); return r; }
template <int R> HD_INLINE void wpowers(cf w, cf (&p)[R]) {
    p[0] = cf{1.0f, 0.0f}; if (R > 1) p[1] = w;
#pragma unroll
    for (int k = 2; k < R; ++k) p[k] = (k & 1) ? cmul(p[k - 1], w) : csqr(p[k >> 1]);
}
template <int LR> HD_INLINE void dif_regs(cf (&v)[1 << LR], XP(const cf) W, int N, int q, int o) {
    constexpr int R = 1 << LR;
#pragma unroll
    for (int st = 0; st < LR; ++st) {
        const int half = R >> (st + 1);
#pragma unroll
        for (int j = 0; j < R; ++j) {
            if ((j & half) == 0) {
                const cf a = v[j], b = v[j + half];
                const int idx = (j & (half - 1)) * (16 / half);
                v[j] = cadd(a, b);
                v[j + half] = (idx == 8) ? csub_mi(a, b) : mul_w32(csub(a, b), idx, false);
            }
        }
    }
    if (q > 1) {
        if (R == 32) {
            cf p[16]; wpowers<16>(W[wpad(o * (N / (R * q)))], p); const cf p16 = csqr(p[8]);
#pragma unroll
            for (int j = 1; j < R; ++j) { const int k = brev(j, LR); v[j] = cmul(v[j], k < 16 ? p[k & 15] : cmul(p[k & 15], p16)); }
        } else {
        cf p[R]; wpowers<R>(W[wpad(o * (N / (R * q)))], p);
#pragma unroll
        for (int j = 1; j < R; ++j) v[j] = cmul(v[j], p[brev(j, LR)]);
        }
    }
}
template <int LR> HD_INLINE void dit_regs(cf (&v)[1 << LR], XP(const cf) W, int N, int s0, int o) {
    constexpr int R = 1 << LR;
    if (s0 > 1) {
        if (R == 32) {
            cf p[16]; wpowers<16>(W[wpad(o * (N / (R * s0)))], p); const cf p16 = csqr(p[8]);
#pragma unroll
            for (int j = 1; j < R; ++j) { const int k = brev(j, LR); v[j] = cmulc(v[j], k < 16 ? p[k & 15] : cmul(p[k & 15], p16)); }
        } else {
        cf p[R]; wpowers<R>(W[wpad(o * (N / (R * s0)))], p);
#pragma unroll
        for (int j = 1; j < R; ++j) v[j] = cmulc(v[j], p[brev(j, LR)]);
        }
    }
#pragma unroll
    for (int st = 0; st < LR; ++st) {
        const int half = 1 << st;
#pragma unroll
        for (int j = 0; j < R; ++j) {
            if ((j & half) == 0) {
                const int idx = (j & (half - 1)) * (16 / half);
                const cf a = v[j];
                if (idx == 8) { const cf x = v[j + half]; v[j] = cadd_pi(a, x); v[j + half] = csub_pi(a, x); }
                else { const cf b = mul_w32(v[j + half], idx, true); v[j] = cadd(a, b); v[j + half] = csub(a, b); }
            }
        }
    }
}
template <int LR> HD_INLINE void dif_pass(XP(cf) X, XP(const cf) W, int N, int S, int tid, int nthr) {
    constexpr int R = 1 << LR;
    const int q = S >> (LR - 1);
#pragma unroll 1
    for (int bf = tid; bf < N / R; bf += nthr) {
        const int blk = bf / q, o = bf - blk * q, base = blk * 2 * S + o;
        cf v[R];
#pragma unroll
        for (int j = 0; j < R; ++j) v[j] = X[fpad(base + j * q)];
        dif_regs<LR>(v, W, N, q, o);
#pragma unroll
        for (int j = 0; j < R; ++j) X[fpad(base + j * q)] = v[j];
    }
}
template <int LR> HD_INLINE void dit_pass(XP(cf) X, XP(const cf) W, int N, int s0, int tid, int nthr) {
    constexpr int R = 1 << LR;
#pragma unroll 1
    for (int bf = tid; bf < N / R; bf += nthr) {
        const int blk = bf / s0, o = bf - blk * s0, base = blk * R * s0 + o;
        cf v[R];
#pragma unroll
        for (int j = 0; j < R; ++j) v[j] = X[fpad(base + j * s0)];
        dit_regs<LR>(v, W, N, s0, o);
#pragma unroll
        for (int j = 0; j < R; ++j) X[fpad(base + j * s0)] = v[j];
    }
}
#endif
#undef HD_INLINE
#undef XP
constexpr int FFT_W_OFF = (8192 + 512 + 16) * 8;
template <int RA> struct FftIn { float ktv[RA]; unsigned up0[RA / 2], up1[RA / 2]; };
template <int RA> __device__ __forceinline__ void fft_load_kt(FftIn<RA>& in, const float* kt, int tid) {
#pragma unroll
    for (int j = 0; j < RA; ++j) in.ktv[j] = kt[tid + 256 * j]; }
template <int RA> __device__ __forceinline__ void fft_load_u(unsigned (&up)[RA / 2], const bf16* u0, int L, int tid) {
#pragma unroll
    for (int j = 0; j < RA / 2; ++j) up[j] = (unsigned)u0[tid + 256 * j] | ((unsigned)u0[(size_t)L + tid + 256 * j] << 16); }
template <int LOG2N> __device__ __forceinline__ void fft_conv_channel(const Frame& F, FftIn<(LOG2N == 13) ? 32 : 16>& in, const float* kt_next, bf16* u, const bf16* u_next, int L) {
    constexpr int N = 1 << LOG2N, LRA = (LOG2N == 13) ? 5 : 4, RA = 1 << LRA, NIN_A = RA / 2, NT1 = N / RA;
    static_assert(NT1 == 256, "stride");
    LAS cf* X = (LAS cf*)F.lds; const LAS cf* W = (const LAS cf*)(F.lds + FFT_W_OFF);
    int tid = F.tid; asm volatile("" : "+v"(tid));
    const bool t1 = tid < NT1;
    const bool hn = kt_next != nullptr;
    if (t1) {
        cf v[RA];
#pragma unroll
        for (int j = 0; j < RA; ++j) v[j] = cf{in.ktv[j], 0.f};
        dif_regs<LRA>(v, W, N, NT1, tid);
#pragma unroll
        for (int j = 0; j < RA; ++j) X[fpad(tid + NT1 * j)] = v[j];
    }
    __syncthreads();
    dif_pass<4>(X, W, N, 128, tid, NTHR);
    __syncthreads();
    cf kf[16];
    if (tid < N / 16) {
#pragma unroll
        for (int j = 0; j < 16; ++j) kf[j] = X[fpad(tid * 16 + j)];
        dif_regs<4>(kf, W, N, 1, 0);
#pragma unroll
        for (int j = 0; j < 16; ++j) kf[j] = cscale(kf[j], 1.0f / N);
    } else {
#pragma unroll
        for (int j = 0; j < 16; ++j) kf[j] = cf{0.f, 0.f};
    }
    __syncthreads();
#pragma unroll
    for (int pr = 0; pr < 2; ++pr) {
        bf16* u0 = u + (size_t)(2 * pr) * L; bf16* u1 = u0 + L;
        if (t1) { cf v[RA];
#pragma unroll
          for (int j = 0; j < RA; ++j) { const unsigned w = (j < NIN_A) ? (pr ? in.up1[j < NIN_A ? j : 0] : in.up0[j < NIN_A ? j : 0]) : 0u; v[j] = (j < NIN_A) ? cf{__uint_as_float(w << 16), __uint_as_float(w & 0xffff0000u)} : cf{0.f, 0.f}; }
          if (hn) { if (pr == 0) fft_load_u<RA>(in.up0, u_next, L, tid); else fft_load_u<RA>(in.up1, u_next + (size_t)2 * L, L, tid); }
          dif_regs<LRA>(v, W, N, NT1, tid);
#pragma unroll
          for (int j = 0; j < RA; ++j) X[fpad(tid + NT1 * j)] = v[j]; }
        __syncthreads();
        dif_pass<4>(X, W, N, 128, tid, NTHR);
        __syncthreads();
        if (tid < N / 16) { cf v[16];
#pragma unroll
            for (int j = 0; j < 16; ++j) v[j] = X[fpad(tid * 16 + j)];
            dif_regs<4>(v, W, N, 1, 0);
#pragma unroll
            for (int j = 0; j < 16; ++j) v[j] = cmul(v[j], kf[j]);
            dit_regs<4>(v, W, N, 1, 0);
#pragma unroll
            for (int j = 0; j < 16; ++j) X[fpad(tid * 16 + j)] = v[j]; }
        if (pr == 1 && hn && t1) fft_load_kt<RA>(in, kt_next, tid);
        __syncthreads();
        dit_pass<4>(X, W, N, 16, tid, NTHR);
        __syncthreads();
        if (t1) { cf v[RA];
#pragma unroll
          for (int j = 0; j < RA; ++j) v[j] = X[fpad(tid + NT1 * j)];
          dit_regs<LRA>(v, W, N, NT1, tid);
#pragma unroll
          for (int j = 0; j < NIN_A; ++j) { u0[tid + NT1 * j] = (bf16)(pk2f(v[j].x, 0.f) & 0xffffu); u1[tid + NT1 * j] = (bf16)(pk2f(v[j].y, 0.f) & 0xffffu); } }
        __syncthreads();
    }
}
template <int LOG2N> __device__ __forceinline__ void fft_channels(const Frame& F, const float* KTb, bf16* UTb, int L) {
    constexpr int RA = (LOG2N == 13) ? 32 : 16; constexpr size_t KS = (size_t)1 << LOG2N;
    int c = F.vcu; if (c >= HW) return;
    FftIn<RA> in;
    { int tid = F.tid; asm volatile("" : "+v"(tid));
      if (tid < 256) { fft_load_kt<RA>(in, KTb + (size_t)c * KS, tid); fft_load_u<RA>(in.up0, UTb + (size_t)c * 4 * L, L, tid); fft_load_u<RA>(in.up1, UTb + (size_t)c * 4 * L + (size_t)2 * L, L, tid); } }
#pragma unroll 1
    for (; c < HW; c += F.G) { const int cn = c + F.G; const bool hn = cn < HW;
        fft_conv_channel<LOG2N>(F, in, hn ? KTb + (size_t)cn * KS : nullptr, UTb + (size_t)c * 4 * L, hn ? UTb + (size_t)cn * 4 * L : nullptr, L); }
}
__device__ __forceinline__ void h2_phase(const Frame& F, const float* KT, bf16* UT) {
    LAS cf* W = (LAS cf*)(F.lds + FFT_W_OFF);
    for (int k = F.tid; k < 4096; k += NTHR) { const float a = (float)k * (1.0f / 4096.0f); W[wpad(k)] = cf{cospif(a), -sinpif(a)}; }
    __syncthreads();
    fft_channels<13>(F, KT, UT, LP);
    __syncthreads();
    for (int k = F.tid; k < 2048; k += NTHR) { const float a = (float)k * (1.0f / 2048.0f); W[wpad(k)] = cf{cospif(a), -sinpif(a)}; }
    __syncthreads();
    fft_channels<12>(F, KT + (size_t)HW * 8192, UT + (size_t)HW * 4 * LP, LS);
    __syncthreads();
}

constexpr int ATT_KROW = 272, ATT_VROW = 648, ATT_BIAS_OFF = 320 * ATT_KROW, ATT_OROW = 272;
#define MFMA32(a, b, c) __builtin_amdgcn_mfma_f32_32x32x16_bf16((a), (b), (c), 0, 0, 0)
__device__ __forceinline__ void attn_phase(const Frame& F, const Args& A, const bf16* QKV, bf16* ATT) {
    const int g4 = F.wave >> 1, sub = F.wave & 1;
    LAS unsigned char* lds = F.lds;
    LAS float* BIAS = (LAS float*)(lds + ATT_BIAS_OFF);
    { const float* rel_bias = A.in[4];
      for (int idx = F.tid; idx < 16 * 257; idx += NTHR) { const int hh = idx / 257, ri = idx - hh * 257, rel = ri - 128, n = rel < 0 ? -rel : rel; int b;
          if (n < 8) b = n; else { int e = 0; while ((64 << (e + 1)) <= n * n) ++e; b = 8 + e; if (b > 15) b = 15; }
          if (rel > 0) b += 16;
          BIAS[hh * 260 + ri] = rel_bias[b * 16 + hh] * 1.44269504089f; } }
    __syncthreads();
    v4u kpre[10]; bf16x8 qf[8];
    auto unit_geom = [&](int unit, int& kvh, int& q0, int& L, int& rowbase) __attribute__((always_inline)) { kvh = unit & 3; const int tile = unit >> 2;
        if (tile < 256) { rowbase = (tile >> 6) * LP; q0 = (tile & 63) * 64; L = LP; } else { const int t2 = tile - 256; rowbase = MP + (t2 >> 5) * LS; q0 = (t2 & 31) * 64; L = LS; } };
    auto issue_k = [&](int unit, int lane) __attribute__((always_inline)) { int kvh, q0, L, rowbase; unit_geom(unit, kvh, q0, L, rowbase); const int rl = lane >> 4, ch = lane & 15;
#pragma unroll
        for (int i = 0; i < 10; ++i) { const int row = (F.wave * 10 + i) * 4 + rl, kp = q0 - 128 + row; kpre[i] = (v4u){0u, 0u, 0u, 0u};
            if (kp >= 0 && kp < L) kpre[i] = *(const v4u*)(QKV + (size_t)(rowbase + kp) * 3072 + 2048 + kvh * 128 + ch * 8); } };
    auto issue_q = [&](int unit, int lane) __attribute__((always_inline)) { int kvh, q0, L, rowbase; unit_geom(unit, kvh, q0, L, rowbase); const int r = lane & 31, h = lane >> 5, hq = kvh * 4 + g4;
        const bf16* qp = QKV + (size_t)(rowbase + q0 + sub * 32 + r) * 3072 + hq * 128 + 8 * h;
#pragma unroll
        for (int s = 0; s < 8; ++s) qf[s] = *(const bf16x8*)(qp + 16 * s); };
    if (F.vcu < 1536) { int lane0 = F.lane; asm volatile("" : "+v"(lane0)); issue_k(F.vcu, lane0); issue_q(F.vcu, lane0); }
#pragma unroll 1
    for (int unit = F.vcu; unit < 1536; unit += F.G) {
        int lane = F.lane; asm volatile("" : "+v"(lane));
        const int r = lane & 31, h = lane >> 5;
        int kvh, q0, L, rowbase; unit_geom(unit, kvh, q0, L, rowbase);
        const int hq = kvh * 4 + g4;
        { const int rl = lane >> 4, ch = lane & 15;
#pragma unroll
          for (int i = 0; i < 10; ++i) { const int row = (F.wave * 10 + i) * 4 + rl; *(LAS v4u*)(lds + row * ATT_KROW + ch * 16) = kpre[i]; } }
        __syncthreads();
        f32x16 sacc[9];
        { const LAS unsigned char* kb = lds + (sub * 32 + r) * ATT_KROW + h * 16;
#pragma unroll
          for (int kt = 0; kt < 9; ++kt) {
#pragma unroll
              for (int e = 0; e < 16; ++e) sacc[kt][e] = 0.f;
#pragma unroll
              for (int s = 0; s < 8; ++s) { const bf16x8 a = *(const LAS bf16x8*)(kb + kt * 32 * ATT_KROW + s * 32); sacc[kt] = MFMA32(a, qf[s], sacc[kt]); }
              __builtin_amdgcn_sched_barrier(0);
          } }
        v4u vv[10];
#pragma unroll
        for (int i = 0; i < 10; ++i) { const int combo = F.wave * 10 + i, kg = combo % 5, ch = combo / 5, kp = q0 - 128 + kg * 64 + lane; vv[i] = (v4u){0u, 0u, 0u, 0u};
            if (kp >= 0 && kp < L) vv[i] = *(const v4u*)(QKV + (size_t)(rowbase + kp) * 3072 + 2560 + kvh * 128 + ch * 8); }
        const float sink = A.in[7][hq] * 1.44269504089f;
        float mx = sink;
        const bool interior = (q0 >= 128) && (q0 + 192 <= L);
        { const int qpos = q0 + sub * 32 + r, relb = 4 * h - 128 - r; const LAS float* bh = BIAS + hq * 260 + 128 + relb;
#pragma unroll
          for (int kt = 0; kt < 9; ++kt) {
              if (interior && kt >= 1 && kt <= 7) {
#pragma unroll
                  for (int e = 0; e < 16; ++e) { const float sv = sacc[kt][e] + bh[kt * 32 + (e & 3) + 8 * (e >> 2)]; sacc[kt][e] = sv; mx = fmaxf(mx, sv); }
              } else {
#pragma unroll
              for (int e = 0; e < 16; ++e) { const int ro = kt * 32 + (e & 3) + 8 * (e >> 2); const int rel = relb + ro; const int kp = qpos + rel;
                  bool ok = kp >= 0 && kp < L; float bv;
                  if (kt == 0) { ok = ok && rel >= -128; bv = bh[ok ? ro : -relb]; }
                  else if (kt == 8) { ok = ok && rel <= 128; bv = bh[ok ? ro : -relb]; }
                  else bv = bh[ro];
                  const float sv = ok ? sacc[kt][e] + bv : -1e30f; sacc[kt][e] = sv; mx = fmaxf(mx, sv); }
              }
              __builtin_amdgcn_sched_barrier(0);
          } }
        mx = fmaxf(mx, shx(mx, 32, lane));
        float sum = 0.f;
        bf16x8 pf[9][2];
#pragma unroll
        for (int kt = 0; kt < 9; ++kt) {
#pragma unroll
            for (int e = 0; e < 16; ++e) { const float p = __builtin_amdgcn_exp2f(sacc[kt][e] - mx); sacc[kt][e] = p; sum += p; }
#pragma unroll
            for (int s2 = 0; s2 < 2; ++s2) { v4u w;
                w.x = pk2f(sacc[kt][8 * s2 + 0], sacc[kt][8 * s2 + 1]); w.y = pk2f(sacc[kt][8 * s2 + 2], sacc[kt][8 * s2 + 3]);
                w.z = pk2f(sacc[kt][8 * s2 + 4], sacc[kt][8 * s2 + 5]); w.w = pk2f(sacc[kt][8 * s2 + 6], sacc[kt][8 * s2 + 7]);
                pf[kt][s2] = __builtin_bit_cast(bf16x8, w); }
            __builtin_amdgcn_sched_barrier(0);
        }
        sum += shx(sum, 32, lane);
        const float inv = 1.0f / (sum + __builtin_amdgcn_exp2f(sink - mx));
        __syncthreads();
#pragma unroll
        for (int i = 0; i < 10; ++i) { const int combo = F.wave * 10 + i, kg = combo % 5, ch = combo / 5; LAS bf16* vp = (LAS bf16*)(lds + (ch * 8) * ATT_VROW + (kg * 64 + lane) * 2);
            vp[0 * 324] = (bf16)(vv[i].x & 0xffffu); vp[1 * 324] = (bf16)(vv[i].x >> 16); vp[2 * 324] = (bf16)(vv[i].y & 0xffffu); vp[3 * 324] = (bf16)(vv[i].y >> 16);
            vp[4 * 324] = (bf16)(vv[i].z & 0xffffu); vp[5 * 324] = (bf16)(vv[i].z >> 16); vp[6 * 324] = (bf16)(vv[i].w & 0xffffu); vp[7 * 324] = (bf16)(vv[i].w >> 16); }
        __syncthreads();
        f32x16 oacc[4];
#pragma unroll
        for (int dt = 0; dt < 4; ++dt)
#pragma unroll
            for (int e = 0; e < 16; ++e) oacc[dt][e] = 0.f;
        { const LAS unsigned char* vb0 = lds + r * ATT_VROW + (sub * 32 + 4 * h) * 2;
#pragma unroll
          for (int kt = 0; kt < 9; ++kt)
#pragma unroll
              for (int s2 = 0; s2 < 2; ++s2) {
#pragma unroll
                  for (int dt = 0; dt < 4; ++dt) { const LAS unsigned char* vb = vb0 + dt * 32 * ATT_VROW + (kt * 32 + 16 * s2) * 2;
                      const s16x4 lo = *(const LAS s16x4*)vb, hi = *(const LAS s16x4*)(vb + 16);
                      const bf16x8 bfr = {lo[0], lo[1], lo[2], lo[3], hi[0], hi[1], hi[2], hi[3]};
                      oacc[dt] = MFMA32(pf[kt][s2], bfr, oacc[dt]); }
                  if (kt == 4 && s2 == 1) issue_k(unit + F.G < 1536 ? unit + F.G : unit, lane);
                  if (kt == 8 && s2 == 1) issue_q(unit + F.G < 1536 ? unit + F.G : unit, lane);
                  __builtin_amdgcn_sched_barrier(0); } }
        __syncthreads();
        { LAS unsigned char* ob = lds + F.wave * (32 * ATT_OROW);
          LAS bf16* ow = (LAS bf16*)(ob + (4 * h) * ATT_OROW + r * 2);
          float invq[16];
#pragma unroll
          for (int e = 0; e < 16; ++e) invq[e] = __int_as_float(__builtin_amdgcn_ds_bpermute(((e & 3) + 8 * (e >> 2) + 4 * h) << 2, __float_as_int(inv)));
#pragma unroll
          for (int dt = 0; dt < 4; ++dt)
#pragma unroll
              for (int e = 0; e < 16; ++e) ow[((e & 3) + 8 * (e >> 2)) * (ATT_OROW / 2) + dt * 32] = (bf16)(pk2f(oacc[dt][e] * invq[e], 0.f) & 0xffffu);
          LDS_WAIT(); asm volatile("" ::: "memory");
          bf16* op = ATT + (size_t)(rowbase + q0 + sub * 32 + (lane >> 4)) * 2048 + hq * 128 + (lane & 15) * 8;
          const LAS unsigned char* orp = ob + (lane >> 4) * ATT_OROW + (lane & 15) * 16;
#pragma unroll
          for (int i = 0; i < 8; ++i) *(v4u*)(op + (size_t)i * 4 * 2048) = *(const LAS v4u*)(orp + i * 4 * ATT_OROW); }
        __syncthreads();
    }
}

__device__ __forceinline__ void attn_naive(const Frame& F, const Args& A, const bf16* QKV, bf16* ATT) {
    const float* rel_bias = A.in[4]; const int lane = F.lane;
    const int gw = F.vcu * NWAVES + F.wave, NGW = F.G * NWAVES;
#pragma unroll 1
    for (int item = gw; item < M * 16; item += NGW) {
        const int row = item >> 4, hq = item & 15, kvh = hq >> 2;
        int L, rowbase, t;
        if (row < MP) { L = LP; rowbase = row & ~(LP - 1); t = row & (LP - 1); } else { L = LS; const int r2 = row - MP; rowbase = MP + (r2 & ~(LS - 1)); t = r2 & (LS - 1); }
        const bf16* qp = QKV + (size_t)row * 3072 + hq * 128;
        const float q0 = __uint_as_float((unsigned)qp[lane] << 16), q1 = __uint_as_float((unsigned)qp[64 + lane] << 16);
        float m = A.in[7][hq] * 1.44269504089f, l = 1.0f, o0 = 0.f, o1 = 0.f;
        const int jlo = t - 128 < 0 ? 0 : t - 128, jhi = t + 128 > L - 1 ? L - 1 : t + 128;
#pragma unroll 1
        for (int j = jlo; j <= jhi; ++j) {
            const bf16* kp = QKV + (size_t)(rowbase + j) * 3072 + 2048 + kvh * 128; const bf16* vp = kp + 512;
            float s = q0 * __uint_as_float((unsigned)kp[lane] << 16) + q1 * __uint_as_float((unsigned)kp[64 + lane] << 16);
#pragma unroll
            for (int o = 1; o < 64; o <<= 1) s += shx(s, o, lane);
            const int rel = j - t, n = rel < 0 ? -rel : rel; int b;
            if (n < 8) b = n; else { int e = 0; while ((64 << (e + 1)) <= n * n) ++e; b = 8 + e; if (b > 15) b = 15; }
            if (rel > 0) b += 16;
            s += rel_bias[b * 16 + hq] * 1.44269504089f;
            const float mn = fmaxf(m, s), sc = exp2f(m - mn), p = exp2f(s - mn);
            l = l * sc + p; o0 = o0 * sc + p * __uint_as_float((unsigned)vp[lane] << 16); o1 = o1 * sc + p * __uint_as_float((unsigned)vp[64 + lane] << 16); m = mn;
        }
        bf16* op = ATT + (size_t)row * 2048 + hq * 128;
        op[lane] = (bf16)(pk2f(o0 / l, 0.f) & 0xffffu); op[64 + lane] = (bf16)(pk2f(o1 / l, 0.f) & 0xffffu);
    }
}

#ifndef DIAG_CLOCK
#define DIAG_CLOCK 0
#endif
__device__ __forceinline__ void p0_prologue(Frame F, const Args& A, unsigned char* ws, unsigned char* dob) {
    LAS float* scr = (LAS float*)(F.lds + F.wave * 16384);
    const int gw = F.vcu * NWAVES + F.wave, NGW = F.G * NWAVES;
    constexpr int I_IN = (DM / 64) * (NIN / 32), I_AO = (AW / 64) * (DM / 32), I_HO = (HW / 64) * (DM / 32), I_OUT = (DM / 64) * (DM / 32), I_UP = (DM / 64) * (2 * FF / 32), I_DN = (FF / 64) * (DM / 32), I_PG = (DM / 64) * (DM / 32), I_PL = (PLE / 64) * (DM / 32);
    constexpr int NITEMS = I_IN + I_AO + I_HO + I_OUT + I_UP;
    auto decode = [&](int it) -> TrItem { int r = it;
        if (r < I_IN) { TrItem t = tr_item(A.in[6], DM, NIN, (bf16*)(ws + WS_WIN), nullptr, r); if (t.n0 >= 36 * 256) t.sc = -1.44269504089f; else if (t.n0 < 2048) t.sc = 0.08838834764831845f * 1.4426950408889634f; return t; } r -= I_IN;
        if (r < I_AO) return tr_item(A.in[19], AW, DM, (bf16*)(ws + WS_WAO), nullptr, r); r -= I_AO;
        if (r < I_HO) return tr_item(A.in[20], HW, DM, (bf16*)(ws + WS_WHO), nullptr, r); r -= I_HO;
        if (r < I_OUT) return tr_item(A.in[21], DM, DM, (bf16*)(ws + WS_WOUT), nullptr, r); r -= I_OUT;
        return tr_item(A.in[23], DM, 2 * FF, (bf16*)(ws + WS_WUP), A.in[22], r); };
    const bool h0first_ = (((int)blockIdx.x >> 3) & 1) != 0;
    if (h0first_) { refresh(F); h0_phase(F, A, (float*)(dob + DO_KT)); __syncthreads(); refresh(F); }
    if (gw < NITEMS) {
        float wa[32], wb[32]; TrItem ci = decode(gw); tr_load(ci, F.lane, wa);
#pragma unroll 1
        for (int it = gw; it < NITEMS; it += NGW) {
            const bool more = it + NGW < NITEMS; TrItem ni = ci;
            if (more) { ni = decode(it + NGW); tr_load(ni, F.lane, wb); }
            tr_store(ci, F.lane, wa, scr);
            if (more) {
#pragma unroll
                for (int i = 0; i < 32; ++i) wa[i] = wb[i];
                ci = ni; }
        }
    }
    if (DIAG_CLOCK >= 15 && blockIdx.x == 0) { __syncthreads(); if (threadIdx.x == 0) ((unsigned long long*)(ws + WS_CTL + 16384))[50] = wall_clock64(); }
    refresh(F);
    rms_phase_bf16(F, A.in[0], A.in[1], A.in[5], (bf16*)(dob + DO_XN));
    refresh(F);
    { bf16* PB = (bf16*)(ws + WS_PB); const size_t gt = (size_t)F.vcu * NTHR + F.tid, GT_ = (size_t)F.G * NTHR;
      constexpr size_t NQ = (size_t)M * PLE / 4;
      f32x4 v[12];
#pragma unroll
      for (int q = 0; q < 12; ++q) { const size_t i = gt + (size_t)q * GT_, e = i * 4; v[q] = (f32x4){0.f, 0.f, 0.f, 0.f}; if (i < NQ) v[q] = *(const f32x4*)(e < (size_t)MP * PLE ? A.in[2] + e : A.in[3] + (e - (size_t)MP * PLE)); }
#pragma unroll
      for (int q = 0; q < 12; ++q) { const size_t i = gt + (size_t)q * GT_, e = i * 4; if (i < NQ) *(unsigned long long*)(PB + e) = (unsigned long long)pk2f(v[q].x, v[q].y) | ((unsigned long long)pk2f(v[q].z, v[q].w) << 32); }
      for (size_t i = gt + 12 * GT_; i < NQ; i += GT_) { const size_t e = i * 4; const float* src = e < (size_t)MP * PLE ? A.in[2] + e : A.in[3] + (e - (size_t)MP * PLE);
          const f32x4 w = *(const f32x4*)src; *(unsigned long long*)(PB + e) = (unsigned long long)pk2f(w.x, w.y) | ((unsigned long long)pk2f(w.z, w.w) << 32); } }
    if (!h0first_) { __syncthreads(); refresh(F); h0_phase(F, A, (float*)(dob + DO_KT)); }
    if (DIAG_CLOCK >= 15 && blockIdx.x == 0) { __syncthreads(); if (threadIdx.x == 0) ((unsigned long long*)(ws + WS_CTL + 16384))[52] = wall_clock64(); }
}

__device__ __forceinline__ void tail_transpose_wdown(Frame F, const Args& A, unsigned char* ws, int blk0, int nblk) {
    const int b = (int)blockIdx.x - blk0; if (b < 0 || b >= nblk) return;
    refresh(F);
    LAS float* scr = (LAS float*)(F.lds + F.wave * 16384);
    constexpr int I_DN0 = (FF / 64) * (DM / 32), I_PG = (DM / 64) * (DM / 32), I_PL = (PLE / 64) * (DM / 32), I_DN = I_DN0 + I_PG + I_PL;
    auto tdec = [&](int r) -> TrItem { if (r < I_DN0) return tr_item(A.in[26], FF, DM, (bf16*)(ws + WS_WDN), nullptr, r); r -= I_DN0;
        if (r < I_PG) return tr_item(A.in[28], DM, DM, (bf16*)(ws + WS_WPG), A.in[27], r); r -= I_PG; return tr_item(A.in[29], PLE, DM, (bf16*)(ws + WS_WPL), nullptr, r); };
    const int w0 = b * NWAVES + F.wave, NW = nblk * NWAVES;
    if (w0 < I_DN) {
        float wa[32], wb[32]; TrItem ci = tdec(w0); tr_load(ci, F.lane, wa);
#pragma unroll 1
        for (int it = w0; it < I_DN; it += NW) {
            const bool more = it + NW < I_DN; TrItem ni = ci;
            if (more) { ni = tdec(it + NW); tr_load(ni, F.lane, wb); }
            tr_store(ci, F.lane, wa, scr);
            if (more) {
#pragma unroll
                for (int i = 0; i < 32; ++i) wa[i] = wb[i];
                ci = ni; }
        }
    }
}
constexpr int N_PHASES = 16;

#ifndef DBL_MASK
#define DBL_MASK 0
#endif
#ifndef DIAG_NAIVE_ATTN
#define DIAG_NAIVE_ATTN 0
#endif
__global__ void __launch_bounds__(NTHR, 2) fwd_kernel(Args args) {
    extern __shared__ __attribute__((aligned(16))) unsigned char lds[];
    Frame F;
    F.lds = (LAS unsigned char*)lds;
    volatile LAS unsigned* MISC = (volatile LAS unsigned*)(F.lds + MISC_OFF);
    F.wave = __builtin_amdgcn_readfirstlane((int)threadIdx.x >> 6); refresh(F);
    F.G = gridDim.x; { const int bx = blockIdx.x; F.vcu = (F.G % 8 == 0) ? (bx % 8) * (F.G / 8) + bx / 8 : bx; }
    unsigned char* ws = args.ws; unsigned char* dob = (unsigned char*)args.out;
    for (int u = F.tid; u < (LDS_BYTES - LDSCTL_OFF) / 4; u += NTHR) ((LAS unsigned*)(F.lds + LDSCTL_OFF))[u] = 0u;
    __syncthreads();
    XcdBarrier bar = xcd_barrier_post((unsigned*)(ws + WS_CTL) + CW_BAR, MISC + 8);
    const int lo = args.ph_lo, hi = args.ph_hi;
#ifdef ONLY_PHASE
#define IN(k) ((k) == ONLY_PHASE && lo <= (k))
#else
#define IN(k) (lo <= (k) && (k) < hi)
#endif
#define SEAM(k) do { if (IN(k) && IN((k) + 1)) xcd_barrier(bar); if (DIAG_CLOCK >= 3 && blockIdx.x == 0 && threadIdx.x == 0) ((unsigned long long*)(ws + WS_CTL + 16384))[(k) + 1] = wall_clock64(); } while (0)
#define REF() refresh(F)
    bf16* const QKV = (bf16*)(ws + WS_QKV); bf16* const HY = (bf16*)(ws + WS_HY); bf16* const GT = (bf16*)(ws + WS_GT);
    bf16* const ATT = (bf16*)(dob + DO_ATT); bf16* const HYO = (bf16*)(ws + WS_HYO); bf16* const TM = (bf16*)(ws + WS_TM);
    bf16* const XN2 = (bf16*)(ws + WS_XN2); bf16* const GU = (bf16*)(ws + WS_GU); bf16* const ACT = (bf16*)(ws + WS_ACT); bf16* const PP = (bf16*)(ws + WS_PP);
#ifndef USE_DYN
#define USE_DYN 0
#endif
#define DQ(i) (USE_DYN ? (unsigned*)(ws + WS_CTL + 786432) + (i) * 512 : (unsigned*)nullptr), (MISC + 16)
    float* const SS1 = (float*)(ws + WS_CTL + 262144); float* const SS2 = (float*)(ws + WS_CTL + 393216); float* const SS3 = (float*)(ws + WS_CTL + 524288); bf16* const X3 = (bf16*)(ws + WS_ACT);
    bf16* const GUS = (bf16*)dob;
    bf16* const UT = (bf16*)(dob + DO_UT); float* const KT = (float*)(dob + DO_KT); float* const OUT = args.out;

    if (DIAG_CLOCK >= 3 && blockIdx.x == 0 && threadIdx.x == 0) ((unsigned long long*)(ws + WS_CTL + 16384))[0] = wall_clock64();
    if (IN(0)) for (int rep_ = 0; rep_ < 1 + ((DBL_MASK >> 0) & 1); ++rep_) { if (rep_) __syncthreads(); REF(); p0_prologue(F, args, ws, dob); } SEAM(0);
    unsigned long long dc0_ = 0, dw0_ = 0; if (DIAG_CLOCK) { dc0_ = clock64(); dw0_ = wall_clock64(); }
    if (IN(1)) for (int rep_ = 0; rep_ < 1 + ((DBL_MASK >> 1) & 1); ++rep_) { if (rep_) __syncthreads(); REF(); pg8::Gemm g{(const bf16*)(dob + DO_XN), (const bf16*)(ws + WS_WIN), M, NIN, DM}; pg8::StaticOrder S; S.init(M, NIN, F.G, (int)blockIdx.x);
        pg8::EpiIn E{QKV, HY, GT}; pg8::gemm_phase<pg8::EpiIn, pg8::StaticOrder, true, true>(F.lds, g, S, E, F.tid, DIAG_CLOCK == 2 ? (float*)(ws + WS_CTL) + 3001 : nullptr, DQ(0)); }
    if (IN(1)) { const int nu = (M / 256) * (NIN / 256), rem = nu % F.G; if (rem) tail_transpose_wdown(F, args, ws, rem, F.G - rem); else tail_transpose_wdown(F, args, ws, 0, F.G); }
    if (DIAG_CLOCK == 8 && blockIdx.x == 0 && threadIdx.x == 0) ((unsigned long long*)(ws + WS_CTL + 16384))[40] = wall_clock64();
    if (DIAG_CLOCK == 7 && threadIdx.x == 0) ((unsigned long long*)(ws + WS_CTL + 32768))[blockIdx.x] = wall_clock64();
    if (DIAG_CLOCK && blockIdx.x == 0 && threadIdx.x == 0) { const unsigned long long dc1_ = clock64(), dw1_ = wall_clock64(); ((float*)(ws + WS_CTL))[3000] = (float)(dc1_ - dc0_) / (float)(dw1_ - dw0_) * 0.1f; }
    SEAM(1);
    if (IN(2)) for (int rep_ = 0; rep_ < 1 + ((DBL_MASK >> 2) & 1); ++rep_) { if (rep_) __syncthreads();
        if (((int)blockIdx.x >> 3) & 1) { REF(); h1_phase(F, args, HY, UT); __syncthreads(); REF(); attn_phase(F, args, QKV, ATT); }
        else { REF(); attn_phase(F, args, QKV, ATT); __syncthreads(); REF(); h1_phase(F, args, HY, UT); } } SEAM(2);
    if (IN(3)) { REF(); h2_phase(F, KT, UT); } SEAM(3);
    if (IN(4)) for (int rep_ = 0; rep_ < 1 + ((DBL_MASK >> 4) & 1); ++rep_) { if (rep_) __syncthreads(); REF(); h3_phase(F, args, HY, UT, HYO); } SEAM(4);
    if (IN(5)) for (int rep_ = 0; rep_ < 1 + ((DBL_MASK >> 5) & 1); ++rep_) { if (rep_) __syncthreads(); REF();
        { pg8::Gemm g{ATT, (const bf16*)(ws + WS_WAO), M, DM, AW}; pg8::StaticOrder S; S.init(M, DM, F.G, (int)blockIdx.x);
          pg8::EpiGate<0> E{GT, TM}; pg8::gemm_phase<pg8::EpiGate<0>, pg8::StaticOrder, true, true>(F.lds, g, S, E, F.tid); }
        { pg8::Gemm g{HYO, (const bf16*)(ws + WS_WHO), M, DM, HW}; pg8::StaticOrder S; S.init(M, DM, F.G, (int)blockIdx.x);
          pg8::EpiGate<1> E{GT, TM}; pg8::gemm_phase<pg8::EpiGate<1>, pg8::StaticOrder, true, true>(F.lds, g, S, E, F.tid); }
    } SEAM(5);
    if (IN(6)) for (int rep_ = 0; rep_ < 1 + ((DBL_MASK >> 6) & 1); ++rep_) { if (rep_) __syncthreads(); REF(); pg8::Gemm g{TM, (const bf16*)(ws + WS_WOUT), M, DM, DM}; pg8::StaticOrder S; S.init(M, DM, F.G, (int)blockIdx.x);
        pg8::EpiRes E{args.in[0], args.in[1], MP, XN2, SS1}; pg8::gemm_phase<pg8::EpiRes, pg8::StaticOrder, true, true>(F.lds, g, S, E, F.tid, nullptr, DQ(1)); } SEAM(6);
    if (IN(8)) for (int rep_ = 0; rep_ < 1 + ((DBL_MASK >> 8) & 1); ++rep_) { if (rep_) __syncthreads(); REF(); pg8::Gemm g{XN2, (const bf16*)(ws + WS_WUP), MP, FF, DM}; pg8::StaticOrder S; S.init(MP, FF, F.G, (int)blockIdx.x);
        pg8::EpiStore E{GU, FF, SS1}; pg8::gemm_phase<pg8::EpiStore, pg8::StaticOrder, true, true>(F.lds, g, S, E, F.tid, nullptr, DQ(2));
        { REF(); pg8::Gemm g2{XN2 + (size_t)MP * DM, (const bf16*)(ws + WS_WUP), MS, FF, DM}; pg8::RangeOrder R; R.init(MS, FF, F.G, (int)blockIdx.x); R.L0 = 0; R.L1 = F.G == 256 ? 64 : 0; R.c0 = 192; R.nb = 64;
          pg8::EpiStore E2{GUS, FF, SS1 + MP}; pg8::gemm_phase<pg8::EpiStore, pg8::RangeOrder, true, true>(F.lds, g2, R, E2, F.tid); } } SEAM(8);
    if (IN(9)) for (int rep_ = 0; rep_ < 1 + ((DBL_MASK >> 9) & 1); ++rep_) { if (rep_) __syncthreads(); REF(); pg8::Gemm g{XN2, (const bf16*)(ws + WS_WUP) + (size_t)FF * DM, MP, FF, DM}; pg8::StaticOrder S; S.init(MP, FF, F.G, (int)blockIdx.x);
        pg8::EpiGlu E{GU, ACT, args.in[24], args.in[25], LP, SS1}; pg8::gemm_phase<pg8::EpiGlu, pg8::StaticOrder, true, true>(F.lds, g, S, E, F.tid, nullptr, DQ(3));
        { REF(); pg8::Gemm g2{XN2 + (size_t)MP * DM, (const bf16*)(ws + WS_WUP), MS, FF, DM}; pg8::RangeOrder R; R.init(MS, FF, F.G, (int)blockIdx.x); R.L0 = 64; R.L1 = F.G == 256 ? 128 : 64; R.c0 = 192; R.nb = 64;
          pg8::EpiStore E2{GUS, FF, SS1 + MP}; pg8::gemm_phase<pg8::EpiStore, pg8::RangeOrder, true, true>(F.lds, g2, R, E2, F.tid); } } SEAM(9);
    if (IN(10)) { REF();
        { pg8::Gemm g{ACT, (const bf16*)(ws + WS_WDN), MP, DM, FF}; pg8::StaticOrder S; S.init(MP, DM, F.G, (int)blockIdx.x);
          pg8::EpiResB E{XN2, SS2}; pg8::gemm_phase<pg8::EpiResB, pg8::StaticOrder, true, true>(F.lds, g, S, E, F.tid, nullptr, DQ(4)); }
        if (DIAG_CLOCK == 11 && blockIdx.x == 0 && threadIdx.x == 0) ((unsigned long long*)(ws + WS_CTL + 16384))[41] = wall_clock64();
        { REF(); pg8::Gemm g{XN2 + (size_t)MP * DM, (const bf16*)(ws + WS_WUP), MS, FF, DM}; pg8::RangeOrder S; S.init(MS, FF, F.G, (int)blockIdx.x); S.L0 = F.G == 256 ? 128 : 0; S.L1 = (MS / 256) * (FF / 256); S.c0 = 0; S.nb = F.G;
          pg8::EpiStore E{GUS, FF, SS1 + MP}; pg8::gemm_phase<pg8::EpiStore, pg8::RangeOrder, true, true>(F.lds, g, S, E, F.tid); }
    } SEAM(10);
    if (IN(11)) for (int rep_ = 0; rep_ < 1 + ((DBL_MASK >> 11) & 1); ++rep_) { if (rep_) __syncthreads(); REF(); pg8::Gemm g{XN2 + (size_t)MP * DM, (const bf16*)(ws + WS_WUP) + (size_t)FF * DM, MS, FF, DM}; pg8::StaticOrder S; S.init(MS, FF, F.G, (int)blockIdx.x);
        pg8::EpiGlu E{GUS, ACT, args.in[24], args.in[25], LS, SS1 + MP}; pg8::gemm_phase<pg8::EpiGlu, pg8::StaticOrder, true, true>(F.lds, g, S, E, F.tid, nullptr, DQ(6));
        { REF(); pg8::Gemm g2{(const bf16*)(ws + WS_PB), (const bf16*)(ws + WS_WPL), M, DM, PLE}; pg8::RangeOrder R; R.init(M, DM, F.G, (int)blockIdx.x); R.L0 = 0; R.L1 = F.G == 256 ? 960 : 0; R.c0 = 96; R.nb = 160;
          pg8::EpiPP E2{PP}; pg8::gemm_phase<pg8::EpiPP, pg8::RangeOrder, true, true>(F.lds, g2, R, E2, F.tid); } } SEAM(11);
    if (IN(12)) { REF(); pg8::Gemm g{ACT, (const bf16*)(ws + WS_WDN), MS, DM, FF}; pg8::StaticOrder S; S.init(MS, DM, F.G, (int)blockIdx.x);
        pg8::EpiResB E{XN2 + (size_t)MP * DM, SS2 + MP}; pg8::gemm_phase<pg8::EpiResB, pg8::StaticOrder, true, true>(F.lds, g, S, E, F.tid, nullptr, DQ(7)); } SEAM(12);
    if (IN(14)) { REF();
        { pg8::Gemm g{(const bf16*)(ws + WS_PB), (const bf16*)(ws + WS_WPL), M, DM, PLE}; pg8::RangeOrder S; S.init(M, DM, F.G, (int)blockIdx.x); S.L0 = F.G == 256 ? 960 : 0; S.L1 = (M / 256) * (DM / 256); S.c0 = F.G == 256 ? 192 : 0; S.nb = F.G;
          pg8::EpiPP E{PP}; pg8::gemm_phase<pg8::EpiPP, pg8::RangeOrder, true, true>(F.lds, g, S, E, F.tid); }
        { pg8::Gemm g{XN2, (const bf16*)(ws + WS_WPG), M, DM, DM}; pg8::StaticOrder S; S.init(M, DM, F.G, (int)blockIdx.x);
          pg8::EpiPle E{PP, XN2, X3, SS2, SS3}; pg8::gemm_phase<pg8::EpiPle, pg8::StaticOrder, true, true>(F.lds, g, S, E, F.tid); }
    } SEAM(14);
    float dadd_ = 0.f;
    if (DIAG_CLOCK >= 3) { const unsigned long long* st_ = (const unsigned long long*)(ws + WS_CTL + 16384);
        auto T = [&](int a, int b) { return (float)(st_[b] - st_[a]) * 1e-5f; };
        float rv_ = 0.f;
        if (DIAG_CLOCK == 3) rv_ = 1e-4f * T(0, 1);
        if (DIAG_CLOCK == 4) rv_ = 3e-5f * T(1, 2);
        if (DIAG_CLOCK == 5) rv_ = 1e-4f * T(2, 5);
        if (DIAG_CLOCK == 6) rv_ = 3e-5f * T(5, 7);
        if (DIAG_CLOCK == 7) rv_ = 2e-5f * T(7, 13);
        if (DIAG_CLOCK == 9) rv_ = 1e-4f * T(13, 15);
        dadd_ = sqrtf(rv_); }
    if (IN(15)) { REF(); final_phase(F, X3, SS3, args.in[30], OUT, dadd_); }
#undef IN
#undef SEAM
#undef REF
#undef DQ
}

#ifndef MK_PER_PHASE
#define MK_PER_PHASE 0
#endif
extern "C" void kernel_launch(void* const* d_in, const int* in_sizes, int n_in, void* d_out, int out_size, void* d_ws, size_t ws_size, hipStream_t stream) {
    static int grid = 0;
    if (grid == 0) {
        if (n_in != 31 || out_size != M * DM || ws_size < WS_END) { fprintf(stderr, "kernel_launch: unexpected shapes (n_in %d out %d ws %zu)\n", n_in, out_size, ws_size); grid = -1; return; }
        int dev = 0, cus = 0, per_cu = 0;
        if (hipGetDevice(&dev) != hipSuccess || hipDeviceGetAttribute(&cus, hipDeviceAttributeMultiprocessorCount, dev) != hipSuccess) { grid = -1; return; }
        if (hipFuncSetAttribute((const void*)fwd_kernel, hipFuncAttributeMaxDynamicSharedMemorySize, LDS_BYTES) != hipSuccess) { fprintf(stderr, "kernel_launch: hipFuncSetAttribute failed\n"); grid = -1; return; }
        if (hipOccupancyMaxActiveBlocksPerMultiprocessor(&per_cu, (const void*)fwd_kernel, NTHR, LDS_BYTES) != hipSuccess || per_cu < 1) fprintf(stderr, "kernel_launch: occupancy query reports %d\n", per_cu);
        (void)hipGetLastError();
        grid = cus;
    }
    if (grid < 0) return;
    if (hipMemsetAsync((char*)d_ws + WS_CTL, 0, CTL_ZERO_BYTES, stream) != hipSuccess) return;
    Args a{};
    for (int i = 0; i < 31; ++i) a.in[i] = (const float*)d_in[i];
    a.out = (float*)d_out; a.ws = (unsigned char*)d_ws;
#if MK_PER_PHASE
    for (int p = 0; p < N_PHASES; ++p) { a.ph_lo = p; a.ph_hi = p + 1; hipLaunchKernelGGL(fwd_kernel, dim3(grid), dim3(NTHR), LDS_BYTES, stream, a); }
#else
    a.ph_lo = 0; a.ph_hi = N_PHASES;
    hipLaunchKernelGGL(fwd_kernel, dim3(grid), dim3(NTHR), LDS_BYTES, stream, a);
#endif
}
```
